# Optimizing an MI355X kernel written in HIP

```python
import jax, jax.numpy as jnp
from jax import lax
import numpy as np

D_MODEL = 1024
BATCH = 32
SEQ = 256
DEPTH = 4
DEC_BATCH = 8
DEC_SEQ = 1024
PAST_LEN = 512

GRID_W = 64
D_MIX = D_MODEL
H_A = 4
D_A = D_MIX // 2
DH_A = D_A // H_A
H_B = 4
D_B = D_MIX // 4
DH_B = D_B // H_B
H_C = 4
D_C = D_MIX // 4
DV_C = D_C // H_C
DK_C = DV_C // 2
GLA_RANK = 16
GLA_TAU = 16.0
MLSTM_CHUNK = 64
RET_CHUNK = 64
GLA_CHUNK = 32
ROPE_BASE = 10000.0
EPS = 1e-6
IN_WIDTHS = (D_A, D_A, D_A, D_A, D_A, 4 * H_A, D_B, D_B, D_B, D_B, H_C * DK_C, H_C * DK_C, D_C, D_C, 2 * GLA_RANK)
D_IN = 5 * D_A + 4 * H_A + 4 * D_B + 2 * H_C * DK_C + 2 * D_C + 2 * GLA_RANK

kernel_name = 'hybrid_mlstm_retention_gla_diffusion_step'


def _rmsnorm(x, g):
    x = x.astype(jnp.float32)
    return x * lax.rsqrt(jnp.mean(x * x, axis=-1, keepdims=True) + EPS) * g.astype(jnp.float32)


def _head_rms(y):
    return y * lax.rsqrt(jnp.mean(y * y, axis=-1, keepdims=True) + EPS)


def _chunk(t, c):
    return t.reshape((t.shape[0], t.shape[1] // c, c) + t.shape[2:])


def _grid_rotary(L):
    rows = L // GRID_W
    r = jnp.repeat(jnp.arange(rows, dtype=jnp.float32), GRID_W)
    col = jnp.tile(jnp.arange(GRID_W, dtype=jnp.float32), rows)
    n_f = DH_B // 4
    freqs = ROPE_BASE ** (-jnp.arange(n_f, dtype=jnp.float32) / n_f)
    ang = jnp.concatenate([r[:, None] * freqs, col[:, None] * freqs], axis=-1)
    return jnp.cos(ang)[None, :, None, :], jnp.sin(ang)[None, :, None, :]


def _rotate(t, cos, sin):
    t1, t2 = jnp.split(t, 2, axis=-1)
    return jnp.concatenate([t1 * cos - t2 * sin, t1 * sin + t2 * cos], axis=-1)


def _mlstm(q, k, v, i_pre, f_pre, state0):
    f32 = jnp.float32
    C0, n0, m0 = (s.astype(f32) for s in state0)
    Cs = MLSTM_CHUNK
    qc, kc, vc = _chunk(q, Cs), _chunk(k, Cs), _chunk(v, Cs)
    ic = _chunk(i_pre, Cs)
    F = jnp.cumsum(jax.nn.log_sigmoid(_chunk(f_pre, Cs)), axis=2)
    F_last = F[:, :, -1]
    g = F_last[:, :, None] - F + ic
    gm = jnp.max(g, axis=2)
    wg = jnp.exp(g - gm[:, :, None])
    U_C = jnp.einsum('bnjh,bnjhd,bnjhe->bnhde', wg, kc, vc)
    U_n = jnp.einsum('bnjh,bnjhd->bnhd', wg, kc)

    def step(carry, inp):
        Cp, npv, mp = carry
        fl, gmx, uc, un = inp
        m_new = jnp.maximum(fl + mp, gmx)
        a = jnp.exp(fl + mp - m_new)
        b = jnp.exp(gmx - m_new)
        new = (a[..., None, None] * Cp + b[..., None, None] * uc, a[..., None] * npv + b[..., None] * un, m_new)
        return new, carry

    mv = lambda t: jnp.moveaxis(t, 1, 0)
    (C_last, n_last, m_last), (C_prev, n_prev, m_prev) = lax.scan(
        step, (C0, n0, m0), (mv(F_last), mv(gm), mv(U_C), mv(U_n)))
    C_prev, n_prev, m_prev = mv(C_prev), mv(n_prev), mv(m_prev)
    a_in = F + m_prev[:, :, None]
    causal = jnp.tril(jnp.ones((Cs, Cs), dtype=bool))
    D = F[:, :, :, None] - F[:, :, None, :] + ic[:, :, None, :]
    D = jnp.where(causal[:, :, None], D, -jnp.inf)
    m_i = jnp.maximum(a_in, jnp.max(D, axis=3))
    wD = jnp.exp(D - m_i[:, :, :, None])
    wa = jnp.exp(a_in - m_i)
    qk = jnp.einsum('bnihd,bnjhd->bnijh', qc, kc) * wD
    num = jnp.einsum('bnijh,bnjhe->bnihe', qk, vc) + wa[..., None] * jnp.einsum('bnihd,bnhde->bnihe', qc, C_prev)
    den = jnp.sum(qk, axis=3) + wa * jnp.einsum('bnihd,bnhd->bnih', qc, n_prev)
    h = num / jnp.maximum(jnp.abs(den), jnp.exp(-m_i))[..., None]
    return h.reshape(v.shape), (C_last, n_last, m_last)


def _retention(q, k, v, log_gamma, S0):
    f32 = jnp.float32
    S0 = S0.astype(f32)
    Cs = RET_CHUNK
    qc, kc, vc = _chunk(q, Cs), _chunk(k, Cs), _chunk(v, Cs)
    pos = jnp.arange(Cs, dtype=f32)
    rel = pos[:, None] - pos[None, :]
    decay = jnp.where((rel >= 0)[..., None], jnp.exp(jnp.maximum(rel, 0.0)[..., None] * log_gamma), 0.0)
    scores = jnp.einsum('bnihd,bnjhd->bnhij', qc, kc) * jnp.transpose(decay, (2, 0, 1))
    intra = jnp.einsum('bnhij,bnjhe->bnihe', scores, vc)
    w_end = jnp.exp((Cs - 1 - pos)[:, None] * log_gamma)
    U = jnp.einsum('bnjhd,jh,bnjhe->bnhde', kc, w_end, vc)
    g_chunk = jnp.exp(Cs * log_gamma)[:, None, None]

    def step(S, U_n):
        return g_chunk * S + U_n, S

    S_last, S_prev = lax.scan(step, S0, jnp.moveaxis(U, 1, 0))
    S_prev = jnp.moveaxis(S_prev, 0, 1)
    w_q = jnp.exp((pos + 1.0)[:, None] * log_gamma)
    inter = jnp.einsum('bnihd,ih,bnhde->bnihe', qc, w_q, S_prev)
    return (intra + inter).reshape(v.shape), S_last


def _gla(q, k, v, log_a, S0):
    f32 = jnp.float32
    S0 = S0.astype(f32)
    Cs = GLA_CHUNK
    qc, kc, vc = _chunk(q, Cs), _chunk(k, Cs), _chunk(v, Cs)
    b = jnp.cumsum(_chunk(log_a, Cs), axis=2)
    causal = jnp.tril(jnp.ones((Cs, Cs), dtype=bool))
    diff = b[:, :, :, None] - b[:, :, None, :]
    diff = jnp.where(causal[None, None, :, :, None, None], diff, -jnp.inf)
    scores = jnp.einsum('bnihd,bnjhd,bnijhd->bnhij', qc, kc, jnp.exp(diff))
    intra = jnp.einsum('bnhij,bnjhe->bnihe', scores, vc)
    b_last = b[:, :, -1]
    U = jnp.einsum('bnjhd,bnjhe->bnhde', kc * jnp.exp(b_last[:, :, None] - b), vc)

    def step(S, inp):
        gl, U_n = inp
        return jnp.exp(gl)[..., None] * S + U_n, S

    S_last, S_prev = lax.scan(step, S0, (jnp.moveaxis(b_last, 1, 0), jnp.moveaxis(U, 1, 0)))
    S_prev = jnp.moveaxis(S_prev, 0, 1)
    inter = jnp.einsum('bnihd,bnhde->bnihe', qc * jnp.exp(b), S_prev)
    return (intra + inter).reshape(v.shape), S_last


def _mixer(h, st_f, st_b, rot, w_in, gate_b, ret_logit, gla_w2, gla_b2, hn_g, w_out):
    f32 = jnp.float32
    B, L, _ = h.shape
    proj = jnp.einsum('bld,de->ble', h, w_in.astype(f32))
    (aq, ak, av, ao, az, ag, bq, bk, bv, bz, cq, ck, cv, cz, clr) = jnp.split(
        proj, np.cumsum(IN_WIDTHS)[:-1].tolist(), axis=-1)
    flip = lambda t: jnp.flip(t, axis=1)

    aq = aq.reshape(B, L, H_A, DH_A)
    ak = ak.reshape(B, L, H_A, DH_A) * DH_A ** -0.5
    av = av.reshape(B, L, H_A, DH_A)
    ag = (ag + gate_b.astype(f32)).reshape(B, L, 4, H_A)
    ha_f, sa_f = _mlstm(aq, ak, av, ag[:, :, 0], ag[:, :, 1], st_f[0:3])
    ha_b, sa_b = _mlstm(flip(aq), flip(ak), flip(av), flip(ag[:, :, 2]), flip(ag[:, :, 3]), st_b[0:3])
    ya = jax.nn.sigmoid(ao).reshape(B, L, H_A, DH_A) * (ha_f + flip(ha_b))

    bq = bq.reshape(B, L, H_B, DH_B)
    bk = bk.reshape(B, L, H_B, DH_B)
    bv = bv.reshape(B, L, H_B, DH_B)
    if rot is not None:
        bq = _rotate(bq, rot[0], rot[1])
        bk = _rotate(bk, rot[0], rot[1])
    bk = bk * DH_B ** -0.5
    log_gamma = jax.nn.log_sigmoid(ret_logit.astype(f32))
    hb_f, sb_f = _retention(bq, bk, bv, log_gamma[0], st_f[3])
    hb_b, sb_b = _retention(flip(bq), flip(bk), flip(bv), log_gamma[1], st_b[3])
    yb = hb_f + flip(hb_b)

    cq = cq.reshape(B, L, H_C, DK_C)
    ck = ck.reshape(B, L, H_C, DK_C) * DK_C ** -0.5
    cv = cv.reshape(B, L, H_C, DV_C)
    clr = clr.reshape(B, L, 2, GLA_RANK)
    log_a = jax.nn.log_sigmoid(jnp.einsum('bldr,drk->bldk', clr, gla_w2.astype(f32)) + gla_b2.astype(f32)) / GLA_TAU
    log_a = log_a.reshape(B, L, 2, H_C, DK_C)
    hc_f, sc_f = _gla(cq, ck, cv, log_a[:, :, 0], st_f[4])
    hc_b, sc_b = _gla(flip(cq), flip(ck), flip(cv), flip(log_a[:, :, 1]), st_b[4])
    yc = hc_f + flip(hc_b)

    y = jnp.concatenate([_head_rms(ya).reshape(B, L, D_A), _head_rms(yb).reshape(B, L, D_B),
                         _head_rms(yc).reshape(B, L, D_C)], axis=-1)
    y = y * hn_g.astype(f32) * jax.nn.silu(jnp.concatenate([az, bz, cz], axis=-1))
    out = jnp.einsum('ble,ed->bld', y, w_out.astype(f32))
    return out, (sa_f[0], sa_f[1], sa_f[2], sb_f, sc_f), (sa_b[0], sa_b[1], sa_b[2], sb_b, sc_b)


def _layer(x, mod, st_f, st_b, rot, g, w_in, gate_b, ret_logit, gla_w2, gla_b2, hn_g, w_out):
    shift, scale, gate = jnp.split(mod[:, None, :], 3, axis=-1)
    h = _rmsnorm(x, g) * (1.0 + scale) + shift
    out, sf, sb = _mixer(h, st_f, st_b, rot, w_in, gate_b, ret_logit, gla_w2, gla_b2, hn_g, w_out)
    return (x.astype(jnp.float32) + gate * out).astype(x.dtype), sf, sb


def _modulation(cvec, w, b):
    return jnp.einsum('bd,de->be', jax.nn.silu(cvec.astype(jnp.float32)), w.astype(jnp.float32)) + b.astype(jnp.float32)


def _zero_state(B):
    z = lambda *s: jnp.zeros((B,) + s, jnp.float32)
    return (z(H_A, DH_A, DH_A), z(H_A, DH_A), z(H_A), z(H_B, DH_B, DH_B), z(H_C, DK_C, DV_C))


def setup_inputs(seed: int = 0) -> dict:
    key = jax.random.key(seed)
    ks = jax.random.split(key, 24)
    f32 = jnp.float32
    nrm = lambda k, shape, s: s * jax.random.normal(k, shape, f32)
    x_prompt = nrm(ks[0], (BATCH, SEQ, D_MODEL), 1.0)
    x_sample = nrm(ks[1], (DEC_BATCH, DEC_SEQ, D_MODEL), 1.0)
    state_mlstm_C = nrm(ks[2], (DEC_BATCH, DEPTH, 2, H_A, DH_A, DH_A), 0.5)
    state_mlstm_n = nrm(ks[3], (DEC_BATCH, DEPTH, 2, H_A, DH_A), 0.5)
    state_mlstm_m = nrm(ks[4], (DEC_BATCH, DEPTH, 2, H_A), 1.0)
    state_ret = nrm(ks[5], (DEC_BATCH, DEPTH, 2, H_B, DH_B, DH_B), 1.0)
    state_gla = nrm(ks[6], (DEC_BATCH, DEPTH, 2, H_C, DK_C, DV_C), 1.0)
    c = nrm(ks[7], (DEC_BATCH, D_MODEL), 1.0)
    c_ctx = nrm(ks[8], (D_MODEL,), 1.0)
    norm_g = 1.0 + nrm(ks[9], (DEPTH, D_MODEL), 0.02)
    w_ada = nrm(ks[10], (DEPTH, D_MODEL, 3 * D_MODEL), 0.5 * D_MODEL ** -0.5)
    b_ada = nrm(ks[11], (DEPTH, 3 * D_MODEL), 0.02)
    w_in = nrm(ks[12], (DEPTH, D_MODEL, D_IN), D_MODEL ** -0.5)
    i_bias = nrm(ks[13], (DEPTH, 2, 1, H_A), 0.1)
    f_bias = jnp.linspace(3.0, 6.0, H_A, dtype=f32) + nrm(ks[14], (DEPTH, 2, 1, H_A), 0.1)
    mlstm_gate_b = jnp.concatenate([i_bias, f_bias], axis=2).reshape(DEPTH, 4 * H_A)
    e = 5.0 + jnp.arange(H_B, dtype=f32)
    ret_decay_logit = jnp.log(2.0 ** e - 1.0) + nrm(ks[15], (DEPTH, 2, H_B), 0.05)
    gla_w2 = nrm(ks[16], (DEPTH, 2, GLA_RANK, H_C * DK_C), GLA_RANK ** -0.5)
    gla_b2 = 1.0 + nrm(ks[17], (DEPTH, 2, H_C * DK_C), 0.1)
    headnorm_g = 1.0 + nrm(ks[18], (DEPTH, D_MIX), 0.02)
    w_out = nrm(ks[19], (DEPTH, D_MIX, D_MODEL), D_MIX ** -0.5)
    final_g = 1.0 + nrm(ks[20], (D_MODEL,), 0.02)
    return {'x_prompt': x_prompt, 'x_sample': x_sample, 'state_mlstm_C': state_mlstm_C,
            'state_mlstm_n': state_mlstm_n, 'state_mlstm_m': state_mlstm_m, 'state_ret': state_ret,
            'state_gla': state_gla, 'c': c, 'c_ctx': c_ctx, 'norm_g': norm_g, 'w_ada': w_ada, 'b_ada': b_ada,
            'w_in': w_in, 'mlstm_gate_b': mlstm_gate_b, 'ret_decay_logit': ret_decay_logit, 'gla_w2': gla_w2,
            'gla_b2': gla_b2, 'headnorm_g': headnorm_g, 'w_out': w_out, 'final_g': final_g}


def reference(x_prompt, x_sample, state_mlstm_C, state_mlstm_n, state_mlstm_m, state_ret, state_gla, c, c_ctx,
              norm_g, w_ada, b_ada, w_in, mlstm_gate_b, ret_decay_logit, gla_w2, gla_b2, headnorm_g, w_out, final_g):
    Bp = x_prompt.shape[0]
    Ls = x_sample.shape[1]
    rot = _grid_rotary(Ls)
    caches = (state_mlstm_C, state_mlstm_n, state_mlstm_m, state_ret, state_gla)
    xp, xs = x_prompt, x_sample
    ctx_states = []
    for l in range(DEPTH):
        lp = (norm_g[l], w_in[l], mlstm_gate_b[l], ret_decay_logit[l], gla_w2[l], gla_b2[l], headnorm_g[l], w_out[l])
        mod_ctx = _modulation(c_ctx[None, :], w_ada[l], b_ada[l])
        mod_lat = _modulation(c, w_ada[l], b_ada[l])
        xp, sf, sb = _layer(xp, mod_ctx, _zero_state(Bp), _zero_state(Bp), None, *lp)
        ctx_states.append([jnp.stack([a, b], axis=1) for a, b in zip(sf, sb)])
        cache_f = [s[:, l, 0] for s in caches]
        cache_b = [s[:, l, 1] for s in caches]
        xs, _, _ = _layer(xs, mod_lat, cache_f, cache_b, rot, *lp)
    new_mlstm_C = jnp.stack([s[0] for s in ctx_states], axis=1)
    new_mlstm_n = jnp.stack([s[1] for s in ctx_states], axis=1)
    new_mlstm_m = jnp.stack([s[2] for s in ctx_states], axis=1)
    new_ret = jnp.stack([s[3] for s in ctx_states], axis=1)
    new_gla = jnp.stack([s[4] for s in ctx_states], axis=1)
    y_prompt = _rmsnorm(xp, final_g).astype(x_prompt.dtype)
    y_sample = _rmsnorm(xs, final_g).astype(x_sample.dtype)
    return (y_prompt, y_sample, new_mlstm_C, new_mlstm_n, new_mlstm_m, new_ret, new_gla)
```

```cpp
#include <hip/hip_runtime.h>
#include <hip/hip_cooperative_groups.h>
#include <cstdio>
#include <cstdint>
namespace cg = cooperative_groups;

#ifndef N_LAUNCH_MODE
#define N_LAUNCH_MODE 1
#endif

#define LAS __attribute__((address_space(3)))
typedef unsigned short bf16;
typedef short bf16x8 __attribute__((ext_vector_type(8)));
typedef short bf16x4 __attribute__((ext_vector_type(4)));
typedef float f32x4 __attribute__((ext_vector_type(4)));
typedef unsigned u32x4 __attribute__((ext_vector_type(4)));
typedef unsigned u32x2 __attribute__((ext_vector_type(2)));

namespace pg8 {
#define PG8_LAS __attribute__((address_space(3)))
typedef unsigned short bf16_t;
constexpr int BM = 256, BK = 64, HALF = 128, HTB = HALF * BK * 2, STAGE_BYTES = 8 * HTB, NXCD = 8, WGM = 8;

__host__ __device__ __forceinline__ int lds_byte(int r, int c) { const int st = (r >> 4) * 2 + (c >> 5), rr = r & 15, cc = c & 31, ob = rr * 64 + cc * 2; return st * 1024 + (ob ^ (((ob >> 9) & 1) << 5)); }
__host__ __device__ __forceinline__ void stage_rc(int b, int& R, int& C) { const int st = b / 1024, sb = b % 1024, swz = sb ^ (((sb >> 9) & 1) << 5); R = (st >> 1) * 16 + swz / 64; C = (st & 1) * 32 + (swz % 64) / 2; }
__host__ __device__ __forceinline__ int perm32(int rho) { const int n = rho >> 4, i = rho & 15; return 8 * (i >> 2) + 4 * n + (i & 3); }

struct Unit { int pm, pn; };
struct Gemm { const bf16_t* A; const bf16_t* Bt; int M, N, K; };

struct StaticOrder {
    int nM, nN, nwg, G, c;
    __host__ __device__ void init(int M, int N, int G_, int c_) { nM = M / BM; nN = N / BM; nwg = nM * nN; G = G_; c = c_; }
    __host__ __device__ bool next(int i, Unit& u) const {
        const long L = (long)i * G + c; if (L >= nwg) return false;
        int wgid = (int)L; { const int q = nwg / NXCD, r = nwg % NXCD, xcd = wgid % NXCD, off = wgid / NXCD; wgid = (xcd < r ? xcd * (q + 1) : r * (q + 1) + (xcd - r) * q) + off; }
        const int nig = WGM * nN, gid = wgid / nig, fm = gid * WGM, gsz = (nM - fm) < WGM ? (nM - fm) : WGM;
        u.pm = fm + ((wgid % nig) % gsz); u.pn = (wgid % nig) / gsz; return true;
    }
    __device__ __forceinline__ void a_ready(const Unit&) const {}
    __device__ __forceinline__ void done(const Unit&) const {}
};

__device__ __forceinline__ unsigned cvt_pk_bf16(float lo, float hi) { unsigned r; asm volatile("v_cvt_pk_bf16_f32 %0, %1, %2" : "=v"(r) : "v"(lo), "v"(hi)); return r; }

struct EpiBf16 {
    static constexpr bool PERM = true, AFTER_DRAIN = false;
    bf16_t* O; int ldc;
    __device__ __forceinline__ void operator()(const f32x4 (&acc)[2][2][4][2], const Unit& u, int wr, int wc, int fr, int fq) const {
        const int row0 = u.pm * BM + wr * 64 + fr; const int col0 = u.pn * BM + wc * 32 + 8 * fq;
#pragma unroll
        for (int ai = 0; ai < 2; ++ai)
#pragma unroll
            for (int m = 0; m < 4; ++m) { bf16_t* rowp = O + (size_t)(row0 + ai * HALF + m * 16) * ldc + col0;
#pragma unroll
                for (int bj = 0; bj < 2; ++bj) { const f32x4 v0 = acc[ai][bj][m][0], v1 = acc[ai][bj][m][1];
                    u32x4 w; w.x = cvt_pk_bf16(v0[0], v0[1]); w.y = cvt_pk_bf16(v0[2], v0[3]); w.z = cvt_pk_bf16(v1[0], v1[1]); w.w = cvt_pk_bf16(v1[2], v1[3]);
                    *(u32x4*)(rowp + bj * HALF) = w; } }
    }
};
struct EpiResid {
    static constexpr bool PERM = false, AFTER_DRAIN = false;
    const float* xin0; const float* xin1;
    float* xout; const float* gate;
    __device__ __forceinline__ void operator()(const f32x4 (&acc)[2][2][4][2], const Unit& u, int wr, int wc, int fr, int fq) const {
        const int row0 = u.pm * BM + wr * 64 + fr, col0 = u.pn * BM + wc * 32 + 4 * fq;
#pragma unroll
        for (int ai = 0; ai < 2; ++ai)
#pragma unroll
            for (int m = 0; m < 4; ++m) { const int row = row0 + ai * HALF + m * 16;
                const float* xr = (row < 8192 ? xin0 + (size_t)row * 1024 : xin1 + (size_t)(row - 8192) * 1024) + col0;
                const float* gr = gate + (size_t)(row < 8192 ? 0 : 1 + ((row - 8192) >> 10)) * 3072 + col0;
                float* orow = xout + (size_t)row * 1024 + col0;
#pragma unroll
                for (int bj = 0; bj < 2; ++bj)
#pragma unroll
                    for (int n = 0; n < 2; ++n) { const f32x4 xv = *(const f32x4*)(xr + bj * HALF + n * 16), gv = *(const f32x4*)(gr + bj * HALF + n * 16);
                        *(f32x4*)(orow + bj * HALF + n * 16) = xv + gv * acc[ai][bj][m][n]; } }
    }
};

template <class Epi, class Sched, bool ALIGN_EPI = false, bool SP2 = false>
__device__ __forceinline__ void gemm_phase(PG8_LAS unsigned char* lds, const Gemm g, const Sched& S, const Epi& E) {
    int tid_ = threadIdx.x; asm volatile("" : "+v"(tid_));
    const int tid = tid_, wid = __builtin_amdgcn_readfirstlane(tid >> 6), lane = tid & 63, wr = wid >> 2, wc = wid & 3, fr = lane & 15, fq = lane >> 4;
    const int K = g.K, nt = K / BK;
    unsigned voffA[2], voffB[2];
#pragma unroll
    for (int i = 0; i < 2; ++i) { int R, C; stage_rc(tid * 16 + i * 8192, R, C); const int Rb = Epi::PERM ? ((R & ~31) + perm32(R & 31)) : R;
        voffA[i] = (unsigned)(R * K + C) * 2u; voffB[i] = (unsigned)(Rb * K + C) * 2u; }
    const size_t kstep = (size_t)(BK * 2);
    const size_t hstep = (size_t)HALF * K * 2;
    const size_t tstep = 2 * hstep;
    const unsigned ldsw = (unsigned)wid * 1024u;
    const int aoff = lds_byte(wr * 64 + fr, fq * 8), boff = lds_byte(wc * 32 + fr, fq * 8);
#define PG8_SA(b, h) (((b) * 2 + (h)) * HTB)
#define PG8_SB(b, h) ((4 + (b) * 2 + (h)) * HTB)
#define PG8_STAGE(bufoff, gbase, voff) do { _Pragma("unroll") for (int _i = 0; _i < 2; ++_i) \
        __builtin_amdgcn_global_load_lds((const unsigned*)((const char*)(gbase) + (voff)[_i]), (PG8_LAS unsigned*)(lds + (bufoff) + ldsw + _i * 8192), 16, 0, 0); } while (0)
#define PG8_LDA(dst, b, h) do { _Pragma("unroll") for (int m = 0; m < 4; ++m) _Pragma("unroll") for (int k = 0; k < 2; ++k) dst[m][k] = *(const PG8_LAS bf16x8*)(lds + PG8_SA(b, h) + aoff + m * 2048 + k * 1024); } while (0)
#define PG8_LDB(dst, b, h) do { _Pragma("unroll") for (int n = 0; n < 2; ++n) _Pragma("unroll") for (int k = 0; k < 2; ++k) dst[n][k] = *(const PG8_LAS bf16x8*)(lds + PG8_SB(b, h) + boff + n * 2048 + k * 1024); } while (0)
#define PG8_MMA(ai, bj, At, Bt) do { __builtin_amdgcn_s_setprio(1); _Pragma("unroll") for (int m = 0; m < 4; ++m) _Pragma("unroll") for (int n = 0; n < 2; ++n) _Pragma("unroll") for (int k = 0; k < 2; ++k) \
        acc[ai][bj][m][n] = __builtin_amdgcn_mfma_f32_16x16x32_bf16(Bt[n][k], At[m][k], acc[ai][bj][m][n], 0, 0, 0); __builtin_amdgcn_s_setprio(0); } while (0)
#define PG8_WAIT_V(n) asm volatile("s_waitcnt vmcnt(" #n ")" ::: "memory")
#define PG8_WAIT_L(n) asm volatile("s_waitcnt lgkmcnt(" #n ")" ::: "memory")
#define PG8_BAR __builtin_amdgcn_s_barrier()
#define PG8_SCHED __builtin_amdgcn_sched_barrier(0)
    Unit cur, nxt; int ui = 0;
    if (!S.next(0, cur)) return;
    f32x4 acc[2][2][4][2];
#pragma unroll
    for (int a = 0; a < 2; ++a)
#pragma unroll
        for (int b = 0; b < 2; ++b)
#pragma unroll
            for (int m = 0; m < 4; ++m)
#pragma unroll
                for (int n = 0; n < 2; ++n) acc[a][b][m][n] = (f32x4){0.f, 0.f, 0.f, 0.f};
    bf16x8 At[4][2], B0[2][2], B1[2][2];
    const char* cA = (const char*)g.A + (size_t)cur.pm * tstep; const char* cB = (const char*)g.Bt + (size_t)cur.pn * tstep;
    S.a_ready(cur);
    if constexpr (SP2) {
        PG8_STAGE(PG8_SB(0, 0), cB, voffB); PG8_STAGE(PG8_SB(0, 1), cB + hstep, voffB); PG8_STAGE(PG8_SA(0, 0), cA, voffA); PG8_STAGE(PG8_SA(0, 1), cA + hstep, voffA);
        if (wr == 1) PG8_BAR;
        PG8_WAIT_V(2); PG8_BAR;
        PG8_STAGE(PG8_SB(1, 0), cB + kstep, voffB); PG8_STAGE(PG8_SA(1, 0), cA + kstep, voffA); PG8_STAGE(PG8_SB(1, 1), cB + hstep + kstep, voffB);
        PG8_WAIT_V(6); PG8_BAR;
    } else {
        PG8_STAGE(PG8_SB(0, 0), cB, voffB); PG8_STAGE(PG8_SA(0, 0), cA, voffA); PG8_STAGE(PG8_SB(0, 1), cB + hstep, voffB); PG8_STAGE(PG8_SA(0, 1), cA + hstep, voffA);
        if (wr == 1) PG8_BAR;
        PG8_WAIT_V(4); PG8_BAR;
        PG8_STAGE(PG8_SB(1, 0), cB + kstep, voffB); PG8_STAGE(PG8_SA(1, 0), cA + kstep, voffA); PG8_STAGE(PG8_SB(1, 1), cB + hstep + kstep, voffB);
        PG8_WAIT_V(6); PG8_BAR;
    }
    for (;;) {
        const bool has_next = S.next(ui + 1, nxt);
        const char* nA = has_next ? (const char*)g.A + (size_t)nxt.pm * tstep : cA; const char* nB = has_next ? (const char*)g.Bt + (size_t)nxt.pn * tstep : cB;
        for (int t = 0; t < nt; t += 2) {
            const bool last = (t == nt - 2);
            const char* a1 = cA + (size_t)(t + 1) * kstep;
            const char* a2 = last ? nA : cA + (size_t)(t + 2) * kstep; const char* b2 = last ? nB : cB + (size_t)(t + 2) * kstep;
            const char* a3 = a2 + kstep; const char* b3 = b2 + kstep;
            if (last && has_next) S.a_ready(nxt);
            if constexpr (SP2) {
            PG8_LDB(B0, 0, 0); PG8_LDB(B1, 0, 1); PG8_SCHED; PG8_LDA(At, 0, 0); PG8_STAGE(PG8_SA(1, 1), a1 + hstep, voffA);
            PG8_WAIT_V(8); PG8_WAIT_L(0); PG8_BAR; PG8_MMA(0, 0, At, B0); PG8_MMA(0, 1, At, B1); PG8_BAR; PG8_SCHED;
            PG8_LDA(At, 0, 1); PG8_STAGE(PG8_SB(0, 0), b2, voffB); PG8_STAGE(PG8_SB(0, 1), b2 + hstep, voffB); PG8_STAGE(PG8_SA(0, 0), a2, voffA);
            PG8_WAIT_V(8); PG8_WAIT_L(0); PG8_BAR; PG8_MMA(1, 0, At, B0); PG8_MMA(1, 1, At, B1); PG8_BAR; PG8_SCHED;
            PG8_LDB(B0, 1, 0); PG8_LDB(B1, 1, 1); PG8_SCHED; PG8_LDA(At, 1, 0); PG8_STAGE(PG8_SA(0, 1), a2 + hstep, voffA);
            PG8_WAIT_V(8); PG8_WAIT_L(0); PG8_BAR; PG8_MMA(0, 0, At, B0); PG8_MMA(0, 1, At, B1); PG8_BAR; PG8_SCHED;
            PG8_LDA(At, 1, 1); PG8_STAGE(PG8_SB(1, 0), b3, voffB); PG8_STAGE(PG8_SB(1, 1), b3 + hstep, voffB); PG8_STAGE(PG8_SA(1, 0), a3, voffA);
            PG8_WAIT_V(8); PG8_WAIT_L(0); PG8_BAR; PG8_MMA(1, 0, At, B0); PG8_MMA(1, 1, At, B1); PG8_BAR; PG8_SCHED;
            } else {
            PG8_LDB(B0, 0, 0); PG8_SCHED; PG8_LDA(At, 0, 0); PG8_STAGE(PG8_SA(1, 1), a1 + hstep, voffA);
            PG8_WAIT_L(8); PG8_BAR; PG8_WAIT_L(0); PG8_MMA(0, 0, At, B0); PG8_BAR; PG8_SCHED;
            PG8_LDB(B1, 0, 1); PG8_STAGE(PG8_SB(0, 0), b2, voffB);
            PG8_BAR; PG8_WAIT_L(0); PG8_MMA(0, 1, At, B1); PG8_BAR;
            PG8_LDA(At, 0, 1); PG8_STAGE(PG8_SA(0, 0), a2, voffA);
            PG8_BAR; PG8_WAIT_L(0); PG8_MMA(1, 0, At, B0); PG8_BAR; PG8_SCHED;
            PG8_STAGE(PG8_SB(0, 1), b2 + hstep, voffB);
            PG8_WAIT_V(6); PG8_BAR; PG8_MMA(1, 1, At, B1); PG8_BAR;
            PG8_LDB(B0, 1, 0); PG8_SCHED; PG8_LDA(At, 1, 0); PG8_STAGE(PG8_SA(0, 1), a2 + hstep, voffA);
            PG8_WAIT_L(8); PG8_BAR; PG8_WAIT_L(0); PG8_MMA(0, 0, At, B0); PG8_BAR; PG8_SCHED;
            PG8_LDB(B1, 1, 1); PG8_STAGE(PG8_SB(1, 0), b3, voffB);
            PG8_BAR; PG8_WAIT_L(0); PG8_MMA(0, 1, At, B1); PG8_BAR;
            PG8_LDA(At, 1, 1); PG8_STAGE(PG8_SA(1, 0), a3, voffA);
            PG8_BAR; PG8_WAIT_L(0); PG8_MMA(1, 0, At, B0); PG8_BAR; PG8_SCHED;
            PG8_STAGE(PG8_SB(1, 1), b3 + hstep, voffB);
            PG8_WAIT_V(6); PG8_BAR; PG8_MMA(1, 1, At, B1); PG8_BAR;
            }
        }
        if constexpr (ALIGN_EPI) { if (wr == 0) PG8_BAR; }
        if constexpr (!Epi::AFTER_DRAIN) { E(acc, cur, wr, wc, fr, fq); S.done(cur); }
        if (!has_next) break;
#pragma unroll
        for (int a = 0; a < 2; ++a)
#pragma unroll
            for (int b = 0; b < 2; ++b)
#pragma unroll
                for (int m = 0; m < 4; ++m)
#pragma unroll
                    for (int n = 0; n < 2; ++n) acc[a][b][m][n] = (f32x4){0.f, 0.f, 0.f, 0.f};
        cur = nxt; cA = nA; cB = nB; ++ui;
        if constexpr (ALIGN_EPI) { if (wr == 1) PG8_BAR; }
    }
    PG8_WAIT_V(0);
    if constexpr (!ALIGN_EPI) { if (wr == 0) PG8_BAR; }
    PG8_BAR;
#undef PG8_SA
#undef PG8_SB
#undef PG8_STAGE
#undef PG8_LDA
#undef PG8_LDB
#undef PG8_MMA
#undef PG8_WAIT_V
#undef PG8_WAIT_L
#undef PG8_BAR
#undef PG8_SCHED
}
}

constexpr int DM = 1024, DEPTH = 4, NTOK = 16384, NCTX = 8192;
constexpr int DIN = 4400, DINP = 4608;
constexpr int NSEQ = 40;
constexpr int C_AQ = 0, C_AK = 512, C_AV = 1024, C_AO = 1536, C_AZ = 2048, C_AG = 2560, C_BQ = 2576, C_BK = 2832, C_BV = 3088, C_BZ = 3344,
              C_CQ = 3600, C_CK = 3728, C_CV = 3856, C_CZ = 4112, C_CLR = 4368;
constexpr float EPS = 1e-6f;
constexpr size_t O_Y = 0, O_C = 16777216, O_N = O_C + 16777216, O_M = O_N + 131072, O_R = O_M + 1024, O_G = O_R + 4194304, O_END = O_G + 2097152;
constexpr size_t MiB = 1u << 20;
constexpr size_t WS_CTL = 0, CTL_ZERO_BYTES = 64 * 1024;
constexpr size_t WS_MOD = 1 * MiB;
constexpr size_t WS_WIN = 2 * MiB;
constexpr size_t WS_WOUT = 38 * MiB;
constexpr size_t WS_R1 = 46 * MiB;
constexpr size_t WS_R2 = 78 * MiB;
constexpr size_t WS_PROJ = 110 * MiB;
constexpr size_t WS_END = 254 * MiB;
constexpr int CW_QUEUE = 64;

constexpr int LDS_BYTES = 147456;
constexpr int NPHASE = 1 + DEPTH * 5 + 1;

__device__ __forceinline__ unsigned f2bf(float f) { unsigned u = __builtin_bit_cast(unsigned, f); return (u + 0x7fffu + ((u >> 16) & 1u)) >> 16; }
__device__ __forceinline__ unsigned pk2(float lo, float hi) { return f2bf(lo) | (f2bf(hi) << 16); }
__device__ __forceinline__ float bf2f(unsigned short b) { return __builtin_bit_cast(float, ((unsigned)b) << 16); }
__device__ __forceinline__ float bflo(unsigned u) { return __builtin_bit_cast(float, u << 16); }
__device__ __forceinline__ float bfhi(unsigned u) { return __builtin_bit_cast(float, u & 0xffff0000u); }
__device__ __forceinline__ float sigmoidf_(float x) { return 1.0f / (1.0f + __expf(-x)); }
__device__ __forceinline__ float siluf_(float x) { return x * sigmoidf_(x); }
__device__ __forceinline__ float logsigmoidf_(float x) { return fminf(x, 0.f) - log1pf(__expf(-fabsf(x))); }
__device__ __forceinline__ float wave_sum(float v) {
#pragma unroll
    for (int o = 1; o < 64; o <<= 1) v += __shfl_xor(v, o);
    return v;
}
__device__ __forceinline__ bf16x8 mk8(bf16x4 lo, bf16x4 hi) { return __builtin_shufflevector(lo, hi, 0, 1, 2, 3, 4, 5, 6, 7); }
__device__ __forceinline__ bf16x8 pack8(f32x4 a, f32x4 b) { u32x4 w; w.x = pk2(a[0], a[1]); w.y = pk2(a[2], a[3]); w.z = pk2(b[0], b[1]); w.w = pk2(b[2], b[3]); return __builtin_bit_cast(bf16x8, w); }
#define MFMA16(a, b, c) __builtin_amdgcn_mfma_f32_16x16x32_bf16((a), (b), (c), 0, 0, 0)

struct Args { const float* in[20]; float* out; unsigned char* ws; int ph_lo, ph_hi; };

struct Ctx {
    LAS unsigned char* lds; int tid, lane, wave, G, bid;
    const float *x_prompt, *x_sample, *st_C, *st_n, *st_m, *st_ret, *st_gla, *cvec, *c_ctx, *norm_g, *w_ada, *b_ada, *w_in, *gate_b, *ret_logit, *gla_w2, *gla_b2, *hn_g, *w_out, *final_g;
    float* out; unsigned* ctl; float* mod; bf16 *WinT, *WoutT, *R1, *R2, *PROJ;
};

#define FRESH_TID(F) do { int t_ = threadIdx.x; asm volatile("" : "+v"(t_)); (F).tid = t_; (F).lane = t_ & 63; (F).wave = __builtin_amdgcn_readfirstlane(t_ >> 6); } while (0)
__device__ __forceinline__ void seq_info(int s, int& row0, int& L) { if (s < 32) { row0 = s * 256; L = 256; } else { row0 = NCTX + (s - 32) * 1024; L = 1024; } }

__device__ __forceinline__ float col_scale_in(int n) {
    if (n >= C_AK && n < C_AV) return 0.08838834764831845f;
    if (n >= C_BK && n < C_BV) return 0.125f;
    if (n >= C_CK && n < C_CV) return 0.17677669529663687f;
    return 1.0f;
}
__device__ __forceinline__ void p0_transpose_item(const float* W, int ldn, int nvalid, bool scale_in, bf16* WT, LAS float* scr, int kb, int nb, int lane) {
    const int k0 = 64 * kb, n0 = 32 * nb;
    const int n = n0 + (lane & 31); const float sc = scale_in ? col_scale_in(n) : 1.0f;
#pragma unroll 8
    for (int i = 0; i < 32; ++i) { const int kk = 2 * i + (lane >> 5); scr[kk * 33 + (lane & 31)] = (n < nvalid) ? W[(size_t)(k0 + kk) * ldn + n] * sc : 0.f; }
    asm volatile("s_waitcnt lgkmcnt(0)" ::: "memory");
    const int c = lane & 7;
#pragma unroll
    for (int j = 0; j < 4; ++j) { const int nn = (lane >> 3) + 8 * j; const LAS float* s = scr + (8 * c) * 33 + nn;
        u32x4 o; o.x = pk2(s[0 * 33], s[1 * 33]); o.y = pk2(s[2 * 33], s[3 * 33]); o.z = pk2(s[4 * 33], s[5 * 33]); o.w = pk2(s[6 * 33], s[7 * 33]);
        *(u32x4*)(WT + (size_t)(n0 + nn) * 1024 + k0 + 8 * c) = o; }
    asm volatile("s_waitcnt lgkmcnt(0)" ::: "memory");
}
__device__ __forceinline__ void p0_prologue(Ctx& F) {
    FRESH_TID(F);
    LAS float* scr = (LAS float*)(F.lds + F.wave * 8448);
    const int gw = F.bid * 8 + F.wave, NGW = F.G * 8;
    constexpr int I_IN = 16 * (DINP / 32), I_OUT = 16 * 32, I_L = I_IN + I_OUT;
    for (int it = gw; it < DEPTH * I_L; it += NGW) {
        const int l = it / I_L; int r = it % I_L;
        if (r < I_IN) p0_transpose_item(F.w_in + (size_t)l * 1024 * DIN, DIN, DIN, true, F.WinT + (size_t)l * DINP * 1024, scr, r / (DINP / 32), r % (DINP / 32), F.lane);
        else { r -= I_IN; p0_transpose_item(F.w_out + (size_t)l * 1024 * 1024, 1024, 1024, false, F.WoutT + (size_t)l * 1024 * 1024, scr, r / 32, r % 32, F.lane); }
    }
    __syncthreads();
    LAS float* sl = (LAS float*)(F.lds + 69632);
    LAS float* red = (LAS float*)(F.lds + 106496);
    bool have_sl = false;
    for (int it = F.bid; it < DEPTH * 48; it += F.G) {
        if (!have_sl) {
            for (int i = F.tid; i < 9 * 1024; i += 512) { const int r = i >> 10, k = i & 1023; const float v = r == 0 ? F.c_ctx[k] : F.cvec[(r - 1) * 1024 + k]; sl[i] = siluf_(v); }
            have_sl = true; __syncthreads();
        }
        const int l = it / 48, e0 = (it % 48) * 64, c = F.tid & 63, kg = F.tid >> 6;
        const float* wp = F.w_ada + ((size_t)l * 1024 + kg * 128) * 3072 + e0 + c;
        float acc[9];
#pragma unroll
        for (int r = 0; r < 9; ++r) acc[r] = 0.f;
#pragma unroll 4
        for (int k = 0; k < 128; ++k) { const float w = wp[(size_t)k * 3072];
#pragma unroll
            for (int r = 0; r < 9; ++r) acc[r] += sl[r * 1024 + kg * 128 + k] * w; }
#pragma unroll
        for (int r = 0; r < 9; ++r) red[(kg * 9 + r) * 64 + c] = acc[r];
        __syncthreads();
        for (int o = F.tid; o < 9 * 64; o += 512) { const int r = o >> 6, cc = o & 63; float s = F.b_ada[l * 3072 + e0 + cc];
#pragma unroll
            for (int g = 0; g < 8; ++g) s += red[(g * 9 + r) * 64 + cc];
            F.mod[((size_t)l * 9 + r) * 3072 + e0 + cc] = s; }
        __syncthreads();
    }
}

__device__ __forceinline__ void hprep_phase(Ctx& F, int l) {
    FRESH_TID(F);
    const int gw = F.bid * 8 + F.wave, NGW = F.G * 8;
    const float* g = F.norm_g + l * 1024;
    for (int m = gw; m < NTOK; m += NGW) {
        const float* xrow = (l == 0) ? (m < NCTX ? F.x_prompt + (size_t)m * 1024 : F.x_sample + (size_t)(m - NCTX) * 1024) : F.out + (size_t)m * 1024;
        const int mr = m < NCTX ? 0 : 1 + ((m - NCTX) >> 10);
        const float* md = F.mod + ((size_t)l * 9 + mr) * 3072;
        const f32x4* xr = (const f32x4*)xrow + F.lane;
        f32x4 v[4]; float s = 0.f;
#pragma unroll
        for (int j = 0; j < 4; ++j) { v[j] = xr[64 * j]; s += (v[j].x * v[j].x + v[j].y * v[j].y) + (v[j].z * v[j].z + v[j].w * v[j].w); }
        const float rstd = 1.0f / sqrtf(wave_sum(s) * (1.f / 1024.f) + EPS);
        unsigned long long* o8 = (unsigned long long*)(F.R1 + (size_t)m * 1024) + F.lane;
#pragma unroll
        for (int j = 0; j < 4; ++j) { const int c = 4 * F.lane + 256 * j;
            const f32x4 gg = *(const f32x4*)(g + c), sh = *(const f32x4*)(md + c), sc = *(const f32x4*)(md + 1024 + c);
            const f32x4 h = v[j] * rstd * gg * (sc + 1.0f) + sh;
            o8[64 * j] = (unsigned long long)pk2(h.x, h.y) | ((unsigned long long)pk2(h.z, h.w) << 32); }
    }
}
__device__ __forceinline__ void yprep_phase(Ctx& F, int l) {
    FRESH_TID(F);
    const int gw = F.bid * 8 + F.wave, NGW = F.G * 8;
    const float* hg = F.hn_g + l * 1024;
    const int lane = F.lane, c0 = 16 * lane;
    for (int m = gw; m < NTOK; m += NGW) {
        const bf16* pr = F.PROJ + (size_t)m * DINP;
        const u32x4* hf = (const u32x4*)(F.R1 + (size_t)m * 1024 + c0); const u32x4* hb = (const u32x4*)(F.R2 + (size_t)m * 1024 + c0);
        const int zc = lane < 32 ? C_AZ + c0 : (lane < 48 ? C_BZ + (c0 - 512) : C_CZ + (c0 - 768));
        const u32x4* zp = (const u32x4*)(pr + zc);
        const u32x4* op = (const u32x4*)(pr + C_AO + (lane < 32 ? c0 : 0));
        float v[16], z[16];
#pragma unroll
        for (int hh = 0; hh < 2; ++hh) { const u32x4 a = hf[hh], b = hb[hh], zz = zp[hh], oo = op[hh];
#pragma unroll
            for (int j = 0; j < 4; ++j) { const unsigned ua = a[j], ub = b[j], uz = zz[j], uo = oo[j];
                float v0 = bflo(ua) + bflo(ub), v1 = bfhi(ua) + bfhi(ub);
                if (lane < 32) { v0 *= sigmoidf_(bflo(uo)); v1 *= sigmoidf_(bfhi(uo)); }
                v[hh * 8 + 2 * j] = v0; v[hh * 8 + 2 * j + 1] = v1; z[hh * 8 + 2 * j] = bflo(uz); z[hh * 8 + 2 * j + 1] = bfhi(uz); } }
        float ss = 0.f;
#pragma unroll
        for (int j = 0; j < 16; ++j) ss += v[j] * v[j];
        ss += __shfl_xor(ss, 1); ss += __shfl_xor(ss, 2);
        const float ss8 = ss + __shfl_xor(ss, 4);
        const float rs = lane < 32 ? 1.0f / sqrtf(ss8 * (1.f / 128.f) + EPS) : 1.0f / sqrtf(ss * (1.f / 64.f) + EPS);
        u32x4 o[2];
#pragma unroll
        for (int hh = 0; hh < 2; ++hh)
#pragma unroll
            for (int j = 0; j < 4; ++j) { const int i0 = hh * 8 + 2 * j;
                const float y0 = v[i0] * rs * hg[c0 + i0] * siluf_(z[i0]), y1 = v[i0 + 1] * rs * hg[c0 + i0 + 1] * siluf_(z[i0 + 1]);
                o[hh][j] = pk2(y0, y1); }
        u32x4* yo = (u32x4*)(F.R1 + (size_t)m * 1024 + c0);
        yo[0] = o[0]; yo[1] = o[1];
    }
}
__device__ __forceinline__ void final_phase(Ctx& F) {
    FRESH_TID(F);
    const int gw = F.bid * 8 + F.wave, NGW = F.G * 8;
    for (int m = gw; m < NTOK; m += NGW) {
        f32x4* xr = (f32x4*)(F.out + (size_t)m * 1024) + F.lane;
        f32x4 v[4]; float s = 0.f;
#pragma unroll
        for (int j = 0; j < 4; ++j) { v[j] = xr[64 * j]; s += (v[j].x * v[j].x + v[j].y * v[j].y) + (v[j].z * v[j].z + v[j].w * v[j].w); }
        const float rstd = 1.0f / sqrtf(wave_sum(s) * (1.f / 1024.f) + EPS);
#pragma unroll
        for (int j = 0; j < 4; ++j) { const f32x4 gg = *(const f32x4*)(F.final_g + 4 * F.lane + 256 * j); xr[64 * j] = v[j] * rstd * gg; }
    }
}

constexpr int A_QS = 0, A_KS = 17408, A_KGT = 34816, A_VT = 53248, A_PS = 71680, A_TAB = 80896;
constexpr int T_U = 0, T_MX = 64, T_WA = 128, T_EM = 192, T_DENP = 256, T_QN = 512, T_NV = 576;

__device__ __forceinline__ void mlstm_unit(Ctx& F, int l, int s, int h, int dir) {
    FRESH_TID(F);
    const int tid = F.tid, lane = F.lane, w = F.wave, c = lane & 15, q = lane >> 4;
    LAS bf16* Qs = (LAS bf16*)(F.lds + A_QS); LAS bf16* Ks = (LAS bf16*)(F.lds + A_KS); LAS bf16* KgT = (LAS bf16*)(F.lds + A_KGT);
    LAS bf16* VT = (LAS bf16*)(F.lds + A_VT); LAS bf16* Ps = (LAS bf16*)(F.lds + A_PS); LAS float* tab = (LAS float*)(F.lds + A_TAB);
    int row0, L; seq_info(s, row0, L);
    const int nch = L / 64, e0 = 16 * w;
    const float bi = F.gate_b[l * 16 + dir * 8 + h], bfg = F.gate_b[l * 16 + dir * 8 + 4 + h];
    f32x4 st[8]; float m_prev;
    if (s >= 32) {
        const size_t sb = (((size_t)(s - 32) * DEPTH + l) * 2 + dir) * 4 + h;
        const float* C0 = F.st_C + sb * 16384;
#pragma unroll
        for (int t = 0; t < 8; ++t)
#pragma unroll
            for (int r = 0; r < 4; ++r) st[t][r] = C0[(size_t)(16 * t + 4 * q + r) * 128 + e0 + c];
        if (tid < 128) tab[T_NV + tid] = F.st_n[sb * 128 + tid];
        m_prev = F.st_m[sb];
    } else {
#pragma unroll
        for (int t = 0; t < 8; ++t) st[t] = (f32x4){0.f, 0.f, 0.f, 0.f};
        if (tid < 128) tab[T_NV + tid] = 0.f;
        m_prev = 0.f;
    }
    bf16* HX = dir ? F.R2 : F.R1;
    for (int n = 0; n < nch; ++n) {
        const int posl = dir ? (L - 1 - (64 * n + lane)) : (64 * n + lane);
        const bf16* gp = F.PROJ + (size_t)(row0 + posl) * DINP + C_AG + dir * 8 + h;
        const float ic = bf2f(gp[0]) + bi, fp = bf2f(gp[4]) + bfg;
        float Fc = logsigmoidf_(fp);
#pragma unroll
        for (int o = 1; o < 64; o <<= 1) { const float t = __shfl_up(Fc, o); if (lane >= o) Fc += t; }
        const float u = ic - Fc;
        float pm = u;
#pragma unroll
        for (int o = 1; o < 64; o <<= 1) { const float t = __shfl_up(pm, o); if (lane >= o) pm = fmaxf(pm, t); }
        const float F_last = __shfl(Fc, 63), pmL = __shfl(pm, 63);
        const float mx = fmaxf(m_prev, pm), gm = F_last + pmL, m_new = fmaxf(F_last + m_prev, gm);
        const float a_dec = __expf(F_last + m_prev - m_new);
        const float gate = __expf(F_last + u - m_new);
        if (w == 0) { tab[T_U + lane] = u; tab[T_MX + lane] = mx; tab[T_WA + lane] = __expf(m_prev - mx); tab[T_EM + lane] = __expf(-(Fc + mx)); }
#pragma unroll
        for (int i = 0; i < 2; ++i) {
            const int p = tid + 512 * i, r = p >> 4, cp = (p & 15) * 8;
            const int pos = dir ? (L - 1 - (64 * n + r)) : (64 * n + r);
            const bf16* src = F.PROJ + (size_t)(row0 + pos) * DINP + h * 128 + cp;
            const u32x4 qv = *(const u32x4*)(src + C_AQ), kv = *(const u32x4*)(src + C_AK), vv = *(const u32x4*)(src + C_AV);
            *(LAS u32x4*)(Qs + r * 136 + cp) = qv; *(LAS u32x4*)(Ks + r * 136 + cp) = kv;
            const float gr = __shfl(gate, r);
#pragma unroll
            for (int j = 0; j < 4; ++j) {
                KgT[(cp + 2 * j) * 72 + r] = (bf16)f2bf(bflo(kv[j]) * gr); KgT[(cp + 2 * j + 1) * 72 + r] = (bf16)f2bf(bfhi(kv[j]) * gr);
                VT[(cp + 2 * j) * 72 + r] = (bf16)(vv[j] & 0xffffu); VT[(cp + 2 * j + 1) * 72 + r] = (bf16)(vv[j] >> 16); }
        }
        __syncthreads();
#pragma unroll
        for (int x = 0; x < 2; ++x) {
            const int tix = w + 8 * x, jt = tix & 3, it = tix >> 2;
            f32x4 acc = (f32x4){0.f, 0.f, 0.f, 0.f};
            if (jt <= it) {
#pragma unroll
                for (int k = 0; k < 4; ++k) { const bf16x8 a = *(const LAS bf16x8*)(Ks + (16 * jt + c) * 136 + 32 * k + 8 * q), b = *(const LAS bf16x8*)(Qs + (16 * it + c) * 136 + 32 * k + 8 * q);
                    acc = MFMA16(a, b, acc); }
            }
            const int i = 16 * it + c, j0 = 16 * jt + 4 * q;
            const float mxi = tab[T_MX + i]; const f32x4 uj = *(const LAS f32x4*)(tab + T_U + j0);
            float p[4], ds = 0.f;
#pragma unroll
            for (int r = 0; r < 4; ++r) { p[r] = (j0 + r <= i) ? acc[r] * __expf(uj[r] - mxi) : 0.f; ds += p[r]; }
            ds += __shfl_xor(ds, 16); ds += __shfl_xor(ds, 32);
            if (q == 0) tab[T_DENP + jt * 64 + i] = ds;
            u32x2 pw; pw.x = pk2(p[0], p[1]); pw.y = pk2(p[2], p[3]);
            *(LAS u32x2*)(Ps + i * 72 + j0) = pw;
        }
        {
            const int i = tid >> 3, d0 = (tid & 7) * 16;
            const u32x4 qa = *(const LAS u32x4*)(Qs + i * 136 + d0), qb = *(const LAS u32x4*)(Qs + i * 136 + d0 + 8);
            float sacc = 0.f;
#pragma unroll
            for (int j = 0; j < 4; ++j) { sacc += bflo(qa[j]) * tab[T_NV + d0 + 2 * j] + bfhi(qa[j]) * tab[T_NV + d0 + 2 * j + 1];
                sacc += bflo(qb[j]) * tab[T_NV + d0 + 8 + 2 * j] + bfhi(qb[j]) * tab[T_NV + d0 + 8 + 2 * j + 1]; }
            sacc += __shfl_xor(sacc, 1); sacc += __shfl_xor(sacc, 2); sacc += __shfl_xor(sacc, 4);
            if ((tid & 7) == 0) tab[T_QN + i] = sacc;
        }
        __syncthreads();
        bf16x8 cf[4];
#pragma unroll
        for (int k = 0; k < 4; ++k) cf[k] = pack8(st[2 * k], st[2 * k + 1]);
#pragma unroll
        for (int it = 0; it < 4; ++it) {
            const int i = 16 * it + c;
            f32x4 ao = (f32x4){0.f, 0.f, 0.f, 0.f}, ai = (f32x4){0.f, 0.f, 0.f, 0.f};
#pragma unroll
            for (int k = 0; k < 2; ++k) if (k == 0 || it >= 2) {
                const bf16x8 a = *(const LAS bf16x8*)(VT + (e0 + c) * 72 + 32 * k + 8 * q), b = *(const LAS bf16x8*)(Ps + i * 72 + 32 * k + 8 * q);
                ao = MFMA16(a, b, ao); }
#pragma unroll
            for (int k = 0; k < 4; ++k) {
                const bf16x4 lo = *(const LAS bf16x4*)(Qs + i * 136 + 32 * k + 4 * q), hi = *(const LAS bf16x4*)(Qs + i * 136 + 32 * k + 16 + 4 * q);
                ai = MFMA16(cf[k], mk8(lo, hi), ai); }
            const float wai = tab[T_WA + i];
            const float den = tab[T_DENP + i] + tab[T_DENP + 64 + i] + tab[T_DENP + 128 + i] + tab[T_DENP + 192 + i] + wai * tab[T_QN + i];
            const float rd = 1.0f / fmaxf(fabsf(den), tab[T_EM + i]);
            const f32x4 hv = (ao + ai * wai) * rd;
            const int pos = dir ? (L - 1 - (64 * n + i)) : (64 * n + i);
            u32x2 o; o.x = pk2(hv[0], hv[1]); o.y = pk2(hv[2], hv[3]);
            *(u32x2*)(HX + (size_t)(row0 + pos) * 1024 + h * 128 + e0 + 4 * q) = o;
        }
#pragma unroll
        for (int t = 0; t < 8; ++t) {
            st[t] = st[t] * a_dec;
#pragma unroll
            for (int k = 0; k < 2; ++k) { const bf16x8 a = *(const LAS bf16x8*)(KgT + (16 * t + c) * 72 + 32 * k + 8 * q), b = *(const LAS bf16x8*)(VT + (e0 + c) * 72 + 32 * k + 8 * q);
                st[t] = MFMA16(a, b, st[t]); }
        }
        if (tid < 128) { float sacc = 0.f;
#pragma unroll
            for (int k = 0; k < 8; ++k) { const u32x4 kv = *(const LAS u32x4*)(KgT + tid * 72 + 8 * k);
#pragma unroll
                for (int j = 0; j < 4; ++j) sacc += bflo(kv[j]) + bfhi(kv[j]); }
            tab[T_NV + tid] = a_dec * tab[T_NV + tid] + sacc; }
        m_prev = m_new;
        __syncthreads();
    }
    if (s < 32) {
        const size_t sb = (((size_t)s * DEPTH + l) * 2 + dir) * 4 + h;
        float* Co = F.out + O_C + sb * 16384;
#pragma unroll
        for (int t = 0; t < 8; ++t)
#pragma unroll
            for (int r = 0; r < 4; ++r) Co[(size_t)(16 * t + 4 * q + r) * 128 + e0 + c] = st[t][r];
        if (tid < 128) F.out[O_N + sb * 128 + tid] = tab[T_NV + tid];
        if (tid == 0) F.out[O_M + sb] = m_prev;
    }
    __syncthreads();
}

__device__ __forceinline__ void ret_unit(Ctx& F, int l, int s, int h) {
    FRESH_TID(F);
    const int tid = F.tid, lane = F.lane, dir = F.wave >> 2, wl = F.wave & 3, tl = tid & 255, c = lane & 15, q = lane >> 4;
    LAS bf16* base = (LAS bf16*)(F.lds + dir * 46080);
    LAS bf16* Qs = base; LAS bf16* Ks = base + 4608; LAS bf16* KgT = base + 9216; LAS bf16* VT = base + 13824; LAS bf16* Ps = base + 18432;
    int row0, L; seq_info(s, row0, L);
    const int nch = L / 64, e0 = 16 * wl;
    const float lg2 = logsigmoidf_(F.ret_logit[(l * 2 + dir) * 4 + h]) * 1.4426950408889634f;
    const bool rot = s >= 32;
    f32x4 st[4];
    if (s >= 32) {
        const float* S0 = F.st_ret + ((((size_t)(s - 32) * DEPTH + l) * 2 + dir) * 4 + h) * 4096;
#pragma unroll
        for (int t = 0; t < 4; ++t)
#pragma unroll
            for (int r = 0; r < 4; ++r) st[t][r] = S0[(size_t)(16 * t + 4 * q + r) * 64 + e0 + c];
    } else {
#pragma unroll
        for (int t = 0; t < 4; ++t) st[t] = (f32x4){0.f, 0.f, 0.f, 0.f};
    }
    bf16* HX = dir ? F.R2 : F.R1;
    const float g64 = exp2f(64.f * lg2);
    for (int n = 0; n < nch; ++n) {
        {
            const int r = tl >> 2, cp = (tl & 3) * 8;
            const int pos = dir ? (L - 1 - (64 * n + r)) : (64 * n + r);
            const bf16* src = F.PROJ + (size_t)(row0 + pos) * DINP + h * 64 + cp;
            const u32x4 q1 = *(const u32x4*)(src + C_BQ), q2 = *(const u32x4*)(src + C_BQ + 32), k1 = *(const u32x4*)(src + C_BK), k2 = *(const u32x4*)(src + C_BK + 32);
            const u32x4 v1 = *(const u32x4*)(src + C_BV), v2 = *(const u32x4*)(src + C_BV + 32);
            float qa[8], qb[8], ka[8], kb[8];
#pragma unroll
            for (int j = 0; j < 4; ++j) { qa[2 * j] = bflo(q1[j]); qa[2 * j + 1] = bfhi(q1[j]); qb[2 * j] = bflo(q2[j]); qb[2 * j + 1] = bfhi(q2[j]);
                ka[2 * j] = bflo(k1[j]); ka[2 * j + 1] = bfhi(k1[j]); kb[2 * j] = bflo(k2[j]); kb[2 * j + 1] = bfhi(k2[j]); }
            if (rot) {
                const float prow = (float)(pos >> 6), pcol = (float)(pos & 63);
#pragma unroll
                for (int x = 0; x < 8; ++x) { const int f = cp + x;
                    const float fr = exp2f(-(float)(f & 15) * 0.8304820237218406f);
                    const float ang = (f < 16 ? prow : pcol) * fr;
                    const float cs = __cosf(ang), sn = __sinf(ang);
                    const float t1 = qa[x], t2 = qb[x]; qa[x] = t1 * cs - t2 * sn; qb[x] = t1 * sn + t2 * cs;
                    const float s1 = ka[x], s2 = kb[x]; ka[x] = s1 * cs - s2 * sn; kb[x] = s1 * sn + s2 * cs; }
            }
            u32x4 o;
            o.x = pk2(qa[0], qa[1]); o.y = pk2(qa[2], qa[3]); o.z = pk2(qa[4], qa[5]); o.w = pk2(qa[6], qa[7]); *(LAS u32x4*)(Qs + r * 72 + cp) = o;
            o.x = pk2(qb[0], qb[1]); o.y = pk2(qb[2], qb[3]); o.z = pk2(qb[4], qb[5]); o.w = pk2(qb[6], qb[7]); *(LAS u32x4*)(Qs + r * 72 + cp + 32) = o;
            o.x = pk2(ka[0], ka[1]); o.y = pk2(ka[2], ka[3]); o.z = pk2(ka[4], ka[5]); o.w = pk2(ka[6], ka[7]); *(LAS u32x4*)(Ks + r * 72 + cp) = o;
            o.x = pk2(kb[0], kb[1]); o.y = pk2(kb[2], kb[3]); o.z = pk2(kb[4], kb[5]); o.w = pk2(kb[6], kb[7]); *(LAS u32x4*)(Ks + r * 72 + cp + 32) = o;
            const float gr = exp2f((float)(63 - r) * lg2);
#pragma unroll
            for (int x = 0; x < 8; ++x) { KgT[(cp + x) * 72 + r] = (bf16)f2bf(ka[x] * gr); KgT[(cp + 32 + x) * 72 + r] = (bf16)f2bf(kb[x] * gr); }
#pragma unroll
            for (int j = 0; j < 4; ++j) { VT[(cp + 2 * j) * 72 + r] = (bf16)(v1[j] & 0xffffu); VT[(cp + 2 * j + 1) * 72 + r] = (bf16)(v1[j] >> 16);
                VT[(cp + 32 + 2 * j) * 72 + r] = (bf16)(v2[j] & 0xffffu); VT[(cp + 32 + 2 * j + 1) * 72 + r] = (bf16)(v2[j] >> 16); }
        }
        __syncthreads();
#pragma unroll
        for (int it = 0; it < 4; ++it) {
            const int jt = wl;
            f32x4 acc = (f32x4){0.f, 0.f, 0.f, 0.f};
            if (jt <= it) {
#pragma unroll
                for (int k = 0; k < 2; ++k) { const bf16x8 a = *(const LAS bf16x8*)(Ks + (16 * jt + c) * 72 + 32 * k + 8 * q), b = *(const LAS bf16x8*)(Qs + (16 * it + c) * 72 + 32 * k + 8 * q);
                    acc = MFMA16(a, b, acc); }
            }
            const int i = 16 * it + c, j0 = 16 * jt + 4 * q;
            float p[4];
#pragma unroll
            for (int r = 0; r < 4; ++r) p[r] = (j0 + r <= i) ? acc[r] * exp2f((float)(i - j0 - r) * lg2) : 0.f;
            u32x2 pw; pw.x = pk2(p[0], p[1]); pw.y = pk2(p[2], p[3]);
            *(LAS u32x2*)(Ps + i * 72 + j0) = pw;
        }
        __syncthreads();
        bf16x8 cf[2];
#pragma unroll
        for (int k = 0; k < 2; ++k) cf[k] = pack8(st[2 * k], st[2 * k + 1]);
#pragma unroll
        for (int it = 0; it < 4; ++it) {
            const int i = 16 * it + c;
            f32x4 ao = (f32x4){0.f, 0.f, 0.f, 0.f}, ai = (f32x4){0.f, 0.f, 0.f, 0.f};
#pragma unroll
            for (int k = 0; k < 2; ++k) if (k == 0 || it >= 2) {
                const bf16x8 a = *(const LAS bf16x8*)(VT + (e0 + c) * 72 + 32 * k + 8 * q), b = *(const LAS bf16x8*)(Ps + i * 72 + 32 * k + 8 * q);
                ao = MFMA16(a, b, ao); }
#pragma unroll
            for (int k = 0; k < 2; ++k) {
                const bf16x4 lo = *(const LAS bf16x4*)(Qs + i * 72 + 32 * k + 4 * q), hi = *(const LAS bf16x4*)(Qs + i * 72 + 32 * k + 16 + 4 * q);
                ai = MFMA16(cf[k], mk8(lo, hi), ai); }
            const float wq = exp2f((float)(i + 1) * lg2);
            const f32x4 hv = ao + ai * wq;
            const int pos = dir ? (L - 1 - (64 * n + i)) : (64 * n + i);
            u32x2 o; o.x = pk2(hv[0], hv[1]); o.y = pk2(hv[2], hv[3]);
            *(u32x2*)(HX + (size_t)(row0 + pos) * 1024 + 512 + h * 64 + e0 + 4 * q) = o;
        }
#pragma unroll
        for (int t = 0; t < 4; ++t) {
            st[t] = st[t] * g64;
#pragma unroll
            for (int k = 0; k < 2; ++k) { const bf16x8 a = *(const LAS bf16x8*)(KgT + (16 * t + c) * 72 + 32 * k + 8 * q), b = *(const LAS bf16x8*)(VT + (e0 + c) * 72 + 32 * k + 8 * q);
                st[t] = MFMA16(a, b, st[t]); }
        }
        __syncthreads();
    }
    if (s < 32) {
        float* So = F.out + O_R + ((((size_t)s * DEPTH + l) * 2 + dir) * 4 + h) * 4096;
#pragma unroll
        for (int t = 0; t < 4; ++t)
#pragma unroll
            for (int r = 0; r < 4; ++r) So[(size_t)(16 * t + 4 * q + r) * 64 + e0 + c] = st[t][r];
    }
}

__device__ __forceinline__ void gla_unit(Ctx& F, int l, int s, int h) {
    FRESH_TID(F);
    const int tid = F.tid, lane = F.lane, dir = F.wave >> 2, wl = F.wave & 3, tl = tid & 255, c = lane & 15, q = lane >> 4;
    LAS bf16* base = (LAS bf16*)(F.lds + dir * 16384);
    LAS bf16* Qs = base; LAS bf16* Ks = base + 1280; LAS bf16* KgT = base + 2560; LAS bf16* VT = base + 3840; LAS bf16* Ps = base + 6400;
    LAS float* fb = (LAS float*)(F.lds + 32768 + dir * 4096);
    LAS float* clrs = fb; LAS float* tot = fb + 512; LAS float* dec = fb + 768;
    int row0, L; seq_info(s, row0, L);
    const int nch = L / 32, e0 = 16 * wl;
    const int d = tl & 31, jg = tl >> 5;
    float w2r[16];
#pragma unroll
    for (int r = 0; r < 16; ++r) w2r[r] = F.gla_w2[(((size_t)l * 2 + dir) * 16 + r) * 128 + h * 32 + d];
    const float b2v = F.gla_b2[((size_t)l * 2 + dir) * 128 + h * 32 + d];
    f32x4 st[2];
    if (s >= 32) {
        const float* S0 = F.st_gla + ((((size_t)(s - 32) * DEPTH + l) * 2 + dir) * 4 + h) * 2048;
#pragma unroll
        for (int t = 0; t < 2; ++t)
#pragma unroll
            for (int r = 0; r < 4; ++r) st[t][r] = S0[(size_t)(16 * t + 4 * q + r) * 64 + e0 + c];
    } else { st[0] = (f32x4){0.f, 0.f, 0.f, 0.f}; st[1] = st[0]; }
    bf16* HX = dir ? F.R2 : F.R1;
    for (int n = 0; n < nch; ++n) {
        if (tl < 64) { const int r = tl >> 1, hp = (tl & 1) * 8;
            const int pos = dir ? (L - 1 - (32 * n + r)) : (32 * n + r);
            const u32x4 cv = *(const u32x4*)(F.PROJ + (size_t)(row0 + pos) * DINP + C_CLR + dir * 16 + hp);
#pragma unroll
            for (int j = 0; j < 4; ++j) { clrs[r * 16 + hp + 2 * j] = bflo(cv[j]); clrs[r * 16 + hp + 2 * j + 1] = bfhi(cv[j]); } }
        {
            const int r = tl >> 3, cp = (tl & 7) * 8;
            const int pos = dir ? (L - 1 - (32 * n + r)) : (32 * n + r);
            const u32x4 vv = *(const u32x4*)(F.PROJ + (size_t)(row0 + pos) * DINP + C_CV + h * 64 + cp);
#pragma unroll
            for (int j = 0; j < 4; ++j) { VT[(cp + 2 * j) * 40 + r] = (bf16)(vv[j] & 0xffffu); VT[(cp + 2 * j + 1) * 40 + r] = (bf16)(vv[j] >> 16); }
        }
        __syncthreads();
        float pb[4], qv[4], kv[4];
        {
            float run = 0.f;
#pragma unroll
            for (int x = 0; x < 4; ++x) { const int j = 4 * jg + x; float xx = b2v;
#pragma unroll
                for (int r = 0; r < 16; ++r) xx += clrs[j * 16 + r] * w2r[r];
                run += logsigmoidf_(xx) * 0.0625f; pb[x] = run;
                const int pos = dir ? (L - 1 - (32 * n + j)) : (32 * n + j);
                const bf16* src = F.PROJ + (size_t)(row0 + pos) * DINP + h * 32 + d;
                qv[x] = bf2f(src[C_CQ]); kv[x] = bf2f(src[C_CK]); }
            tot[jg * 32 + d] = run;
        }
        __syncthreads();
        {
            float off = 0.f, blast = 0.f;
#pragma unroll
            for (int g = 0; g < 8; ++g) { const float t = tot[g * 32 + d]; if (g < jg) off += t; blast += t; }
            float ku[4];
#pragma unroll
            for (int x = 0; x < 4; ++x) { const int j = 4 * jg + x; const float b = off + pb[x];
                Qs[j * 40 + d] = (bf16)f2bf(qv[x] * __expf(b)); Ks[j * 40 + d] = (bf16)f2bf(kv[x] * __expf(-b)); ku[x] = kv[x] * __expf(blast - b); }
            u32x2 kw; kw.x = pk2(ku[0], ku[1]); kw.y = pk2(ku[2], ku[3]);
            *(LAS u32x2*)(KgT + d * 40 + 4 * jg) = kw;
            if (jg == 0) dec[d] = __expf(blast);
        }
        __syncthreads();
        {
            const int jt = wl & 1, it = wl >> 1;
            f32x4 acc = (f32x4){0.f, 0.f, 0.f, 0.f};
            if (jt <= it) { const bf16x8 a = *(const LAS bf16x8*)(Ks + (16 * jt + c) * 40 + 8 * q), b = *(const LAS bf16x8*)(Qs + (16 * it + c) * 40 + 8 * q); acc = MFMA16(a, b, acc); }
            const int i = 16 * it + c, j0 = 16 * jt + 4 * q;
            float p[4];
#pragma unroll
            for (int r = 0; r < 4; ++r) p[r] = (j0 + r <= i) ? acc[r] : 0.f;
            u32x2 pw; pw.x = pk2(p[0], p[1]); pw.y = pk2(p[2], p[3]);
            *(LAS u32x2*)(Ps + i * 40 + j0) = pw;
        }
        __syncthreads();
        const bf16x8 cf = pack8(st[0], st[1]);
#pragma unroll
        for (int it = 0; it < 2; ++it) {
            const int i = 16 * it + c;
            f32x4 ao = (f32x4){0.f, 0.f, 0.f, 0.f};
            { const bf16x8 a = *(const LAS bf16x8*)(VT + (e0 + c) * 40 + 8 * q), b = *(const LAS bf16x8*)(Ps + i * 40 + 8 * q); ao = MFMA16(a, b, ao); }
            { const bf16x4 lo = *(const LAS bf16x4*)(Qs + i * 40 + 4 * q), hi = *(const LAS bf16x4*)(Qs + i * 40 + 16 + 4 * q); ao = MFMA16(cf, mk8(lo, hi), ao); }
            const int pos = dir ? (L - 1 - (32 * n + i)) : (32 * n + i);
            u32x2 o; o.x = pk2(ao[0], ao[1]); o.y = pk2(ao[2], ao[3]);
            *(u32x2*)(HX + (size_t)(row0 + pos) * 1024 + 768 + h * 64 + e0 + 4 * q) = o;
        }
#pragma unroll
        for (int t = 0; t < 2; ++t) {
            const f32x4 dv = *(const LAS f32x4*)(dec + 16 * t + 4 * q);
            st[t] = st[t] * dv;
            const bf16x8 a = *(const LAS bf16x8*)(KgT + (16 * t + c) * 40 + 8 * q), b = *(const LAS bf16x8*)(VT + (e0 + c) * 40 + 8 * q);
            st[t] = MFMA16(a, b, st[t]);
        }
        __syncthreads();
    }
    if (s < 32) {
        float* So = F.out + O_G + ((((size_t)s * DEPTH + l) * 2 + dir) * 4 + h) * 2048;
#pragma unroll
        for (int t = 0; t < 2; ++t)
#pragma unroll
            for (int r = 0; r < 4; ++r) So[(size_t)(16 * t + 4 * q + r) * 64 + e0 + c] = st[t][r];
    }
}

__device__ __forceinline__ void mixer_phase(Ctx& F, int l) {
    LAS int* slot = (LAS int*)(F.lds + 147456 - 64);
    unsigned* qc = F.ctl + CW_QUEUE + 64 * l;
    for (;;) {
        if (F.tid == 0) slot[0] = (int)__hip_atomic_fetch_add(qc, 1u, __ATOMIC_RELAXED, __HIP_MEMORY_SCOPE_AGENT);
        __syncthreads();
        const int u = slot[0];
        __syncthreads();
        if (u >= 640) break;
        if (u < 64) { mlstm_unit(F, l, 32 + (u >> 3), (u >> 1) & 3, u & 1); }
        else if (u < 96) { const int v = u - 64; gla_unit(F, l, 32 + (v >> 2), v & 3); }
        else if (u < 128) { const int v = u - 96; ret_unit(F, l, 32 + (v >> 2), v & 3); }
        else if (u < 384) { const int v = u - 128; mlstm_unit(F, l, v >> 3, (v >> 1) & 3, v & 1); }
        else if (u < 512) { const int v = u - 384; gla_unit(F, l, v >> 2, v & 3); }
        else { const int v = u - 512; ret_unit(F, l, v >> 2, v & 3); }
    }
}

__global__ void __launch_bounds__(512, 2) fwd_kernel(Args args) {
    extern __shared__ __attribute__((aligned(16))) unsigned char lds_raw[];
    Ctx F;
    F.lds = (LAS unsigned char*)lds_raw;
    F.tid = threadIdx.x; F.lane = F.tid & 63; F.wave = __builtin_amdgcn_readfirstlane(F.tid >> 6); F.G = gridDim.x; F.bid = blockIdx.x;
    F.x_prompt = args.in[0]; F.x_sample = args.in[1]; F.st_C = args.in[2]; F.st_n = args.in[3]; F.st_m = args.in[4]; F.st_ret = args.in[5]; F.st_gla = args.in[6];
    F.cvec = args.in[7]; F.c_ctx = args.in[8]; F.norm_g = args.in[9]; F.w_ada = args.in[10]; F.b_ada = args.in[11]; F.w_in = args.in[12]; F.gate_b = args.in[13];
    F.ret_logit = args.in[14]; F.gla_w2 = args.in[15]; F.gla_b2 = args.in[16]; F.hn_g = args.in[17]; F.w_out = args.in[18]; F.final_g = args.in[19];
    F.out = args.out; unsigned char* ws = args.ws;
    F.ctl = (unsigned*)(ws + WS_CTL); F.mod = (float*)(ws + WS_MOD); F.WinT = (bf16*)(ws + WS_WIN); F.WoutT = (bf16*)(ws + WS_WOUT);
    F.R1 = (bf16*)(ws + WS_R1); F.R2 = (bf16*)(ws + WS_R2); F.PROJ = (bf16*)(ws + WS_PROJ);
    const int lo = args.ph_lo, hi = args.ph_hi;
#if N_LAUNCH_MODE == 1
    cg::grid_group grid = cg::this_grid();
#define SEAM(k) do { if (lo <= (k) && (k) + 1 < hi) grid.sync(); } while (0)
#else
#define SEAM(k) do { } while (0)
#endif
#define IN(k) (lo <= (k) && (k) < hi)
    int ph = 0;
    if (IN(ph)) { p0_prologue(F); } SEAM(ph); ++ph;
    for (int l = 0; l < DEPTH; ++l) {
        if (IN(ph)) { hprep_phase(F, l); } SEAM(ph); ++ph;
        if (IN(ph)) {
            pg8::Gemm g{F.R1, F.WinT + (size_t)l * DINP * 1024, NTOK, DINP, 1024}; pg8::StaticOrder S; S.init(NTOK, DINP, F.G, F.bid);
            pg8::EpiBf16 E{F.PROJ, DINP};
            pg8::gemm_phase<pg8::EpiBf16, pg8::StaticOrder, true, true>(F.lds, g, S, E);
        } SEAM(ph); ++ph;
        if (IN(ph)) { mixer_phase(F, l); } SEAM(ph); ++ph;
        if (IN(ph)) { yprep_phase(F, l); } SEAM(ph); ++ph;
        if (IN(ph)) {
            pg8::Gemm g{F.R1, F.WoutT + (size_t)l * 1024 * 1024, NTOK, 1024, 1024}; pg8::StaticOrder S; S.init(NTOK, 1024, F.G, F.bid);
            pg8::EpiResid E{l == 0 ? F.x_prompt : F.out, l == 0 ? F.x_sample : F.out + (size_t)NCTX * 1024, F.out, F.mod + (size_t)l * 9 * 3072 + 2048};
            pg8::gemm_phase<pg8::EpiResid, pg8::StaticOrder, true, true>(F.lds, g, S, E);
        } SEAM(ph); ++ph;
    }
    if (IN(ph)) { final_phase(F); }
}

extern "C" void kernel_launch(void* const* d_in, const int* in_sizes, int n_in, void* d_out, int out_size, void* d_ws, size_t ws_size, hipStream_t stream) {
    static int grid = 0;
    if (grid == 0) {
        if (n_in != 20 || out_size != (int)O_END || ws_size < WS_END) { fprintf(stderr, "kernel_launch: unexpected shapes: n_in %d out %d ws %zu\n", n_in, out_size, ws_size); grid = -1; return; }
        int dev = 0, cus = 0, per_cu = 0;
        if (hipGetDevice(&dev) != hipSuccess || hipDeviceGetAttribute(&cus, hipDeviceAttributeMultiprocessorCount, dev) != hipSuccess) { grid = -1; return; }
        if (hipFuncSetAttribute((const void*)fwd_kernel, hipFuncAttributeMaxDynamicSharedMemorySize, LDS_BYTES) != hipSuccess) { fprintf(stderr, "kernel_launch: hipFuncSetAttribute failed\n"); grid = -1; return; }
        if (hipOccupancyMaxActiveBlocksPerMultiprocessor(&per_cu, (const void*)fwd_kernel, 512, LDS_BYTES) != hipSuccess || per_cu < 1) { fprintf(stderr, "kernel_launch: occupancy query says %d blocks per CU\n", per_cu); per_cu = 1; }
        (void)hipGetLastError();
        grid = cus;
    }
    if (grid < 0) return;
    (void)hipMemsetAsync((char*)d_ws + WS_CTL, 0, CTL_ZERO_BYTES, stream);
    Args a{};
    for (int i = 0; i < 20; ++i) a.in[i] = (const float*)d_in[i];
    a.out = (float*)d_out; a.ws = (unsigned char*)d_ws;
#if N_LAUNCH_MODE == 1
    a.ph_lo = 0; a.ph_hi = NPHASE;
    void* kargs[] = {&a};
    hipError_t e = hipLaunchCooperativeKernel((const void*)fwd_kernel, dim3(grid), dim3(512), kargs, LDS_BYTES, stream);
    if (e != hipSuccess) fprintf(stderr, "kernel_launch: cooperative launch failed: %s (grid %d)\n", hipGetErrorString(e), grid);
#else
    for (int p = 0; p < NPHASE; ++p) { a.ph_lo = p; a.ph_hi = p + 1; hipLaunchKernelGGL(fwd_kernel, dim3(grid), dim3(512), LDS_BYTES, stream, a); }
#endif
}
```

```cpp
#include <hip/hip_runtime.h>
#include <hip/hip_cooperative_groups.h>
#include <cstdio>
#include <cstdint>
namespace cg = cooperative_groups;

#ifndef N_LAUNCH_MODE
#define N_LAUNCH_MODE 1
#endif

#define LAS __attribute__((address_space(3)))
typedef unsigned short bf16;
typedef short bf16x8 __attribute__((ext_vector_type(8)));
typedef short bf16x4 __attribute__((ext_vector_type(4)));
typedef float f32x4 __attribute__((ext_vector_type(4)));
typedef unsigned u32x4 __attribute__((ext_vector_type(4)));
typedef unsigned u32x2 __attribute__((ext_vector_type(2)));

namespace pg8 {
#define PG8_LAS __attribute__((address_space(3)))
typedef unsigned short bf16_t;
constexpr int BM = 256, BK = 64, HALF = 128, HTB = HALF * BK * 2, STAGE_BYTES = 8 * HTB, NXCD = 8, WGM = 8;

__host__ __device__ __forceinline__ int lds_byte(int r, int c) { const int st = (r >> 4) * 2 + (c >> 5), rr = r & 15, cc = c & 31, ob = rr * 64 + cc * 2; return st * 1024 + (ob ^ (((ob >> 9) & 1) << 5)); }
__host__ __device__ __forceinline__ void stage_rc(int b, int& R, int& C) { const int st = b / 1024, sb = b % 1024, swz = sb ^ (((sb >> 9) & 1) << 5); R = (st >> 1) * 16 + swz / 64; C = (st & 1) * 32 + (swz % 64) / 2; }
__host__ __device__ __forceinline__ int perm32(int rho) { const int n = rho >> 4, i = rho & 15; return 8 * (i >> 2) + 4 * n + (i & 3); }

struct Unit { int pm, pn; };
struct Gemm { const bf16_t* A; const bf16_t* Bt; int M, N, K; };

struct StaticOrder {
    int nM, nN, nwg, G, c;
    __host__ __device__ void init(int M, int N, int G_, int c_) { nM = M / BM; nN = N / BM; nwg = nM * nN; G = G_; c = c_; }
    __host__ __device__ bool next(int i, Unit& u) const {
        const long L = (long)i * G + c; if (L >= nwg) return false;
        int wgid = (int)L; { const int q = nwg / NXCD, r = nwg % NXCD, xcd = wgid % NXCD, off = wgid / NXCD; wgid = (xcd < r ? xcd * (q + 1) : r * (q + 1) + (xcd - r) * q) + off; }
        const int nig = WGM * nN, gid = wgid / nig, fm = gid * WGM, gsz = (nM - fm) < WGM ? (nM - fm) : WGM;
        u.pm = fm + ((wgid % nig) % gsz); u.pn = (wgid % nig) / gsz; return true;
    }
    __device__ __forceinline__ void a_ready(const Unit&) const {}
    __device__ __forceinline__ void done(const Unit&) const {}
};

__device__ __forceinline__ unsigned cvt_pk_bf16(float lo, float hi) { unsigned r; asm volatile("v_cvt_pk_bf16_f32 %0, %1, %2" : "=v"(r) : "v"(lo), "v"(hi)); return r; }

struct EpiBf16 {
    static constexpr bool PERM = true, AFTER_DRAIN = false;
    bf16_t* O; int ldc;
    __device__ __forceinline__ void operator()(const f32x4 (&acc)[2][2][4][2], const Unit& u, int wr, int wc, int fr, int fq) const {
        const int row0 = u.pm * BM + wr * 64 + fr; const int col0 = u.pn * BM + wc * 32 + 8 * fq;
#pragma unroll
        for (int ai = 0; ai < 2; ++ai)
#pragma unroll
            for (int m = 0; m < 4; ++m) { bf16_t* rowp = O + (size_t)(row0 + ai * HALF + m * 16) * ldc + col0;
#pragma unroll
                for (int bj = 0; bj < 2; ++bj) { const f32x4 v0 = acc[ai][bj][m][0], v1 = acc[ai][bj][m][1];
                    u32x4 w; w.x = cvt_pk_bf16(v0[0], v0[1]); w.y = cvt_pk_bf16(v0[2], v0[3]); w.z = cvt_pk_bf16(v1[0], v1[1]); w.w = cvt_pk_bf16(v1[2], v1[3]);
                    *(u32x4*)(rowp + bj * HALF) = w; } }
    }
};
struct EpiResid {
    static constexpr bool PERM = false, AFTER_DRAIN = false;
    const float* xin0; const float* xin1;
    float* xout; const float* gate;
    __device__ __forceinline__ void operator()(const f32x4 (&acc)[2][2][4][2], const Unit& u, int wr, int wc, int fr, int fq) const {
        const int row0 = u.pm * BM + wr * 64 + fr, col0 = u.pn * BM + wc * 32 + 4 * fq;
#pragma unroll
        for (int ai = 0; ai < 2; ++ai)
#pragma unroll
            for (int m = 0; m < 4; ++m) { const int row = row0 + ai * HALF + m * 16;
                const float* xr = (row < 8192 ? xin0 + (size_t)row * 1024 : xin1 + (size_t)(row - 8192) * 1024) + col0;
                const float* gr = gate + (size_t)(row < 8192 ? 0 : 1 + ((row - 8192) >> 10)) * 3072 + col0;
                float* orow = xout + (size_t)row * 1024 + col0;
#pragma unroll
                for (int bj = 0; bj < 2; ++bj)
#pragma unroll
                    for (int n = 0; n < 2; ++n) { const f32x4 xv = *(const f32x4*)(xr + bj * HALF + n * 16), gv = *(const f32x4*)(gr + bj * HALF + n * 16);
                        *(f32x4*)(orow + bj * HALF + n * 16) = xv + gv * acc[ai][bj][m][n]; } }
    }
};

template <class Epi, class Sched, bool ALIGN_EPI = false, bool SP2 = false>
__device__ __forceinline__ void gemm_phase(PG8_LAS unsigned char* lds, const Gemm g, const Sched& S, const Epi& E) {
    int tid_ = threadIdx.x; asm volatile("" : "+v"(tid_));
    const int tid = tid_, wid = __builtin_amdgcn_readfirstlane(tid >> 6), lane = tid & 63, wr = wid >> 2, wc = wid & 3, fr = lane & 15, fq = lane >> 4;
    const int K = g.K, nt = K / BK;
    unsigned voffA[2], voffB[2];
#pragma unroll
    for (int i = 0; i < 2; ++i) { int R, C; stage_rc(tid * 16 + i * 8192, R, C); const int Rb = Epi::PERM ? ((R & ~31) + perm32(R & 31)) : R;
        voffA[i] = (unsigned)(R * K + C) * 2u; voffB[i] = (unsigned)(Rb * K + C) * 2u; }
    const size_t kstep = (size_t)(BK * 2);
    const size_t hstep = (size_t)HALF * K * 2;
    const size_t tstep = 2 * hstep;
    const unsigned ldsw = (unsigned)wid * 1024u;
    const int aoff = lds_byte(wr * 64 + fr, fq * 8), boff = lds_byte(wc * 32 + fr, fq * 8);
#define PG8_SA(b, h) (((b) * 2 + (h)) * HTB)
#define PG8_SB(b, h) ((4 + (b) * 2 + (h)) * HTB)
#define PG8_STAGE(bufoff, gbase, voff) do { _Pragma("unroll") for (int _i = 0; _i < 2; ++_i) \
        __builtin_amdgcn_global_load_lds((const unsigned*)((const char*)(gbase) + (voff)[_i]), (PG8_LAS unsigned*)(lds + (bufoff) + ldsw + _i * 8192), 16, 0, 0); } while (0)
#define PG8_LDA(dst, b, h) do { _Pragma("unroll") for (int m = 0; m < 4; ++m) _Pragma("unroll") for (int k = 0; k < 2; ++k) dst[m][k] = *(const PG8_LAS bf16x8*)(lds + PG8_SA(b, h) + aoff + m * 2048 + k * 1024); } while (0)
#define PG8_LDB(dst, b, h) do { _Pragma("unroll") for (int n = 0; n < 2; ++n) _Pragma("unroll") for (int k = 0; k < 2; ++k) dst[n][k] = *(const PG8_LAS bf16x8*)(lds + PG8_SB(b, h) + boff + n * 2048 + k * 1024); } while (0)
#define PG8_MMA(ai, bj, At, Bt) do { __builtin_amdgcn_s_setprio(1); _Pragma("unroll") for (int m = 0; m < 4; ++m) _Pragma("unroll") for (int n = 0; n < 2; ++n) _Pragma("unroll") for (int k = 0; k < 2; ++k) \
        acc[ai][bj][m][n] = __builtin_amdgcn_mfma_f32_16x16x32_bf16(Bt[n][k], At[m][k], acc[ai][bj][m][n], 0, 0, 0); __builtin_amdgcn_s_setprio(0); } while (0)
#define PG8_WAIT_V(n) asm volatile("s_waitcnt vmcnt(" #n ")" ::: "memory")
#define PG8_WAIT_L(n) asm volatile("s_waitcnt lgkmcnt(" #n ")" ::: "memory")
#define PG8_BAR __builtin_amdgcn_s_barrier()
#define PG8_SCHED __builtin_amdgcn_sched_barrier(0)
    Unit cur, nxt; int ui = 0;
    if (!S.next(0, cur)) return;
    f32x4 acc[2][2][4][2];
#pragma unroll
    for (int a = 0; a < 2; ++a)
#pragma unroll
        for (int b = 0; b < 2; ++b)
#pragma unroll
            for (int m = 0; m < 4; ++m)
#pragma unroll
                for (int n = 0; n < 2; ++n) acc[a][b][m][n] = (f32x4){0.f, 0.f, 0.f, 0.f};
    bf16x8 At[4][2], B0[2][2], B1[2][2];
    const char* cA = (const char*)g.A + (size_t)cur.pm * tstep; const char* cB = (const char*)g.Bt + (size_t)cur.pn * tstep;
    S.a_ready(cur);
    if constexpr (SP2) {
        PG8_STAGE(PG8_SB(0, 0), cB, voffB); PG8_STAGE(PG8_SB(0, 1), cB + hstep, voffB); PG8_STAGE(PG8_SA(0, 0), cA, voffA); PG8_STAGE(PG8_SA(0, 1), cA + hstep, voffA);
        if (wr == 1) PG8_BAR;
        PG8_WAIT_V(2); PG8_BAR;
        PG8_STAGE(PG8_SB(1, 0), cB + kstep, voffB); PG8_STAGE(PG8_SA(1, 0), cA + kstep, voffA); PG8_STAGE(PG8_SB(1, 1), cB + hstep + kstep, voffB);
        PG8_WAIT_V(6); PG8_BAR;
    } else {
        PG8_STAGE(PG8_SB(0, 0), cB, voffB); PG8_STAGE(PG8_SA(0, 0), cA, voffA); PG8_STAGE(PG8_SB(0, 1), cB + hstep, voffB); PG8_STAGE(PG8_SA(0, 1), cA + hstep, voffA);
        if (wr == 1) PG8_BAR;
        PG8_WAIT_V(4); PG8_BAR;
        PG8_STAGE(PG8_SB(1, 0), cB + kstep, voffB); PG8_STAGE(PG8_SA(1, 0), cA + kstep, voffA); PG8_STAGE(PG8_SB(1, 1), cB + hstep + kstep, voffB);
        PG8_WAIT_V(6); PG8_BAR;
    }
    for (;;) {
        const bool has_next = S.next(ui + 1, nxt);
        const char* nA = has_next ? (const char*)g.A + (size_t)nxt.pm * tstep : cA; const char* nB = has_next ? (const char*)g.Bt + (size_t)nxt.pn * tstep : cB;
        for (int t = 0; t < nt; t += 2) {
            const bool last = (t == nt - 2);
            const char* a1 = cA + (size_t)(t + 1) * kstep;
            const char* a2 = last ? nA : cA + (size_t)(t + 2) * kstep; const char* b2 = last ? nB : cB + (size_t)(t + 2) * kstep;
            const char* a3 = a2 + kstep; const char* b3 = b2 + kstep;
            if (last && has_next) S.a_ready(nxt);
            if constexpr (SP2) {
            PG8_LDB(B0, 0, 0); PG8_LDB(B1, 0, 1); PG8_SCHED; PG8_LDA(At, 0, 0); PG8_STAGE(PG8_SA(1, 1), a1 + hstep, voffA);
            PG8_WAIT_V(8); PG8_WAIT_L(0); PG8_BAR; PG8_MMA(0, 0, At, B0); PG8_MMA(0, 1, At, B1); PG8_BAR; PG8_SCHED;
            PG8_LDA(At, 0, 1); PG8_STAGE(PG8_SB(0, 0), b2, voffB); PG8_STAGE(PG8_SB(0, 1), b2 + hstep, voffB); PG8_STAGE(PG8_SA(0, 0), a2, voffA);
            PG8_WAIT_V(8); PG8_WAIT_L(0); PG8_BAR; PG8_MMA(1, 0, At, B0); PG8_MMA(1, 1, At, B1); PG8_BAR; PG8_SCHED;
            PG8_LDB(B0, 1, 0); PG8_LDB(B1, 1, 1); PG8_SCHED; PG8_LDA(At, 1, 0); PG8_STAGE(PG8_SA(0, 1), a2 + hstep, voffA);
            PG8_WAIT_V(8); PG8_WAIT_L(0); PG8_BAR; PG8_MMA(0, 0, At, B0); PG8_MMA(0, 1, At, B1); PG8_BAR; PG8_SCHED;
            PG8_LDA(At, 1, 1); PG8_STAGE(PG8_SB(1, 0), b3, voffB); PG8_STAGE(PG8_SB(1, 1), b3 + hstep, voffB); PG8_STAGE(PG8_SA(1, 0), a3, voffA);
            PG8_WAIT_V(8); PG8_WAIT_L(0); PG8_BAR; PG8_MMA(1, 0, At, B0); PG8_MMA(1, 1, At, B1); PG8_BAR; PG8_SCHED;
            } else {
            PG8_LDB(B0, 0, 0); PG8_SCHED; PG8_LDA(At, 0, 0); PG8_STAGE(PG8_SA(1, 1), a1 + hstep, voffA);
            PG8_WAIT_L(8); PG8_BAR; PG8_WAIT_L(0); PG8_MMA(0, 0, At, B0); PG8_BAR; PG8_SCHED;
            PG8_LDB(B1, 0, 1); PG8_STAGE(PG8_SB(0, 0), b2, voffB);
            PG8_BAR; PG8_WAIT_L(0); PG8_MMA(0, 1, At, B1); PG8_BAR;
            PG8_LDA(At, 0, 1); PG8_STAGE(PG8_SA(0, 0), a2, voffA);
            PG8_BAR; PG8_WAIT_L(0); PG8_MMA(1, 0, At, B0); PG8_BAR; PG8_SCHED;
            PG8_STAGE(PG8_SB(0, 1), b2 + hstep, voffB);
            PG8_WAIT_V(6); PG8_BAR; PG8_MMA(1, 1, At, B1); PG8_BAR;
            PG8_LDB(B0, 1, 0); PG8_SCHED; PG8_LDA(At, 1, 0); PG8_STAGE(PG8_SA(0, 1), a2 + hstep, voffA);
            PG8_WAIT_L(8); PG8_BAR; PG8_WAIT_L(0); PG8_MMA(0, 0, At, B0); PG8_BAR; PG8_SCHED;
            PG8_LDB(B1, 1, 1); PG8_STAGE(PG8_SB(1, 0), b3, voffB);
            PG8_BAR; PG8_WAIT_L(0); PG8_MMA(0, 1, At, B1); PG8_BAR;
            PG8_LDA(At, 1, 1); PG8_STAGE(PG8_SA(1, 0), a3, voffA);
            PG8_BAR; PG8_WAIT_L(0); PG8_MMA(1, 0, At, B0); PG8_BAR; PG8_SCHED;
            PG8_STAGE(PG8_SB(1, 1), b3 + hstep, voffB);
            PG8_WAIT_V(6); PG8_BAR; PG8_MMA(1, 1, At, B1); PG8_BAR;
            }
        }
        if constexpr (ALIGN_EPI) { if (wr == 0) PG8_BAR; }
        if constexpr (!Epi::AFTER_DRAIN) { E(acc, cur, wr, wc, fr, fq); S.done(cur); }
        if (!has_next) break;
#pragma unroll
        for (int a = 0; a < 2; ++a)
#pragma unroll
            for (int b = 0; b < 2; ++b)
#pragma unroll
                for (int m = 0; m < 4; ++m)
#pragma unroll
                    for (int n = 0; n < 2; ++n) acc[a][b][m][n] = (f32x4){0.f, 0.f, 0.f, 0.f};
        cur = nxt; cA = nA; cB = nB; ++ui;
        if constexpr (ALIGN_EPI) { if (wr == 1) PG8_BAR; }
    }
    PG8_WAIT_V(0);
    if constexpr (!ALIGN_EPI) { if (wr == 0) PG8_BAR; }
    PG8_BAR;
#undef PG8_SA
#undef PG8_SB
#undef PG8_STAGE
#undef PG8_LDA
#undef PG8_LDB
#undef PG8_MMA
#undef PG8_WAIT_V
#undef PG8_WAIT_L
#undef PG8_BAR
#undef PG8_SCHED
}
}


#define XB_TMO      128
#define XB_XCNT(j)  (256  + 64 * (j))
#define XB_XSUB(j)  (1280 + 64 * (j))
#define XB_XGEN(j)  (2304 + 64 * (j))
#define XB_TOP      3328
#define XB_TOPGEN   3392
#define XCD_BAR_WORDS 3456
#define XB_SPIN_CAP (1u << 18)
__device__ __forceinline__ unsigned xb_ld(unsigned* p)              { return __hip_atomic_load(p, __ATOMIC_RELAXED, __HIP_MEMORY_SCOPE_AGENT); }
__device__ __forceinline__ unsigned xb_add(unsigned* p, unsigned v) { return __hip_atomic_fetch_add(p, v, __ATOMIC_RELAXED, __HIP_MEMORY_SCOPE_AGENT); }
__device__ __forceinline__ unsigned xb_xcc_id() { return (unsigned)__builtin_amdgcn_s_getreg((3 << 11) | 20) & 0xFu; }
#define XB_SPIN(cond, bar) do { unsigned _sp = 0; while (cond) { __builtin_amdgcn_s_sleep(1); \
    if ((++_sp & 255u) == 0u) { if (xb_ld(&(bar)[XB_TMO])) break; if (_sp > XB_SPIN_CAP) { atomicAdd(&(bar)[XB_TMO], 1u); break; } } } } while (0)
struct XcdBarrier { unsigned* bar; unsigned x; volatile LAS unsigned* st; };
__device__ __forceinline__ XcdBarrier xcd_barrier_post(unsigned* bar, volatile LAS unsigned* st) {
    XcdBarrier b; b.bar = bar; b.x = xb_xcc_id(); b.st = st;
    if (threadIdx.x == 0) (void)xb_add(&bar[XB_XCNT(b.x)], 1u);
    return b;
}
__device__ __forceinline__ void xcd_barrier_complete(unsigned* bar, unsigned x, unsigned& nloc, unsigned& nx) {
    const unsigned G = gridDim.x * gridDim.y * gridDim.z;
    unsigned sum, cnt, mine, sp = 0u;
    for (;;) {
        sum = 0u; cnt = 0u; mine = 0u;
#pragma unroll
        for (unsigned j = 0; j < 16; ++j) { const unsigned c = xb_ld(&bar[XB_XCNT(j)]); sum += c; cnt += (c > 0u) ? 1u : 0u; mine = (j == x) ? c : mine; }
        if (sum == G) break;
        __builtin_amdgcn_s_sleep(1);
        if ((++sp & 255u) == 0u) { if (xb_ld(&bar[XB_TMO])) break; if (sp > XB_SPIN_CAP) { atomicAdd(&bar[XB_TMO], 1u); break; } }
    }
    nloc = mine > 0u ? mine : 1u; nx = cnt > 0u ? cnt : 1u;
}
__device__ __forceinline__ void xcd_barrier(const XcdBarrier& b) {
    asm volatile("s_waitcnt vmcnt(0)" ::: "memory");
    __syncthreads();
    if (threadIdx.x == 0) {
        unsigned* bar = b.bar;
        __builtin_amdgcn_s_waitcnt(0);
        unsigned nloc = b.st[0], nx = b.st[1];
        if (nloc == 0u) { xcd_barrier_complete(bar, b.x, nloc, nx); b.st[0] = nloc; b.st[1] = nx; }
        const unsigned old = xb_add(&bar[XB_XSUB(b.x)], 1u);
        const unsigned gen = old / nloc;
        if (old + 1u == (gen + 1u) * nloc) {
            __builtin_amdgcn_fence(__ATOMIC_RELEASE, "agent");
            asm volatile("s_waitcnt vmcnt(0)" ::: "memory");
            const unsigned og = xb_add(&bar[XB_TOP], 1u);
            const unsigned tg = og / nx;
            if (og + 1u == (tg + 1u) * nx) xb_add(&bar[XB_TOPGEN], 1u);
            else XB_SPIN(xb_ld(&bar[XB_TOPGEN]) == tg, bar);
            __builtin_amdgcn_fence(__ATOMIC_ACQUIRE, "agent");
            xb_add(&bar[XB_XGEN(b.x)], 1u);
            asm volatile("s_waitcnt vmcnt(0)" ::: "memory");
        } else {
            XB_SPIN(xb_ld(&bar[XB_XGEN(b.x)]) == gen, bar);
            __builtin_amdgcn_fence(__ATOMIC_ACQUIRE, "agent");
            asm volatile("s_waitcnt vmcnt(0)" ::: "memory");
        }
    }
    __syncthreads();
}

constexpr int DM = 1024, DEPTH = 4, NTOK = 16384, NCTX = 8192;
constexpr int DIN = 4400, DINP = 4608;
constexpr int NSEQ = 40;
constexpr int C_AQ = 0, C_AK = 512, C_AV = 1024, C_AO = 1536, C_AZ = 2048, C_AG = 2560, C_BQ = 2576, C_BK = 2832, C_BV = 3088, C_BZ = 3344,
              C_CQ = 3600, C_CK = 3728, C_CV = 3856, C_CZ = 4112, C_CLR = 4368;
constexpr float EPS = 1e-6f;
constexpr size_t O_Y = 0, O_C = 16777216, O_N = O_C + 16777216, O_M = O_N + 131072, O_R = O_M + 1024, O_G = O_R + 4194304, O_END = O_G + 2097152;
constexpr size_t MiB = 1u << 20;
constexpr size_t WS_CTL = 0, CTL_ZERO_BYTES = 64 * 1024;
constexpr size_t WS_MOD = 1 * MiB;
constexpr size_t WS_WIN = 2 * MiB;
constexpr size_t WS_WOUT = 38 * MiB;
constexpr size_t WS_R1 = 46 * MiB;
constexpr size_t WS_R2 = 78 * MiB;
constexpr size_t WS_PROJ = 110 * MiB;
constexpr size_t WS_END = 254 * MiB;
constexpr int CW_QUEUE = 64;
constexpr int CW_BAR = 4096;

constexpr int LDS_BYTES = 147456;
constexpr int NPHASE = 1 + DEPTH * 5 + 1;

__device__ __forceinline__ unsigned f2bf(float f) { unsigned u = __builtin_bit_cast(unsigned, f); return (u + 0x7fffu + ((u >> 16) & 1u)) >> 16; }
__device__ __forceinline__ unsigned pk2(float lo, float hi) { return f2bf(lo) | (f2bf(hi) << 16); }
__device__ __forceinline__ float bf2f(unsigned short b) { return __builtin_bit_cast(float, ((unsigned)b) << 16); }
__device__ __forceinline__ float bflo(unsigned u) { return __builtin_bit_cast(float, u << 16); }
__device__ __forceinline__ float bfhi(unsigned u) { return __builtin_bit_cast(float, u & 0xffff0000u); }
__device__ __forceinline__ float sigmoidf_(float x) { return 1.0f / (1.0f + __expf(-x)); }
__device__ __forceinline__ float siluf_(float x) { return x * sigmoidf_(x); }
__device__ __forceinline__ float logsigmoidf_(float x) { return fminf(x, 0.f) - log1pf(__expf(-fabsf(x))); }
__device__ __forceinline__ float wave_sum(float v) {
#pragma unroll
    for (int o = 1; o < 64; o <<= 1) v += __shfl_xor(v, o);
    return v;
}
__device__ __forceinline__ bf16x8 mk8(bf16x4 lo, bf16x4 hi) { return __builtin_shufflevector(lo, hi, 0, 1, 2, 3, 4, 5, 6, 7); }
__device__ __forceinline__ bf16x8 pack8(f32x4 a, f32x4 b) { u32x4 w; w.x = pk2(a[0], a[1]); w.y = pk2(a[2], a[3]); w.z = pk2(b[0], b[1]); w.w = pk2(b[2], b[3]); return __builtin_bit_cast(bf16x8, w); }
#define MFMA16(a, b, c) __builtin_amdgcn_mfma_f32_16x16x32_bf16((a), (b), (c), 0, 0, 0)

struct Args { const float* in[20]; float* out; unsigned char* ws; int ph_lo, ph_hi; };

struct Ctx {
    LAS unsigned char* lds; int tid, lane, wave, G, bid;
    const float *x_prompt, *x_sample, *st_C, *st_n, *st_m, *st_ret, *st_gla, *cvec, *c_ctx, *norm_g, *w_ada, *b_ada, *w_in, *gate_b, *ret_logit, *gla_w2, *gla_b2, *hn_g, *w_out, *final_g;
    float* out; unsigned* ctl; float* mod; bf16 *WinT, *WoutT, *R1, *R2, *PROJ;
};

#define FRESH_TID(F) do { int t_ = threadIdx.x; asm volatile("" : "+v"(t_)); (F).tid = t_; (F).lane = t_ & 63; (F).wave = __builtin_amdgcn_readfirstlane(t_ >> 6); } while (0)
__device__ __forceinline__ void seq_info(int s, int& row0, int& L) { if (s < 32) { row0 = s * 256; L = 256; } else { row0 = NCTX + (s - 32) * 1024; L = 1024; } }

__device__ __forceinline__ float col_scale_in(int n) {
    if (n >= C_AK && n < C_AV) return 0.08838834764831845f;
    if (n >= C_BK && n < C_BV) return 0.125f;
    if (n >= C_CK && n < C_CV) return 0.17677669529663687f;
    return 1.0f;
}
__device__ __forceinline__ void p0_transpose_item(const float* W, int ldn, int nvalid, bool scale_in, bf16* WT, LAS float* scr, int kb, int nb, int lane) {
    const int k0 = 64 * kb, n0 = 32 * nb;
    const int n = n0 + (lane & 31); const float sc = scale_in ? col_scale_in(n) : 1.0f;
#pragma unroll 8
    for (int i = 0; i < 32; ++i) { const int kk = 2 * i + (lane >> 5); scr[kk * 33 + (lane & 31)] = (n < nvalid) ? W[(size_t)(k0 + kk) * ldn + n] * sc : 0.f; }
    asm volatile("s_waitcnt lgkmcnt(0)" ::: "memory");
    const int c = lane & 7;
#pragma unroll
    for (int j = 0; j < 4; ++j) { const int nn = (lane >> 3) + 8 * j; const LAS float* s = scr + (8 * c) * 33 + nn;
        u32x4 o; o.x = pk2(s[0 * 33], s[1 * 33]); o.y = pk2(s[2 * 33], s[3 * 33]); o.z = pk2(s[4 * 33], s[5 * 33]); o.w = pk2(s[6 * 33], s[7 * 33]);
        *(u32x4*)(WT + (size_t)(n0 + nn) * 1024 + k0 + 8 * c) = o; }
    asm volatile("s_waitcnt lgkmcnt(0)" ::: "memory");
}
__device__ __forceinline__ void p0_prologue(Ctx& F) {
    FRESH_TID(F);
    LAS float* scr = (LAS float*)(F.lds + F.wave * 8448);
    const int gw = F.bid * 8 + F.wave, NGW = F.G * 8;
    constexpr int I_IN = 16 * (DINP / 32), I_OUT = 16 * 32, I_L = I_IN + I_OUT;
    for (int it = gw; it < DEPTH * I_L; it += NGW) {
        const int l = it / I_L; int r = it % I_L;
        if (r < I_IN) p0_transpose_item(F.w_in + (size_t)l * 1024 * DIN, DIN, DIN, true, F.WinT + (size_t)l * DINP * 1024, scr, r / (DINP / 32), r % (DINP / 32), F.lane);
        else { r -= I_IN; p0_transpose_item(F.w_out + (size_t)l * 1024 * 1024, 1024, 1024, false, F.WoutT + (size_t)l * 1024 * 1024, scr, r / 32, r % 32, F.lane); }
    }
    __syncthreads();
    LAS float* sl = (LAS float*)(F.lds + 69632);
    LAS float* red = (LAS float*)(F.lds + 106496);
    bool have_sl = false;
    for (int it = F.bid; it < DEPTH * 48; it += F.G) {
        if (!have_sl) {
            for (int i = F.tid; i < 9 * 1024; i += 512) { const int r = i >> 10, k = i & 1023; const float v = r == 0 ? F.c_ctx[k] : F.cvec[(r - 1) * 1024 + k]; sl[i] = siluf_(v); }
            have_sl = true; __syncthreads();
        }
        const int l = it / 48, e0 = (it % 48) * 64, c = F.tid & 63, kg = F.tid >> 6;
        const float* wp = F.w_ada + ((size_t)l * 1024 + kg * 128) * 3072 + e0 + c;
        float acc[9];
#pragma unroll
        for (int r = 0; r < 9; ++r) acc[r] = 0.f;
#pragma unroll 4
        for (int k = 0; k < 128; ++k) { const float w = wp[(size_t)k * 3072];
#pragma unroll
            for (int r = 0; r < 9; ++r) acc[r] += sl[r * 1024 + kg * 128 + k] * w; }
#pragma unroll
        for (int r = 0; r < 9; ++r) red[(kg * 9 + r) * 64 + c] = acc[r];
        __syncthreads();
        for (int o = F.tid; o < 9 * 64; o += 512) { const int r = o >> 6, cc = o & 63; float s = F.b_ada[l * 3072 + e0 + cc];
#pragma unroll
            for (int g = 0; g < 8; ++g) s += red[(g * 9 + r) * 64 + cc];
            F.mod[((size_t)l * 9 + r) * 3072 + e0 + cc] = s; }
        __syncthreads();
    }
}

__device__ __forceinline__ void hprep_phase(Ctx& F, int l) {
    FRESH_TID(F);
    const int gw = F.bid * 8 + F.wave, NGW = F.G * 8;
    const float* g = F.norm_g + l * 1024;
    for (int m = gw; m < NTOK; m += NGW) {
        const float* xrow = (l == 0) ? (m < NCTX ? F.x_prompt + (size_t)m * 1024 : F.x_sample + (size_t)(m - NCTX) * 1024) : F.out + (size_t)m * 1024;
        const int mr = m < NCTX ? 0 : 1 + ((m - NCTX) >> 10);
        const float* md = F.mod + ((size_t)l * 9 + mr) * 3072;
        const f32x4* xr = (const f32x4*)xrow + F.lane;
        f32x4 v[4]; float s = 0.f;
#pragma unroll
        for (int j = 0; j < 4; ++j) { v[j] = xr[64 * j]; s += (v[j].x * v[j].x + v[j].y * v[j].y) + (v[j].z * v[j].z + v[j].w * v[j].w); }
        const float rstd = 1.0f / sqrtf(wave_sum(s) * (1.f / 1024.f) + EPS);
        unsigned long long* o8 = (unsigned long long*)(F.R1 + (size_t)m * 1024) + F.lane;
#pragma unroll
        for (int j = 0; j < 4; ++j) { const int c = 4 * F.lane + 256 * j;
            const f32x4 gg = *(const f32x4*)(g + c), sh = *(const f32x4*)(md + c), sc = *(const f32x4*)(md + 1024 + c);
            const f32x4 h = v[j] * rstd * gg * (sc + 1.0f) + sh;
            o8[64 * j] = (unsigned long long)pk2(h.x, h.y) | ((unsigned long long)pk2(h.z, h.w) << 32); }
    }
}
__device__ __forceinline__ void yprep_phase(Ctx& F, int l) {
    FRESH_TID(F);
    const int gw = F.bid * 8 + F.wave, NGW = F.G * 8;
    const float* hg = F.hn_g + l * 1024;
    const int lane = F.lane, c0 = 16 * lane;
    for (int m = gw; m < NTOK; m += NGW) {
        const bf16* pr = F.PROJ + (size_t)m * DINP;
        const u32x4* hf = (const u32x4*)(F.R1 + (size_t)m * 1024 + c0); const u32x4* hb = (const u32x4*)(F.R2 + (size_t)m * 1024 + c0);
        const int zc = lane < 32 ? C_AZ + c0 : (lane < 48 ? C_BZ + (c0 - 512) : C_CZ + (c0 - 768));
        const u32x4* zp = (const u32x4*)(pr + zc);
        const u32x4* op = (const u32x4*)(pr + C_AO + (lane < 32 ? c0 : 0));
        float v[16], z[16];
#pragma unroll
        for (int hh = 0; hh < 2; ++hh) { const u32x4 a = hf[hh], b = hb[hh], zz = zp[hh], oo = op[hh];
#pragma unroll
            for (int j = 0; j < 4; ++j) { const unsigned ua = a[j], ub = b[j], uz = zz[j], uo = oo[j];
                float v0 = bflo(ua) + bflo(ub), v1 = bfhi(ua) + bfhi(ub);
                if (lane < 32) { v0 *= sigmoidf_(bflo(uo)); v1 *= sigmoidf_(bfhi(uo)); }
                v[hh * 8 + 2 * j] = v0; v[hh * 8 + 2 * j + 1] = v1; z[hh * 8 + 2 * j] = bflo(uz); z[hh * 8 + 2 * j + 1] = bfhi(uz); } }
        float ss = 0.f;
#pragma unroll
        for (int j = 0; j < 16; ++j) ss += v[j] * v[j];
        ss += __shfl_xor(ss, 1); ss += __shfl_xor(ss, 2);
        const float ss8 = ss + __shfl_xor(ss, 4);
        const float rs = lane < 32 ? 1.0f / sqrtf(ss8 * (1.f / 128.f) + EPS) : 1.0f / sqrtf(ss * (1.f / 64.f) + EPS);
        u32x4 o[2];
#pragma unroll
        for (int hh = 0; hh < 2; ++hh)
#pragma unroll
            for (int j = 0; j < 4; ++j) { const int i0 = hh * 8 + 2 * j;
                const float y0 = v[i0] * rs * hg[c0 + i0] * siluf_(z[i0]), y1 = v[i0 + 1] * rs * hg[c0 + i0 + 1] * siluf_(z[i0 + 1]);
                o[hh][j] = pk2(y0, y1); }
        u32x4* yo = (u32x4*)(F.R1 + (size_t)m * 1024 + c0);
        yo[0] = o[0]; yo[1] = o[1];
    }
}
__device__ __forceinline__ void final_phase(Ctx& F) {
    FRESH_TID(F);
    const int gw = F.bid * 8 + F.wave, NGW = F.G * 8;
    for (int m = gw; m < NTOK; m += NGW) {
        f32x4* xr = (f32x4*)(F.out + (size_t)m * 1024) + F.lane;
        f32x4 v[4]; float s = 0.f;
#pragma unroll
        for (int j = 0; j < 4; ++j) { v[j] = xr[64 * j]; s += (v[j].x * v[j].x + v[j].y * v[j].y) + (v[j].z * v[j].z + v[j].w * v[j].w); }
        const float rstd = 1.0f / sqrtf(wave_sum(s) * (1.f / 1024.f) + EPS);
#pragma unroll
        for (int j = 0; j < 4; ++j) { const f32x4 gg = *(const f32x4*)(F.final_g + 4 * F.lane + 256 * j); xr[64 * j] = v[j] * rstd * gg; }
    }
}

constexpr int A_QS = 0, A_KS = 17408, A_KGT = 34816, A_VT = 53248, A_PS = 71680, A_TAB = 80896;
constexpr int T_U = 0, T_MX = 64, T_WA = 128, T_EM = 192, T_DENP = 256, T_QN = 512, T_NV = 576;

__device__ __forceinline__ void mlstm_unit(Ctx& F, int l, int s, int h, int dir) {
    FRESH_TID(F);
    const int tid = F.tid, lane = F.lane, w = F.wave, c = lane & 15, q = lane >> 4;
    LAS bf16* Qs = (LAS bf16*)(F.lds + A_QS); LAS bf16* Ks = (LAS bf16*)(F.lds + A_KS); LAS bf16* KgT = (LAS bf16*)(F.lds + A_KGT);
    LAS bf16* VT = (LAS bf16*)(F.lds + A_VT); LAS bf16* Ps = (LAS bf16*)(F.lds + A_PS); LAS float* tab = (LAS float*)(F.lds + A_TAB);
    int row0, L; seq_info(s, row0, L);
    const int nch = L / 64, e0 = 16 * w;
    const float bi = F.gate_b[l * 16 + dir * 8 + h], bfg = F.gate_b[l * 16 + dir * 8 + 4 + h];
    f32x4 st[8]; float m_prev;
    if (s >= 32) {
        const size_t sb = (((size_t)(s - 32) * DEPTH + l) * 2 + dir) * 4 + h;
        const float* C0 = F.st_C + sb * 16384;
#pragma unroll
        for (int t = 0; t < 8; ++t)
#pragma unroll
            for (int r = 0; r < 4; ++r) st[t][r] = C0[(size_t)(16 * t + 4 * q + r) * 128 + e0 + c];
        if (tid < 128) tab[T_NV + tid] = F.st_n[sb * 128 + tid];
        m_prev = F.st_m[sb];
    } else {
#pragma unroll
        for (int t = 0; t < 8; ++t) st[t] = (f32x4){0.f, 0.f, 0.f, 0.f};
        if (tid < 128) tab[T_NV + tid] = 0.f;
        m_prev = 0.f;
    }
    bf16* HX = dir ? F.R2 : F.R1;
    for (int n = 0; n < nch; ++n) {
        const int posl = dir ? (L - 1 - (64 * n + lane)) : (64 * n + lane);
        const bf16* gp = F.PROJ + (size_t)(row0 + posl) * DINP + C_AG + dir * 8 + h;
        const float ic = bf2f(gp[0]) + bi, fp = bf2f(gp[4]) + bfg;
        float Fc = logsigmoidf_(fp);
#pragma unroll
        for (int o = 1; o < 64; o <<= 1) { const float t = __shfl_up(Fc, o); if (lane >= o) Fc += t; }
        const float u = ic - Fc;
        float pm = u;
#pragma unroll
        for (int o = 1; o < 64; o <<= 1) { const float t = __shfl_up(pm, o); if (lane >= o) pm = fmaxf(pm, t); }
        const float F_last = __shfl(Fc, 63), pmL = __shfl(pm, 63);
        const float mx = fmaxf(m_prev, pm), gm = F_last + pmL, m_new = fmaxf(F_last + m_prev, gm);
        const float a_dec = __expf(F_last + m_prev - m_new);
        const float gate = __expf(F_last + u - m_new);
        if (w == 0) { tab[T_U + lane] = u; tab[T_MX + lane] = mx; tab[T_WA + lane] = __expf(m_prev - mx); tab[T_EM + lane] = __expf(-(Fc + mx)); }
#pragma unroll
        for (int i = 0; i < 2; ++i) {
            const int p = tid + 512 * i, r = p >> 4, cp = (p & 15) * 8;
            const int pos = dir ? (L - 1 - (64 * n + r)) : (64 * n + r);
            const bf16* src = F.PROJ + (size_t)(row0 + pos) * DINP + h * 128 + cp;
            const u32x4 qv = *(const u32x4*)(src + C_AQ), kv = *(const u32x4*)(src + C_AK), vv = *(const u32x4*)(src + C_AV);
            *(LAS u32x4*)(Qs + r * 136 + cp) = qv; *(LAS u32x4*)(Ks + r * 136 + cp) = kv;
            const float gr = __shfl(gate, r);
#pragma unroll
            for (int j = 0; j < 4; ++j) {
                KgT[(cp + 2 * j) * 72 + r] = (bf16)f2bf(bflo(kv[j]) * gr); KgT[(cp + 2 * j + 1) * 72 + r] = (bf16)f2bf(bfhi(kv[j]) * gr);
                VT[(cp + 2 * j) * 72 + r] = (bf16)(vv[j] & 0xffffu); VT[(cp + 2 * j + 1) * 72 + r] = (bf16)(vv[j] >> 16); }
        }
        __syncthreads();
#pragma unroll
        for (int x = 0; x < 2; ++x) {
            const int tix = w + 8 * x, jt = tix & 3, it = tix >> 2;
            f32x4 acc = (f32x4){0.f, 0.f, 0.f, 0.f};
            if (jt <= it) {
#pragma unroll
                for (int k = 0; k < 4; ++k) { const bf16x8 a = *(const LAS bf16x8*)(Ks + (16 * jt + c) * 136 + 32 * k + 8 * q), b = *(const LAS bf16x8*)(Qs + (16 * it + c) * 136 + 32 * k + 8 * q);
                    acc = MFMA16(a, b, acc); }
            }
            const int i = 16 * it + c, j0 = 16 * jt + 4 * q;
            const float mxi = tab[T_MX + i]; const f32x4 uj = *(const LAS f32x4*)(tab + T_U + j0);
            float p[4], ds = 0.f;
#pragma unroll
            for (int r = 0; r < 4; ++r) { p[r] = (j0 + r <= i) ? acc[r] * __expf(uj[r] - mxi) : 0.f; ds += p[r]; }
            ds += __shfl_xor(ds, 16); ds += __shfl_xor(ds, 32);
            if (q == 0) tab[T_DENP + jt * 64 + i] = ds;
            u32x2 pw; pw.x = pk2(p[0], p[1]); pw.y = pk2(p[2], p[3]);
            *(LAS u32x2*)(Ps + i * 72 + j0) = pw;
        }
        {
            const int i = tid >> 3, d0 = (tid & 7) * 16;
            const u32x4 qa = *(const LAS u32x4*)(Qs + i * 136 + d0), qb = *(const LAS u32x4*)(Qs + i * 136 + d0 + 8);
            float sacc = 0.f;
#pragma unroll
            for (int j = 0; j < 4; ++j) { sacc += bflo(qa[j]) * tab[T_NV + d0 + 2 * j] + bfhi(qa[j]) * tab[T_NV + d0 + 2 * j + 1];
                sacc += bflo(qb[j]) * tab[T_NV + d0 + 8 + 2 * j] + bfhi(qb[j]) * tab[T_NV + d0 + 8 + 2 * j + 1]; }
            sacc += __shfl_xor(sacc, 1); sacc += __shfl_xor(sacc, 2); sacc += __shfl_xor(sacc, 4);
            if ((tid & 7) == 0) tab[T_QN + i] = sacc;
        }
        __syncthreads();
        bf16x8 cf[4];
#pragma unroll
        for (int k = 0; k < 4; ++k) cf[k] = pack8(st[2 * k], st[2 * k + 1]);
#pragma unroll
        for (int it = 0; it < 4; ++it) {
            const int i = 16 * it + c;
            f32x4 ao = (f32x4){0.f, 0.f, 0.f, 0.f}, ai = (f32x4){0.f, 0.f, 0.f, 0.f};
#pragma unroll
            for (int k = 0; k < 2; ++k) if (k == 0 || it >= 2) {
                const bf16x8 a = *(const LAS bf16x8*)(VT + (e0 + c) * 72 + 32 * k + 8 * q), b = *(const LAS bf16x8*)(Ps + i * 72 + 32 * k + 8 * q);
                ao = MFMA16(a, b, ao); }
#pragma unroll
            for (int k = 0; k < 4; ++k) {
                const bf16x4 lo = *(const LAS bf16x4*)(Qs + i * 136 + 32 * k + 4 * q), hi = *(const LAS bf16x4*)(Qs + i * 136 + 32 * k + 16 + 4 * q);
                ai = MFMA16(cf[k], mk8(lo, hi), ai); }
            const float wai = tab[T_WA + i];
            const float den = tab[T_DENP + i] + tab[T_DENP + 64 + i] + tab[T_DENP + 128 + i] + tab[T_DENP + 192 + i] + wai * tab[T_QN + i];
            const float rd = 1.0f / fmaxf(fabsf(den), tab[T_EM + i]);
            const f32x4 hv = (ao + ai * wai) * rd;
            const int pos = dir ? (L - 1 - (64 * n + i)) : (64 * n + i);
            u32x2 o; o.x = pk2(hv[0], hv[1]); o.y = pk2(hv[2], hv[3]);
            *(u32x2*)(HX + (size_t)(row0 + pos) * 1024 + h * 128 + e0 + 4 * q) = o;
        }
#pragma unroll
        for (int t = 0; t < 8; ++t) {
            st[t] = st[t] * a_dec;
#pragma unroll
            for (int k = 0; k < 2; ++k) { const bf16x8 a = *(const LAS bf16x8*)(KgT + (16 * t + c) * 72 + 32 * k + 8 * q), b = *(const LAS bf16x8*)(VT + (e0 + c) * 72 + 32 * k + 8 * q);
                st[t] = MFMA16(a, b, st[t]); }
        }
        if (tid < 128) { float sacc = 0.f;
#pragma unroll
            for (int k = 0; k < 8; ++k) { const u32x4 kv = *(const LAS u32x4*)(KgT + tid * 72 + 8 * k);
#pragma unroll
                for (int j = 0; j < 4; ++j) sacc += bflo(kv[j]) + bfhi(kv[j]); }
            tab[T_NV + tid] = a_dec * tab[T_NV + tid] + sacc; }
        m_prev = m_new;
        __syncthreads();
    }
    if (s < 32) {
        const size_t sb = (((size_t)s * DEPTH + l) * 2 + dir) * 4 + h;
        float* Co = F.out + O_C + sb * 16384;
#pragma unroll
        for (int t = 0; t < 8; ++t)
#pragma unroll
            for (int r = 0; r < 4; ++r) Co[(size_t)(16 * t + 4 * q + r) * 128 + e0 + c] = st[t][r];
        if (tid < 128) F.out[O_N + sb * 128 + tid] = tab[T_NV + tid];
        if (tid == 0) F.out[O_M + sb] = m_prev;
    }
    __syncthreads();
}

__device__ __forceinline__ void ret_unit(Ctx& F, int l, int s, int h) {
    FRESH_TID(F);
    const int tid = F.tid, lane = F.lane, dir = F.wave >> 2, wl = F.wave & 3, tl = tid & 255, c = lane & 15, q = lane >> 4;
    LAS bf16* base = (LAS bf16*)(F.lds + dir * 46080);
    LAS bf16* Qs = base; LAS bf16* Ks = base + 4608; LAS bf16* KgT = base + 9216; LAS bf16* VT = base + 13824; LAS bf16* Ps = base + 18432;
    int row0, L; seq_info(s, row0, L);
    const int nch = L / 64, e0 = 16 * wl;
    const float lg2 = logsigmoidf_(F.ret_logit[(l * 2 + dir) * 4 + h]) * 1.4426950408889634f;
    const bool rot = s >= 32;
    f32x4 st[4];
    if (s >= 32) {
        const float* S0 = F.st_ret + ((((size_t)(s - 32) * DEPTH + l) * 2 + dir) * 4 + h) * 4096;
#pragma unroll
        for (int t = 0; t < 4; ++t)
#pragma unroll
            for (int r = 0; r < 4; ++r) st[t][r] = S0[(size_t)(16 * t + 4 * q + r) * 64 + e0 + c];
    } else {
#pragma unroll
        for (int t = 0; t < 4; ++t) st[t] = (f32x4){0.f, 0.f, 0.f, 0.f};
    }
    bf16* HX = dir ? F.R2 : F.R1;
    const float g64 = exp2f(64.f * lg2);
    for (int n = 0; n < nch; ++n) {
        {
            const int r = tl >> 2, cp = (tl & 3) * 8;
            const int pos = dir ? (L - 1 - (64 * n + r)) : (64 * n + r);
            const bf16* src = F.PROJ + (size_t)(row0 + pos) * DINP + h * 64 + cp;
            const u32x4 q1 = *(const u32x4*)(src + C_BQ), q2 = *(const u32x4*)(src + C_BQ + 32), k1 = *(const u32x4*)(src + C_BK), k2 = *(const u32x4*)(src + C_BK + 32);
            const u32x4 v1 = *(const u32x4*)(src + C_BV), v2 = *(const u32x4*)(src + C_BV + 32);
            float qa[8], qb[8], ka[8], kb[8];
#pragma unroll
            for (int j = 0; j < 4; ++j) { qa[2 * j] = bflo(q1[j]); qa[2 * j + 1] = bfhi(q1[j]); qb[2 * j] = bflo(q2[j]); qb[2 * j + 1] = bfhi(q2[j]);
                ka[2 * j] = bflo(k1[j]); ka[2 * j + 1] = bfhi(k1[j]); kb[2 * j] = bflo(k2[j]); kb[2 * j + 1] = bfhi(k2[j]); }
            if (rot) {
                const float prow = (float)(pos >> 6), pcol = (float)(pos & 63);
#pragma unroll
                for (int x = 0; x < 8; ++x) { const int f = cp + x;
                    const float fr = exp2f(-(float)(f & 15) * 0.8304820237218406f);
                    const float ang = (f < 16 ? prow : pcol) * fr;
                    const float cs = __cosf(ang), sn = __sinf(ang);
                    const float t1 = qa[x], t2 = qb[x]; qa[x] = t1 * cs - t2 * sn; qb[x] = t1 * sn + t2 * cs;
                    const float s1 = ka[x], s2 = kb[x]; ka[x] = s1 * cs - s2 * sn; kb[x] = s1 * sn + s2 * cs; }
            }
            u32x4 o;
            o.x = pk2(qa[0], qa[1]); o.y = pk2(qa[2], qa[3]); o.z = pk2(qa[4], qa[5]); o.w = pk2(qa[6], qa[7]); *(LAS u32x4*)(Qs + r * 72 + cp) = o;
            o.x = pk2(qb[0], qb[1]); o.y = pk2(qb[2], qb[3]); o.z = pk2(qb[4], qb[5]); o.w = pk2(qb[6], qb[7]); *(LAS u32x4*)(Qs + r * 72 + cp + 32) = o;
            o.x = pk2(ka[0], ka[1]); o.y = pk2(ka[2], ka[3]); o.z = pk2(ka[4], ka[5]); o.w = pk2(ka[6], ka[7]); *(LAS u32x4*)(Ks + r * 72 + cp) = o;
            o.x = pk2(kb[0], kb[1]); o.y = pk2(kb[2], kb[3]); o.z = pk2(kb[4], kb[5]); o.w = pk2(kb[6], kb[7]); *(LAS u32x4*)(Ks + r * 72 + cp + 32) = o;
            const float gr = exp2f((float)(63 - r) * lg2);
#pragma unroll
            for (int x = 0; x < 8; ++x) { KgT[(cp + x) * 72 + r] = (bf16)f2bf(ka[x] * gr); KgT[(cp + 32 + x) * 72 + r] = (bf16)f2bf(kb[x] * gr); }
#pragma unroll
            for (int j = 0; j < 4; ++j) { VT[(cp + 2 * j) * 72 + r] = (bf16)(v1[j] & 0xffffu); VT[(cp + 2 * j + 1) * 72 + r] = (bf16)(v1[j] >> 16);
                VT[(cp + 32 + 2 * j) * 72 + r] = (bf16)(v2[j] & 0xffffu); VT[(cp + 32 + 2 * j + 1) * 72 + r] = (bf16)(v2[j] >> 16); }
        }
        __syncthreads();
#pragma unroll
        for (int it = 0; it < 4; ++it) {
            const int jt = wl;
            f32x4 acc = (f32x4){0.f, 0.f, 0.f, 0.f};
            if (jt <= it) {
#pragma unroll
                for (int k = 0; k < 2; ++k) { const bf16x8 a = *(const LAS bf16x8*)(Ks + (16 * jt + c) * 72 + 32 * k + 8 * q), b = *(const LAS bf16x8*)(Qs + (16 * it + c) * 72 + 32 * k + 8 * q);
                    acc = MFMA16(a, b, acc); }
            }
            const int i = 16 * it + c, j0 = 16 * jt + 4 * q;
            float p[4];
#pragma unroll
            for (int r = 0; r < 4; ++r) p[r] = (j0 + r <= i) ? acc[r] * exp2f((float)(i - j0 - r) * lg2) : 0.f;
            u32x2 pw; pw.x = pk2(p[0], p[1]); pw.y = pk2(p[2], p[3]);
            *(LAS u32x2*)(Ps + i * 72 + j0) = pw;
        }
        __syncthreads();
        bf16x8 cf[2];
#pragma unroll
        for (int k = 0; k < 2; ++k) cf[k] = pack8(st[2 * k], st[2 * k + 1]);
#pragma unroll
        for (int it = 0; it < 4; ++it) {
            const int i = 16 * it + c;
            f32x4 ao = (f32x4){0.f, 0.f, 0.f, 0.f}, ai = (f32x4){0.f, 0.f, 0.f, 0.f};
#pragma unroll
            for (int k = 0; k < 2; ++k) if (k == 0 || it >= 2) {
                const bf16x8 a = *(const LAS bf16x8*)(VT + (e0 + c) * 72 + 32 * k + 8 * q), b = *(const LAS bf16x8*)(Ps + i * 72 + 32 * k + 8 * q);
                ao = MFMA16(a, b, ao); }
#pragma unroll
            for (int k = 0; k < 2; ++k) {
                const bf16x4 lo = *(const LAS bf16x4*)(Qs + i * 72 + 32 * k + 4 * q), hi = *(const LAS bf16x4*)(Qs + i * 72 + 32 * k + 16 + 4 * q);
                ai = MFMA16(cf[k], mk8(lo, hi), ai); }
            const float wq = exp2f((float)(i + 1) * lg2);
            const f32x4 hv = ao + ai * wq;
            const int pos = dir ? (L - 1 - (64 * n + i)) : (64 * n + i);
            u32x2 o; o.x = pk2(hv[0], hv[1]); o.y = pk2(hv[2], hv[3]);
            *(u32x2*)(HX + (size_t)(row0 + pos) * 1024 + 512 + h * 64 + e0 + 4 * q) = o;
        }
#pragma unroll
        for (int t = 0; t < 4; ++t) {
            st[t] = st[t] * g64;
#pragma unroll
            for (int k = 0; k < 2; ++k) { const bf16x8 a = *(const LAS bf16x8*)(KgT + (16 * t + c) * 72 + 32 * k + 8 * q), b = *(const LAS bf16x8*)(VT + (e0 + c) * 72 + 32 * k + 8 * q);
                st[t] = MFMA16(a, b, st[t]); }
        }
        __syncthreads();
    }
    if (s < 32) {
        float* So = F.out + O_R + ((((size_t)s * DEPTH + l) * 2 + dir) * 4 + h) * 4096;
#pragma unroll
        for (int t = 0; t < 4; ++t)
#pragma unroll
            for (int r = 0; r < 4; ++r) So[(size_t)(16 * t + 4 * q + r) * 64 + e0 + c] = st[t][r];
    }
}

__device__ __forceinline__ void gla_unit(Ctx& F, int l, int s, int h) {
    FRESH_TID(F);
    const int tid = F.tid, lane = F.lane, dir = F.wave >> 2, wl = F.wave & 3, tl = tid & 255, c = lane & 15, q = lane >> 4;
    LAS bf16* base = (LAS bf16*)(F.lds + dir * 16384);
    LAS bf16* Qs = base; LAS bf16* Ks = base + 1280; LAS bf16* KgT = base + 2560; LAS bf16* VT = base + 3840; LAS bf16* Ps = base + 6400;
    LAS float* fb = (LAS float*)(F.lds + 32768 + dir * 4096);
    LAS float* clrs = fb; LAS float* tot = fb + 512; LAS float* dec = fb + 768;
    int row0, L; seq_info(s, row0, L);
    const int nch = L / 32, e0 = 16 * wl;
    const int d = tl & 31, jg = tl >> 5;
    float w2r[16];
#pragma unroll
    for (int r = 0; r < 16; ++r) w2r[r] = F.gla_w2[(((size_t)l * 2 + dir) * 16 + r) * 128 + h * 32 + d];
    const float b2v = F.gla_b2[((size_t)l * 2 + dir) * 128 + h * 32 + d];
    f32x4 st[2];
    if (s >= 32) {
        const float* S0 = F.st_gla + ((((size_t)(s - 32) * DEPTH + l) * 2 + dir) * 4 + h) * 2048;
#pragma unroll
        for (int t = 0; t < 2; ++t)
#pragma unroll
            for (int r = 0; r < 4; ++r) st[t][r] = S0[(size_t)(16 * t + 4 * q + r) * 64 + e0 + c];
    } else { st[0] = (f32x4){0.f, 0.f, 0.f, 0.f}; st[1] = st[0]; }
    bf16* HX = dir ? F.R2 : F.R1;
    for (int n = 0; n < nch; ++n) {
        if (tl < 64) { const int r = tl >> 1, hp = (tl & 1) * 8;
            const int pos = dir ? (L - 1 - (32 * n + r)) : (32 * n + r);
            const u32x4 cv = *(const u32x4*)(F.PROJ + (size_t)(row0 + pos) * DINP + C_CLR + dir * 16 + hp);
#pragma unroll
            for (int j = 0; j < 4; ++j) { clrs[r * 16 + hp + 2 * j] = bflo(cv[j]); clrs[r * 16 + hp + 2 * j + 1] = bfhi(cv[j]); } }
        {
            const int r = tl >> 3, cp = (tl & 7) * 8;
            const int pos = dir ? (L - 1 - (32 * n + r)) : (32 * n + r);
            const u32x4 vv = *(const u32x4*)(F.PROJ + (size_t)(row0 + pos) * DINP + C_CV + h * 64 + cp);
#pragma unroll
            for (int j = 0; j < 4; ++j) { VT[(cp + 2 * j) * 40 + r] = (bf16)(vv[j] & 0xffffu); VT[(cp + 2 * j + 1) * 40 + r] = (bf16)(vv[j] >> 16); }
        }
        __syncthreads();
        float pb[4], qv[4], kv[4];
        {
            float run = 0.f;
#pragma unroll
            for (int x = 0; x < 4; ++x) { const int j = 4 * jg + x; float xx = b2v;
#pragma unroll
                for (int r = 0; r < 16; ++r) xx += clrs[j * 16 + r] * w2r[r];
                run += logsigmoidf_(xx) * 0.0625f; pb[x] = run;
                const int pos = dir ? (L - 1 - (32 * n + j)) : (32 * n + j);
                const bf16* src = F.PROJ + (size_t)(row0 + pos) * DINP + h * 32 + d;
                qv[x] = bf2f(src[C_CQ]); kv[x] = bf2f(src[C_CK]); }
            tot[jg * 32 + d] = run;
        }
        __syncthreads();
        {
            float off = 0.f, blast = 0.f;
#pragma unroll
            for (int g = 0; g < 8; ++g) { const float t = tot[g * 32 + d]; if (g < jg) off += t; blast += t; }
            float ku[4];
#pragma unroll
            for (int x = 0; x < 4; ++x) { const int j = 4 * jg + x; const float b = off + pb[x];
                Qs[j * 40 + d] = (bf16)f2bf(qv[x] * __expf(b)); Ks[j * 40 + d] = (bf16)f2bf(kv[x] * __expf(-b)); ku[x] = kv[x] * __expf(blast - b); }
            u32x2 kw; kw.x = pk2(ku[0], ku[1]); kw.y = pk2(ku[2], ku[3]);
            *(LAS u32x2*)(KgT + d * 40 + 4 * jg) = kw;
            if (jg == 0) dec[d] = __expf(blast);
        }
        __syncthreads();
        {
            const int jt = wl & 1, it = wl >> 1;
            f32x4 acc = (f32x4){0.f, 0.f, 0.f, 0.f};
            if (jt <= it) { const bf16x8 a = *(const LAS bf16x8*)(Ks + (16 * jt + c) * 40 + 8 * q), b = *(const LAS bf16x8*)(Qs + (16 * it + c) * 40 + 8 * q); acc = MFMA16(a, b, acc); }
            const int i = 16 * it + c, j0 = 16 * jt + 4 * q;
            float p[4];
#pragma unroll
            for (int r = 0; r < 4; ++r) p[r] = (j0 + r <= i) ? acc[r] : 0.f;
            u32x2 pw; pw.x = pk2(p[0], p[1]); pw.y = pk2(p[2], p[3]);
            *(LAS u32x2*)(Ps + i * 40 + j0) = pw;
        }
        __syncthreads();
        const bf16x8 cf = pack8(st[0], st[1]);
#pragma unroll
        for (int it = 0; it < 2; ++it) {
            const int i = 16 * it + c;
            f32x4 ao = (f32x4){0.f, 0.f, 0.f, 0.f};
            { const bf16x8 a = *(const LAS bf16x8*)(VT + (e0 + c) * 40 + 8 * q), b = *(const LAS bf16x8*)(Ps + i * 40 + 8 * q); ao = MFMA16(a, b, ao); }
            { const bf16x4 lo = *(const LAS bf16x4*)(Qs + i * 40 + 4 * q), hi = *(const LAS bf16x4*)(Qs + i * 40 + 16 + 4 * q); ao = MFMA16(cf, mk8(lo, hi), ao); }
            const int pos = dir ? (L - 1 - (32 * n + i)) : (32 * n + i);
            u32x2 o; o.x = pk2(ao[0], ao[1]); o.y = pk2(ao[2], ao[3]);
            *(u32x2*)(HX + (size_t)(row0 + pos) * 1024 + 768 + h * 64 + e0 + 4 * q) = o;
        }
#pragma unroll
        for (int t = 0; t < 2; ++t) {
            const f32x4 dv = *(const LAS f32x4*)(dec + 16 * t + 4 * q);
            st[t] = st[t] * dv;
            const bf16x8 a = *(const LAS bf16x8*)(KgT + (16 * t + c) * 40 + 8 * q), b = *(const LAS bf16x8*)(VT + (e0 + c) * 40 + 8 * q);
            st[t] = MFMA16(a, b, st[t]);
        }
        __syncthreads();
    }
    if (s < 32) {
        float* So = F.out + O_G + ((((size_t)s * DEPTH + l) * 2 + dir) * 4 + h) * 2048;
#pragma unroll
        for (int t = 0; t < 2; ++t)
#pragma unroll
            for (int r = 0; r < 4; ++r) So[(size_t)(16 * t + 4 * q + r) * 64 + e0 + c] = st[t][r];
    }
}

__device__ __forceinline__ void mixer_phase(Ctx& F, int l) {
    LAS int* slot = (LAS int*)(F.lds + 147456 - 64);
    unsigned* qc = F.ctl + CW_QUEUE + 64 * l;
    for (;;) {
        if (F.tid == 0) slot[0] = (int)__hip_atomic_fetch_add(qc, 1u, __ATOMIC_RELAXED, __HIP_MEMORY_SCOPE_AGENT);
        __syncthreads();
        const int u = slot[0];
        __syncthreads();
        if (u >= 640) break;
        if (u < 64) { mlstm_unit(F, l, 32 + (u >> 3), (u >> 1) & 3, u & 1); }
        else if (u < 96) { const int v = u - 64; gla_unit(F, l, 32 + (v >> 2), v & 3); }
        else if (u < 128) { const int v = u - 96; ret_unit(F, l, 32 + (v >> 2), v & 3); }
        else if (u < 384) { const int v = u - 128; mlstm_unit(F, l, v >> 3, (v >> 1) & 3, v & 1); }
        else if (u < 512) { const int v = u - 384; gla_unit(F, l, v >> 2, v & 3); }
        else { const int v = u - 512; ret_unit(F, l, v >> 2, v & 3); }
    }
}

__global__ void __launch_bounds__(512, 2) fwd_kernel(Args args) {
    extern __shared__ __attribute__((aligned(16))) unsigned char lds_raw[];
    Ctx F;
    F.lds = (LAS unsigned char*)lds_raw;
    F.tid = threadIdx.x; F.lane = F.tid & 63; F.wave = __builtin_amdgcn_readfirstlane(F.tid >> 6); F.G = gridDim.x; F.bid = blockIdx.x;
    F.x_prompt = args.in[0]; F.x_sample = args.in[1]; F.st_C = args.in[2]; F.st_n = args.in[3]; F.st_m = args.in[4]; F.st_ret = args.in[5]; F.st_gla = args.in[6];
    F.cvec = args.in[7]; F.c_ctx = args.in[8]; F.norm_g = args.in[9]; F.w_ada = args.in[10]; F.b_ada = args.in[11]; F.w_in = args.in[12]; F.gate_b = args.in[13];
    F.ret_logit = args.in[14]; F.gla_w2 = args.in[15]; F.gla_b2 = args.in[16]; F.hn_g = args.in[17]; F.w_out = args.in[18]; F.final_g = args.in[19];
    F.out = args.out; unsigned char* ws = args.ws;
    F.ctl = (unsigned*)(ws + WS_CTL); F.mod = (float*)(ws + WS_MOD); F.WinT = (bf16*)(ws + WS_WIN); F.WoutT = (bf16*)(ws + WS_WOUT);
    F.R1 = (bf16*)(ws + WS_R1); F.R2 = (bf16*)(ws + WS_R2); F.PROJ = (bf16*)(ws + WS_PROJ);
    const int lo = args.ph_lo, hi = args.ph_hi;
#if N_LAUNCH_MODE == 1
    cg::grid_group grid = cg::this_grid();
    if (F.tid < 8) ((LAS unsigned*)(F.lds + LDS_BYTES - 32))[F.tid] = 0u;
    __syncthreads();
    const XcdBarrier xbar = xcd_barrier_post(F.ctl + CW_BAR, (volatile LAS unsigned*)(F.lds + LDS_BYTES - 32));
#define SEAM(k) do { if (lo <= (k) && (k) + 1 < hi) { if ((k) == 0) grid.sync(); else xcd_barrier(xbar); } } while (0)
#else
#define SEAM(k) do { } while (0)
#endif
#define IN(k) (lo <= (k) && (k) < hi)
    int ph = 0;
    if (IN(ph)) { p0_prologue(F); } SEAM(ph); ++ph;
    for (int l = 0; l < DEPTH; ++l) {
        if (IN(ph)) { hprep_phase(F, l); } SEAM(ph); ++ph;
        if (IN(ph)) {
            pg8::Gemm g{F.R1, F.WinT + (size_t)l * DINP * 1024, NTOK, DINP, 1024}; pg8::StaticOrder S; S.init(NTOK, DINP, F.G, F.bid);
            pg8::EpiBf16 E{F.PROJ, DINP};
            pg8::gemm_phase<pg8::EpiBf16, pg8::StaticOrder, true, true>(F.lds, g, S, E);
        } SEAM(ph); ++ph;
        if (IN(ph)) { mixer_phase(F, l); } SEAM(ph); ++ph;
        if (IN(ph)) { yprep_phase(F, l); } SEAM(ph); ++ph;
        if (IN(ph)) {
            pg8::Gemm g{F.R1, F.WoutT + (size_t)l * 1024 * 1024, NTOK, 1024, 1024}; pg8::StaticOrder S; S.init(NTOK, 1024, F.G, F.bid);
            pg8::EpiResid E{l == 0 ? F.x_prompt : F.out, l == 0 ? F.x_sample : F.out + (size_t)NCTX * 1024, F.out, F.mod + (size_t)l * 9 * 3072 + 2048};
            pg8::gemm_phase<pg8::EpiResid, pg8::StaticOrder, true, true>(F.lds, g, S, E);
        } SEAM(ph); ++ph;
    }
    if (IN(ph)) { final_phase(F); }
}

extern "C" void kernel_launch(void* const* d_in, const int* in_sizes, int n_in, void* d_out, int out_size, void* d_ws, size_t ws_size, hipStream_t stream) {
    static int grid = 0;
    if (grid == 0) {
        if (n_in != 20 || out_size != (int)O_END || ws_size < WS_END) { fprintf(stderr, "kernel_launch: unexpected shapes: n_in %d out %d ws %zu\n", n_in, out_size, ws_size); grid = -1; return; }
        int dev = 0, cus = 0, per_cu = 0;
        if (hipGetDevice(&dev) != hipSuccess || hipDeviceGetAttribute(&cus, hipDeviceAttributeMultiprocessorCount, dev) != hipSuccess) { grid = -1; return; }
        if (hipFuncSetAttribute((const void*)fwd_kernel, hipFuncAttributeMaxDynamicSharedMemorySize, LDS_BYTES) != hipSuccess) { fprintf(stderr, "kernel_launch: hipFuncSetAttribute failed\n"); grid = -1; return; }
        if (hipOccupancyMaxActiveBlocksPerMultiprocessor(&per_cu, (const void*)fwd_kernel, 512, LDS_BYTES) != hipSuccess || per_cu < 1) { fprintf(stderr, "kernel_launch: occupancy query says %d blocks per CU\n", per_cu); per_cu = 1; }
        (void)hipGetLastError();
        grid = cus;
    }
    if (grid < 0) return;
    (void)hipMemsetAsync((char*)d_ws + WS_CTL, 0, CTL_ZERO_BYTES, stream);
    Args a{};
    for (int i = 0; i < 20; ++i) a.in[i] = (const float*)d_in[i];
    a.out = (float*)d_out; a.ws = (unsigned char*)d_ws;
#if N_LAUNCH_MODE == 1
    a.ph_lo = 0; a.ph_hi = NPHASE;
    void* kargs[] = {&a};
    hipError_t e = hipLaunchCooperativeKernel((const void*)fwd_kernel, dim3(grid), dim3(512), kargs, LDS_BYTES, stream);
    if (e != hipSuccess) fprintf(stderr, "kernel_launch: cooperative launch failed: %s (grid %d)\n", hipGetErrorString(e), grid);
#else
    for (int p = 0; p < NPHASE; ++p) { a.ph_lo = p; a.ph_hi = p + 1; hipLaunchKernelGGL(fwd_kernel, dim3(grid), dim3(512), LDS_BYTES, stream, a); }
#endif
}
```

```cpp
#include <hip/hip_runtime.h>
#include <hip/hip_cooperative_groups.h>
#include <cstdio>
#include <cstdint>
namespace cg = cooperative_groups;

#ifndef N_LAUNCH_MODE
#define N_LAUNCH_MODE 1
#endif

#define LAS __attribute__((address_space(3)))
typedef unsigned short bf16;
typedef short bf16x8 __attribute__((ext_vector_type(8)));
typedef short bf16x4 __attribute__((ext_vector_type(4)));
typedef float f32x4 __attribute__((ext_vector_type(4)));
typedef unsigned u32x4 __attribute__((ext_vector_type(4)));
typedef unsigned u32x2 __attribute__((ext_vector_type(2)));

namespace pg8 {
#define PG8_LAS __attribute__((address_space(3)))
typedef unsigned short bf16_t;
constexpr int BM = 256, BK = 64, HALF = 128, HTB = HALF * BK * 2, STAGE_BYTES = 8 * HTB, NXCD = 8, WGM = 8;

__host__ __device__ __forceinline__ int lds_byte(int r, int c) { const int st = (r >> 4) * 2 + (c >> 5), rr = r & 15, cc = c & 31, ob = rr * 64 + cc * 2; return st * 1024 + (ob ^ (((ob >> 9) & 1) << 5)); }
__host__ __device__ __forceinline__ void stage_rc(int b, int& R, int& C) { const int st = b / 1024, sb = b % 1024, swz = sb ^ (((sb >> 9) & 1) << 5); R = (st >> 1) * 16 + swz / 64; C = (st & 1) * 32 + (swz % 64) / 2; }
__host__ __device__ __forceinline__ int perm32(int rho) { const int n = rho >> 4, i = rho & 15; return 8 * (i >> 2) + 4 * n + (i & 3); }

struct Unit { int pm, pn; };
struct Gemm { const bf16_t* A; const bf16_t* Bt; int M, N, K; };

struct StaticOrder {
    int nM, nN, nwg, G, c;
    __host__ __device__ void init(int M, int N, int G_, int c_) { nM = M / BM; nN = N / BM; nwg = nM * nN; G = G_; c = c_; }
    __host__ __device__ bool next(int i, Unit& u) const {
        const long L = (long)i * G + c; if (L >= nwg) return false;
        int wgid = (int)L; { const int q = nwg / NXCD, r = nwg % NXCD, xcd = wgid % NXCD, off = wgid / NXCD; wgid = (xcd < r ? xcd * (q + 1) : r * (q + 1) + (xcd - r) * q) + off; }
        const int nig = WGM * nN, gid = wgid / nig, fm = gid * WGM, gsz = (nM - fm) < WGM ? (nM - fm) : WGM;
        u.pm = fm + ((wgid % nig) % gsz); u.pn = (wgid % nig) / gsz; return true;
    }
    __device__ __forceinline__ void a_ready(const Unit&) const {}
    __device__ __forceinline__ void done(const Unit&) const {}
};

__device__ __forceinline__ unsigned cvt_pk_bf16(float lo, float hi) { unsigned r; asm volatile("v_cvt_pk_bf16_f32 %0, %1, %2" : "=v"(r) : "v"(lo), "v"(hi)); return r; }

struct EpiBf16 {
    static constexpr bool PERM = true, AFTER_DRAIN = false;
    bf16_t* O; int ldc;
    __device__ __forceinline__ void operator()(const f32x4 (&acc)[2][2][4][2], const Unit& u, int wr, int wc, int fr, int fq) const {
        const int row0 = u.pm * BM + wr * 64 + fr; const int col0 = u.pn * BM + wc * 32 + 8 * fq;
#pragma unroll
        for (int ai = 0; ai < 2; ++ai)
#pragma unroll
            for (int m = 0; m < 4; ++m) { bf16_t* rowp = O + (size_t)(row0 + ai * HALF + m * 16) * ldc + col0;
#pragma unroll
                for (int bj = 0; bj < 2; ++bj) { const f32x4 v0 = acc[ai][bj][m][0], v1 = acc[ai][bj][m][1];
                    u32x4 w; w.x = cvt_pk_bf16(v0[0], v0[1]); w.y = cvt_pk_bf16(v0[2], v0[3]); w.z = cvt_pk_bf16(v1[0], v1[1]); w.w = cvt_pk_bf16(v1[2], v1[3]);
                    *(u32x4*)(rowp + bj * HALF) = w; } }
    }
};
struct EpiResid {
    static constexpr bool PERM = false, AFTER_DRAIN = false;
    const float* xin0; const float* xin1;
    float* xout; const float* gate;
    __device__ __forceinline__ void operator()(const f32x4 (&acc)[2][2][4][2], const Unit& u, int wr, int wc, int fr, int fq) const {
        const int row0 = u.pm * BM + wr * 64 + fr, col0 = u.pn * BM + wc * 32 + 4 * fq;
#pragma unroll
        for (int ai = 0; ai < 2; ++ai)
#pragma unroll
            for (int m = 0; m < 4; ++m) { const int row = row0 + ai * HALF + m * 16;
                const float* xr = (row < 8192 ? xin0 + (size_t)row * 1024 : xin1 + (size_t)(row - 8192) * 1024) + col0;
                const float* gr = gate + (size_t)(row < 8192 ? 0 : 1 + ((row - 8192) >> 10)) * 3072 + col0;
                float* orow = xout + (size_t)row * 1024 + col0;
#pragma unroll
                for (int bj = 0; bj < 2; ++bj)
#pragma unroll
                    for (int n = 0; n < 2; ++n) { const f32x4 xv = *(const f32x4*)(xr + bj * HALF + n * 16), gv = *(const f32x4*)(gr + bj * HALF + n * 16);
                        *(f32x4*)(orow + bj * HALF + n * 16) = xv + gv * acc[ai][bj][m][n]; } }
    }
};

template <class Epi, class Sched, bool ALIGN_EPI = false, bool SP2 = false>
__device__ __forceinline__ void gemm_phase(PG8_LAS unsigned char* lds, const Gemm g, const Sched& S, const Epi& E) {
    int tid_ = threadIdx.x; asm volatile("" : "+v"(tid_));
    const int tid = tid_, wid = __builtin_amdgcn_readfirstlane(tid >> 6), lane = tid & 63, wr = wid >> 2, wc = wid & 3, fr = lane & 15, fq = lane >> 4;
    const int K = g.K, nt = K / BK;
    unsigned voffA[2], voffB[2];
#pragma unroll
    for (int i = 0; i < 2; ++i) { int R, C; stage_rc(tid * 16 + i * 8192, R, C); const int Rb = Epi::PERM ? ((R & ~31) + perm32(R & 31)) : R;
        voffA[i] = (unsigned)(R * K + C) * 2u; voffB[i] = (unsigned)(Rb * K + C) * 2u; }
    const size_t kstep = (size_t)(BK * 2);
    const size_t hstep = (size_t)HALF * K * 2;
    const size_t tstep = 2 * hstep;
    const unsigned ldsw = (unsigned)wid * 1024u;
    const int aoff = lds_byte(wr * 64 + fr, fq * 8), boff = lds_byte(wc * 32 + fr, fq * 8);
#define PG8_SA(b, h) (((b) * 2 + (h)) * HTB)
#define PG8_SB(b, h) ((4 + (b) * 2 + (h)) * HTB)
#define PG8_STAGE(bufoff, gbase, voff) do { _Pragma("unroll") for (int _i = 0; _i < 2; ++_i) \
        __builtin_amdgcn_global_load_lds((const unsigned*)((const char*)(gbase) + (voff)[_i]), (PG8_LAS unsigned*)(lds + (bufoff) + ldsw + _i * 8192), 16, 0, 0); } while (0)
#define PG8_LDA(dst, b, h) do { _Pragma("unroll") for (int m = 0; m < 4; ++m) _Pragma("unroll") for (int k = 0; k < 2; ++k) dst[m][k] = *(const PG8_LAS bf16x8*)(lds + PG8_SA(b, h) + aoff + m * 2048 + k * 1024); } while (0)
#define PG8_LDB(dst, b, h) do { _Pragma("unroll") for (int n = 0; n < 2; ++n) _Pragma("unroll") for (int k = 0; k < 2; ++k) dst[n][k] = *(const PG8_LAS bf16x8*)(lds + PG8_SB(b, h) + boff + n * 2048 + k * 1024); } while (0)
#define PG8_MMA(ai, bj, At, Bt) do { __builtin_amdgcn_s_setprio(1); _Pragma("unroll") for (int m = 0; m < 4; ++m) _Pragma("unroll") for (int n = 0; n < 2; ++n) _Pragma("unroll") for (int k = 0; k < 2; ++k) \
        acc[ai][bj][m][n] = __builtin_amdgcn_mfma_f32_16x16x32_bf16(Bt[n][k], At[m][k], acc[ai][bj][m][n], 0, 0, 0); __builtin_amdgcn_s_setprio(0); } while (0)
#define PG8_WAIT_V(n) asm volatile("s_waitcnt vmcnt(" #n ")" ::: "memory")
#define PG8_WAIT_L(n) asm volatile("s_waitcnt lgkmcnt(" #n ")" ::: "memory")
#define PG8_BAR __builtin_amdgcn_s_barrier()
#define PG8_SCHED __builtin_amdgcn_sched_barrier(0)
    Unit cur, nxt; int ui = 0;
    if (!S.next(0, cur)) return;
    f32x4 acc[2][2][4][2];
#pragma unroll
    for (int a = 0; a < 2; ++a)
#pragma unroll
        for (int b = 0; b < 2; ++b)
#pragma unroll
            for (int m = 0; m < 4; ++m)
#pragma unroll
                for (int n = 0; n < 2; ++n) acc[a][b][m][n] = (f32x4){0.f, 0.f, 0.f, 0.f};
    bf16x8 At[4][2], B0[2][2], B1[2][2];
    const char* cA = (const char*)g.A + (size_t)cur.pm * tstep; const char* cB = (const char*)g.Bt + (size_t)cur.pn * tstep;
    S.a_ready(cur);
    if constexpr (SP2) {
        PG8_STAGE(PG8_SB(0, 0), cB, voffB); PG8_STAGE(PG8_SB(0, 1), cB + hstep, voffB); PG8_STAGE(PG8_SA(0, 0), cA, voffA); PG8_STAGE(PG8_SA(0, 1), cA + hstep, voffA);
        if (wr == 1) PG8_BAR;
        PG8_WAIT_V(2); PG8_BAR;
        PG8_STAGE(PG8_SB(1, 0), cB + kstep, voffB); PG8_STAGE(PG8_SA(1, 0), cA + kstep, voffA); PG8_STAGE(PG8_SB(1, 1), cB + hstep + kstep, voffB);
        PG8_WAIT_V(6); PG8_BAR;
    } else {
        PG8_STAGE(PG8_SB(0, 0), cB, voffB); PG8_STAGE(PG8_SA(0, 0), cA, voffA); PG8_STAGE(PG8_SB(0, 1), cB + hstep, voffB); PG8_STAGE(PG8_SA(0, 1), cA + hstep, voffA);
        if (wr == 1) PG8_BAR;
        PG8_WAIT_V(4); PG8_BAR;
        PG8_STAGE(PG8_SB(1, 0), cB + kstep, voffB); PG8_STAGE(PG8_SA(1, 0), cA + kstep, voffA); PG8_STAGE(PG8_SB(1, 1), cB + hstep + kstep, voffB);
        PG8_WAIT_V(6); PG8_BAR;
    }
    for (;;) {
        const bool has_next = S.next(ui + 1, nxt);
        const char* nA = has_next ? (const char*)g.A + (size_t)nxt.pm * tstep : cA; const char* nB = has_next ? (const char*)g.Bt + (size_t)nxt.pn * tstep : cB;
        for (int t = 0; t < nt; t += 2) {
            const bool last = (t == nt - 2);
            const char* a1 = cA + (size_t)(t + 1) * kstep;
            const char* a2 = last ? nA : cA + (size_t)(t + 2) * kstep; const char* b2 = last ? nB : cB + (size_t)(t + 2) * kstep;
            const char* a3 = a2 + kstep; const char* b3 = b2 + kstep;
            if (last && has_next) S.a_ready(nxt);
            if constexpr (SP2) {
            PG8_LDB(B0, 0, 0); PG8_LDB(B1, 0, 1); PG8_SCHED; PG8_LDA(At, 0, 0); PG8_STAGE(PG8_SA(1, 1), a1 + hstep, voffA);
            PG8_WAIT_V(8); PG8_WAIT_L(0); PG8_BAR; PG8_MMA(0, 0, At, B0); PG8_MMA(0, 1, At, B1); PG8_BAR; PG8_SCHED;
            PG8_LDA(At, 0, 1); PG8_STAGE(PG8_SB(0, 0), b2, voffB); PG8_STAGE(PG8_SB(0, 1), b2 + hstep, voffB); PG8_STAGE(PG8_SA(0, 0), a2, voffA);
            PG8_WAIT_V(8); PG8_WAIT_L(0); PG8_BAR; PG8_MMA(1, 0, At, B0); PG8_MMA(1, 1, At, B1); PG8_BAR; PG8_SCHED;
            PG8_LDB(B0, 1, 0); PG8_LDB(B1, 1, 1); PG8_SCHED; PG8_LDA(At, 1, 0); PG8_STAGE(PG8_SA(0, 1), a2 + hstep, voffA);
            PG8_WAIT_V(8); PG8_WAIT_L(0); PG8_BAR; PG8_MMA(0, 0, At, B0); PG8_MMA(0, 1, At, B1); PG8_BAR; PG8_SCHED;
            PG8_LDA(At, 1, 1); PG8_STAGE(PG8_SB(1, 0), b3, voffB); PG8_STAGE(PG8_SB(1, 1), b3 + hstep, voffB); PG8_STAGE(PG8_SA(1, 0), a3, voffA);
            PG8_WAIT_V(8); PG8_WAIT_L(0); PG8_BAR; PG8_MMA(1, 0, At, B0); PG8_MMA(1, 1, At, B1); PG8_BAR; PG8_SCHED;
            } else {
            PG8_LDB(B0, 0, 0); PG8_SCHED; PG8_LDA(At, 0, 0); PG8_STAGE(PG8_SA(1, 1), a1 + hstep, voffA);
            PG8_WAIT_L(8); PG8_BAR; PG8_WAIT_L(0); PG8_MMA(0, 0, At, B0); PG8_BAR; PG8_SCHED;
            PG8_LDB(B1, 0, 1); PG8_STAGE(PG8_SB(0, 0), b2, voffB);
            PG8_BAR; PG8_WAIT_L(0); PG8_MMA(0, 1, At, B1); PG8_BAR;
            PG8_LDA(At, 0, 1); PG8_STAGE(PG8_SA(0, 0), a2, voffA);
            PG8_BAR; PG8_WAIT_L(0); PG8_MMA(1, 0, At, B0); PG8_BAR; PG8_SCHED;
            PG8_STAGE(PG8_SB(0, 1), b2 + hstep, voffB);
            PG8_WAIT_V(6); PG8_BAR; PG8_MMA(1, 1, At, B1); PG8_BAR;
            PG8_LDB(B0, 1, 0); PG8_SCHED; PG8_LDA(At, 1, 0); PG8_STAGE(PG8_SA(0, 1), a2 + hstep, voffA);
            PG8_WAIT_L(8); PG8_BAR; PG8_WAIT_L(0); PG8_MMA(0, 0, At, B0); PG8_BAR; PG8_SCHED;
            PG8_LDB(B1, 1, 1); PG8_STAGE(PG8_SB(1, 0), b3, voffB);
            PG8_BAR; PG8_WAIT_L(0); PG8_MMA(0, 1, At, B1); PG8_BAR;
            PG8_LDA(At, 1, 1); PG8_STAGE(PG8_SA(1, 0), a3, voffA);
            PG8_BAR; PG8_WAIT_L(0); PG8_MMA(1, 0, At, B0); PG8_BAR; PG8_SCHED;
            PG8_STAGE(PG8_SB(1, 1), b3 + hstep, voffB);
            PG8_WAIT_V(6); PG8_BAR; PG8_MMA(1, 1, At, B1); PG8_BAR;
            }
        }
        if constexpr (ALIGN_EPI) { if (wr == 0) PG8_BAR; }
        if constexpr (!Epi::AFTER_DRAIN) { E(acc, cur, wr, wc, fr, fq); S.done(cur); }
        if (!has_next) break;
#pragma unroll
        for (int a = 0; a < 2; ++a)
#pragma unroll
            for (int b = 0; b < 2; ++b)
#pragma unroll
                for (int m = 0; m < 4; ++m)
#pragma unroll
                    for (int n = 0; n < 2; ++n) acc[a][b][m][n] = (f32x4){0.f, 0.f, 0.f, 0.f};
        cur = nxt; cA = nA; cB = nB; ++ui;
        if constexpr (ALIGN_EPI) { if (wr == 1) PG8_BAR; }
    }
    PG8_WAIT_V(0);
    if constexpr (!ALIGN_EPI) { if (wr == 0) PG8_BAR; }
    PG8_BAR;
#undef PG8_SA
#undef PG8_SB
#undef PG8_STAGE
#undef PG8_LDA
#undef PG8_LDB
#undef PG8_MMA
#undef PG8_WAIT_V
#undef PG8_WAIT_L
#undef PG8_BAR
#undef PG8_SCHED
}
}


#define XB_TMO      128
#define XB_XCNT(j)  (256  + 64 * (j))
#define XB_XSUB(j)  (1280 + 64 * (j))
#define XB_XGEN(j)  (2304 + 64 * (j))
#define XB_TOP      3328
#define XB_TOPGEN   3392
#define XCD_BAR_WORDS 3456
#define XB_SPIN_CAP (1u << 18)
__device__ __forceinline__ unsigned xb_ld(unsigned* p)              { return __hip_atomic_load(p, __ATOMIC_RELAXED, __HIP_MEMORY_SCOPE_AGENT); }
__device__ __forceinline__ unsigned xb_add(unsigned* p, unsigned v) { return __hip_atomic_fetch_add(p, v, __ATOMIC_RELAXED, __HIP_MEMORY_SCOPE_AGENT); }
__device__ __forceinline__ unsigned xb_xcc_id() { return (unsigned)__builtin_amdgcn_s_getreg((3 << 11) | 20) & 0xFu; }
#define XB_SPIN(cond, bar) do { unsigned _sp = 0; while (cond) { __builtin_amdgcn_s_sleep(1); \
    if ((++_sp & 255u) == 0u) { if (xb_ld(&(bar)[XB_TMO])) break; if (_sp > XB_SPIN_CAP) { atomicAdd(&(bar)[XB_TMO], 1u); break; } } } } while (0)
struct XcdBarrier { unsigned* bar; unsigned x; volatile LAS unsigned* st; };
__device__ __forceinline__ XcdBarrier xcd_barrier_post(unsigned* bar, volatile LAS unsigned* st) {
    XcdBarrier b; b.bar = bar; b.x = xb_xcc_id(); b.st = st;
    if (threadIdx.x == 0) (void)xb_add(&bar[XB_XCNT(b.x)], 1u);
    return b;
}
__device__ __forceinline__ void xcd_barrier_complete(unsigned* bar, unsigned x, unsigned& nloc, unsigned& nx) {
    const unsigned G = gridDim.x * gridDim.y * gridDim.z;
    unsigned sum, cnt, mine, sp = 0u;
    for (;;) {
        sum = 0u; cnt = 0u; mine = 0u;
#pragma unroll
        for (unsigned j = 0; j < 16; ++j) { const unsigned c = xb_ld(&bar[XB_XCNT(j)]); sum += c; cnt += (c > 0u) ? 1u : 0u; mine = (j == x) ? c : mine; }
        if (sum == G) break;
        __builtin_amdgcn_s_sleep(1);
        if ((++sp & 255u) == 0u) { if (xb_ld(&bar[XB_TMO])) break; if (sp > XB_SPIN_CAP) { atomicAdd(&bar[XB_TMO], 1u); break; } }
    }
    nloc = mine > 0u ? mine : 1u; nx = cnt > 0u ? cnt : 1u;
}
__device__ __forceinline__ void xcd_barrier(const XcdBarrier& b) {
    asm volatile("s_waitcnt vmcnt(0)" ::: "memory");
    __syncthreads();
    if (threadIdx.x == 0) {
        unsigned* bar = b.bar;
        __builtin_amdgcn_s_waitcnt(0);
        unsigned nloc = b.st[0], nx = b.st[1];
        if (nloc == 0u) { xcd_barrier_complete(bar, b.x, nloc, nx); b.st[0] = nloc; b.st[1] = nx; }
        const unsigned old = xb_add(&bar[XB_XSUB(b.x)], 1u);
        const unsigned gen = old / nloc;
        if (old + 1u == (gen + 1u) * nloc) {
            __builtin_amdgcn_fence(__ATOMIC_RELEASE, "agent");
            asm volatile("s_waitcnt vmcnt(0)" ::: "memory");
            const unsigned og = xb_add(&bar[XB_TOP], 1u);
            const unsigned tg = og / nx;
            if (og + 1u == (tg + 1u) * nx) xb_add(&bar[XB_TOPGEN], 1u);
            else XB_SPIN(xb_ld(&bar[XB_TOPGEN]) == tg, bar);
            __builtin_amdgcn_fence(__ATOMIC_ACQUIRE, "agent");
            xb_add(&bar[XB_XGEN(b.x)], 1u);
            asm volatile("s_waitcnt vmcnt(0)" ::: "memory");
        } else {
            XB_SPIN(xb_ld(&bar[XB_XGEN(b.x)]) == gen, bar);
            __builtin_amdgcn_fence(__ATOMIC_ACQUIRE, "agent");
            asm volatile("s_waitcnt vmcnt(0)" ::: "memory");
        }
    }
    __syncthreads();
}

constexpr int DM = 1024, DEPTH = 4, NTOK = 16384, NCTX = 8192;
constexpr int DIN = 4400, DINP = 4608;
constexpr int NSEQ = 40;
constexpr int C_AQ = 0, C_AK = 512, C_AV = 1024, C_AO = 1536, C_AZ = 2048, C_AG = 2560, C_BQ = 2576, C_BK = 2832, C_BV = 3088, C_BZ = 3344,
              C_CQ = 3600, C_CK = 3728, C_CV = 3856, C_CZ = 4112, C_CLR = 4368;
constexpr float EPS = 1e-6f;
constexpr size_t O_Y = 0, O_C = 16777216, O_N = O_C + 16777216, O_M = O_N + 131072, O_R = O_M + 1024, O_G = O_R + 4194304, O_END = O_G + 2097152;
constexpr size_t MiB = 1u << 20;
constexpr size_t WS_CTL = 0, CTL_ZERO_BYTES = 64 * 1024;
constexpr size_t WS_MOD = 1 * MiB;
constexpr size_t WS_WIN = 2 * MiB;
constexpr size_t WS_WOUT = 38 * MiB;
constexpr size_t WS_R1 = 46 * MiB;
constexpr size_t WS_PROJ = 78 * MiB;
constexpr size_t WS_AST = 222 * MiB;
constexpr size_t WS_ANM = 286 * MiB;
constexpr size_t WS_BST = 288 * MiB;
constexpr size_t WS_CST = 304 * MiB;
constexpr size_t WS_END = 320 * MiB;
constexpr int CW_QUEUE = 64;
constexpr int CW_BAR = 4096;

constexpr int LDS_BYTES = 147456;
constexpr int NPHASE = 1 + DEPTH * 5 + 1;

__device__ __forceinline__ unsigned f2bf(float f) { unsigned u = __builtin_bit_cast(unsigned, f); return (u + 0x7fffu + ((u >> 16) & 1u)) >> 16; }
__device__ __forceinline__ unsigned pk2(float lo, float hi) { return f2bf(lo) | (f2bf(hi) << 16); }
__device__ __forceinline__ float bf2f(unsigned short b) { return __builtin_bit_cast(float, ((unsigned)b) << 16); }
__device__ __forceinline__ float bflo(unsigned u) { return __builtin_bit_cast(float, u << 16); }
__device__ __forceinline__ float bfhi(unsigned u) { return __builtin_bit_cast(float, u & 0xffff0000u); }
__device__ __forceinline__ float sigmoidf_(float x) { return 1.0f / (1.0f + __expf(-x)); }
__device__ __forceinline__ float siluf_(float x) { return x * sigmoidf_(x); }
__device__ __forceinline__ float logsigmoidf_(float x) { return fminf(x, 0.f) - log1pf(__expf(-fabsf(x))); }
__device__ __forceinline__ float wave_sum(float v) {
#pragma unroll
    for (int o = 1; o < 64; o <<= 1) v += __shfl_xor(v, o);
    return v;
}
__device__ __forceinline__ bf16x8 mk8(bf16x4 lo, bf16x4 hi) { return __builtin_shufflevector(lo, hi, 0, 1, 2, 3, 4, 5, 6, 7); }
__device__ __forceinline__ bf16x8 pack8(f32x4 a, f32x4 b) { u32x4 w; w.x = pk2(a[0], a[1]); w.y = pk2(a[2], a[3]); w.z = pk2(b[0], b[1]); w.w = pk2(b[2], b[3]); return __builtin_bit_cast(bf16x8, w); }
#define MFMA16(a, b, c) __builtin_amdgcn_mfma_f32_16x16x32_bf16((a), (b), (c), 0, 0, 0)

struct Args { const float* in[20]; float* out; unsigned char* ws; int ph_lo, ph_hi; };

struct Ctx {
    LAS unsigned char* lds; int tid, lane, wave, G, bid;
    const float *x_prompt, *x_sample, *st_C, *st_n, *st_m, *st_ret, *st_gla, *cvec, *c_ctx, *norm_g, *w_ada, *b_ada, *w_in, *gate_b, *ret_logit, *gla_w2, *gla_b2, *hn_g, *w_out, *final_g;
    float* out; unsigned* ctl; float* mod; bf16 *WinT, *WoutT, *R1, *PROJ, *Ast, *Bst, *Cst; float* Anm;
};

#define FRESH_TID(F) do { int t_ = threadIdx.x; asm volatile("" : "+v"(t_)); (F).tid = t_; (F).lane = t_ & 63; (F).wave = __builtin_amdgcn_readfirstlane(t_ >> 6); } while (0)
__device__ __forceinline__ void seq_info(int s, int& row0, int& L) { if (s < 32) { row0 = s * 256; L = 256; } else { row0 = NCTX + (s - 32) * 1024; L = 1024; } }

__device__ __forceinline__ float col_scale_in(int n) {
    if (n >= C_AK && n < C_AV) return 0.08838834764831845f;
    if (n >= C_BK && n < C_BV) return 0.125f;
    if (n >= C_CK && n < C_CV) return 0.17677669529663687f;
    return 1.0f;
}
__device__ __forceinline__ void p0_transpose_item(const float* W, int ldn, int nvalid, bool scale_in, bf16* WT, LAS float* scr, int kb, int nb, int lane) {
    const int k0 = 64 * kb, n0 = 32 * nb;
    const int n = n0 + (lane & 31); const float sc = scale_in ? col_scale_in(n) : 1.0f;
#pragma unroll 8
    for (int i = 0; i < 32; ++i) { const int kk = 2 * i + (lane >> 5); scr[kk * 33 + (lane & 31)] = (n < nvalid) ? W[(size_t)(k0 + kk) * ldn + n] * sc : 0.f; }
    asm volatile("s_waitcnt lgkmcnt(0)" ::: "memory");
    const int c = lane & 7;
#pragma unroll
    for (int j = 0; j < 4; ++j) { const int nn = (lane >> 3) + 8 * j; const LAS float* s = scr + (8 * c) * 33 + nn;
        u32x4 o; o.x = pk2(s[0 * 33], s[1 * 33]); o.y = pk2(s[2 * 33], s[3 * 33]); o.z = pk2(s[4 * 33], s[5 * 33]); o.w = pk2(s[6 * 33], s[7 * 33]);
        *(u32x4*)(WT + (size_t)(n0 + nn) * 1024 + k0 + 8 * c) = o; }
    asm volatile("s_waitcnt lgkmcnt(0)" ::: "memory");
}
__device__ __forceinline__ void p0_prologue(Ctx& F) {
    FRESH_TID(F);
    LAS float* scr = (LAS float*)(F.lds + F.wave * 8448);
    const int gw = F.bid * 8 + F.wave, NGW = F.G * 8;
    constexpr int I_IN = 16 * (DINP / 32), I_OUT = 16 * 32, I_L = I_IN + I_OUT;
    for (int it = gw; it < DEPTH * I_L; it += NGW) {
        const int l = it / I_L; int r = it % I_L;
        if (r < I_IN) p0_transpose_item(F.w_in + (size_t)l * 1024 * DIN, DIN, DIN, true, F.WinT + (size_t)l * DINP * 1024, scr, r / (DINP / 32), r % (DINP / 32), F.lane);
        else { r -= I_IN; p0_transpose_item(F.w_out + (size_t)l * 1024 * 1024, 1024, 1024, false, F.WoutT + (size_t)l * 1024 * 1024, scr, r / 32, r % 32, F.lane); }
    }
    __syncthreads();
    LAS float* sl = (LAS float*)(F.lds + 69632);
    LAS float* red = (LAS float*)(F.lds + 106496);
    bool have_sl = false;
    for (int it = F.bid; it < DEPTH * 48; it += F.G) {
        if (!have_sl) {
            for (int i = F.tid; i < 9 * 1024; i += 512) { const int r = i >> 10, k = i & 1023; const float v = r == 0 ? F.c_ctx[k] : F.cvec[(r - 1) * 1024 + k]; sl[i] = siluf_(v); }
            have_sl = true; __syncthreads();
        }
        const int l = it / 48, e0 = (it % 48) * 64, c = F.tid & 63, kg = F.tid >> 6;
        const float* wp = F.w_ada + ((size_t)l * 1024 + kg * 128) * 3072 + e0 + c;
        float acc[9];
#pragma unroll
        for (int r = 0; r < 9; ++r) acc[r] = 0.f;
#pragma unroll 4
        for (int k = 0; k < 128; ++k) { const float w = wp[(size_t)k * 3072];
#pragma unroll
            for (int r = 0; r < 9; ++r) acc[r] += sl[r * 1024 + kg * 128 + k] * w; }
#pragma unroll
        for (int r = 0; r < 9; ++r) red[(kg * 9 + r) * 64 + c] = acc[r];
        __syncthreads();
        for (int o = F.tid; o < 9 * 64; o += 512) { const int r = o >> 6, cc = o & 63; float s = F.b_ada[l * 3072 + e0 + cc];
#pragma unroll
            for (int g = 0; g < 8; ++g) s += red[(g * 9 + r) * 64 + cc];
            F.mod[((size_t)l * 9 + r) * 3072 + e0 + cc] = s; }
        __syncthreads();
    }
}

__device__ __forceinline__ void hprep_phase(Ctx& F, int l) {
    FRESH_TID(F);
    const int gw = F.bid * 8 + F.wave, NGW = F.G * 8;
    const float* g = F.norm_g + l * 1024;
    for (int m = gw; m < NTOK; m += NGW) {
        const float* xrow = (l == 0) ? (m < NCTX ? F.x_prompt + (size_t)m * 1024 : F.x_sample + (size_t)(m - NCTX) * 1024) : F.out + (size_t)m * 1024;
        const int mr = m < NCTX ? 0 : 1 + ((m - NCTX) >> 10);
        const float* md = F.mod + ((size_t)l * 9 + mr) * 3072;
        const f32x4* xr = (const f32x4*)xrow + F.lane;
        f32x4 v[4]; float s = 0.f;
#pragma unroll
        for (int j = 0; j < 4; ++j) { v[j] = xr[64 * j]; s += (v[j].x * v[j].x + v[j].y * v[j].y) + (v[j].z * v[j].z + v[j].w * v[j].w); }
        const float rstd = 1.0f / sqrtf(wave_sum(s) * (1.f / 1024.f) + EPS);
        unsigned long long* o8 = (unsigned long long*)(F.R1 + (size_t)m * 1024) + F.lane;
#pragma unroll
        for (int j = 0; j < 4; ++j) { const int c = 4 * F.lane + 256 * j;
            const f32x4 gg = *(const f32x4*)(g + c), sh = *(const f32x4*)(md + c), sc = *(const f32x4*)(md + 1024 + c);
            const f32x4 h = v[j] * rstd * gg * (sc + 1.0f) + sh;
            o8[64 * j] = (unsigned long long)pk2(h.x, h.y) | ((unsigned long long)pk2(h.z, h.w) << 32); }
    }
}
__device__ __forceinline__ void final_phase(Ctx& F) {
    FRESH_TID(F);
    const int gw = F.bid * 8 + F.wave, NGW = F.G * 8;
    for (int m = gw; m < NTOK; m += NGW) {
        f32x4* xr = (f32x4*)(F.out + (size_t)m * 1024) + F.lane;
        f32x4 v[4]; float s = 0.f;
#pragma unroll
        for (int j = 0; j < 4; ++j) { v[j] = xr[64 * j]; s += (v[j].x * v[j].x + v[j].y * v[j].y) + (v[j].z * v[j].z + v[j].w * v[j].w); }
        const float rstd = 1.0f / sqrtf(wave_sum(s) * (1.f / 1024.f) + EPS);
#pragma unroll
        for (int j = 0; j < 4; ++j) { const f32x4 gg = *(const f32x4*)(F.final_g + 4 * F.lane + 256 * j); xr[64 * j] = v[j] * rstd * gg; }
    }
}

__device__ __forceinline__ bf16x8 tr_frag(const LAS bf16* base, int RS, int row0, int col0, int c) {
    const LAS bf16* p = base + (row0 + (c >> 2)) * RS + col0 + 4 * (c & 3);
    const bf16x4 lo = __builtin_amdgcn_ds_read_tr16_b64_v4i16((LAS bf16x4*)p);
    const bf16x4 hi = __builtin_amdgcn_ds_read_tr16_b64_v4i16((LAS bf16x4*)(p + 4 * RS));
    return mk8(lo, hi);
}
__device__ __forceinline__ u32x4 scale8(u32x4 v, float g) { u32x4 o;
#pragma unroll
    for (int j = 0; j < 4; ++j) o[j] = pk2(bflo(v[j]) * g, bfhi(v[j]) * g);
    return o; }

constexpr int RSA = 136;
__device__ __forceinline__ void mlstm_chain(Ctx& F, int l, int s, int h, int dir) {
    FRESH_TID(F);
    const int tid = F.tid, lane = F.lane, w = F.wave, c = lane & 15, q = lane >> 4;
    int row0, L; seq_info(s, row0, L);
    const int nch = L / 64, e0 = 16 * w, gc0 = row0 >> 6;
    const float bi = F.gate_b[l * 16 + dir * 8 + h], bfg = F.gate_b[l * 16 + dir * 8 + 4 + h];
    f32x4 st[8], nst; float m_prev;
    if (s >= 32) {
        const size_t sb = (((size_t)(s - 32) * DEPTH + l) * 2 + dir) * 4 + h;
        const float* C0 = F.st_C + sb * 16384;
#pragma unroll
        for (int t = 0; t < 8; ++t)
#pragma unroll
            for (int r = 0; r < 4; ++r) st[t][r] = C0[(size_t)(16 * t + 4 * q + r) * 128 + e0 + c];
#pragma unroll
        for (int r = 0; r < 4; ++r) nst[r] = F.st_n[sb * 128 + 16 * w + 4 * q + r];
        m_prev = F.st_m[sb];
    } else {
#pragma unroll
        for (int t = 0; t < 8; ++t) st[t] = (f32x4){0.f, 0.f, 0.f, 0.f};
        nst = (f32x4){0.f, 0.f, 0.f, 0.f}; m_prev = 0.f;
    }
    u32x4 kr[2], vr[2]; float gi, gf;
#define A1_LOAD(nn) do { \
        const int posl_ = dir ? (L - 1 - (64 * (nn) + lane)) : (64 * (nn) + lane); \
        const bf16* gp_ = F.PROJ + (size_t)(row0 + posl_) * DINP + C_AG + dir * 8 + h; \
        gi = bf2f(gp_[0]); gf = bf2f(gp_[4]); \
        _Pragma("unroll") for (int i_ = 0; i_ < 2; ++i_) { const int p_ = tid + 512 * i_, r_ = p_ >> 4, cp_ = (p_ & 15) * 8; \
            const int pos_ = dir ? (L - 1 - (64 * (nn) + r_)) : (64 * (nn) + r_); \
            const bf16* src_ = F.PROJ + (size_t)(row0 + pos_) * DINP + h * 128 + cp_; \
            kr[i_] = *(const u32x4*)(src_ + C_AK); vr[i_] = *(const u32x4*)(src_ + C_AV); } } while (0)
    A1_LOAD(0);
    const u32x4 ones_u = (u32x4){0x3f803f80u, 0x3f803f80u, 0x3f803f80u, 0x3f803f80u};
    const bf16x8 ones = __builtin_bit_cast(bf16x8, ones_u);
    for (int n = 0; n < nch; ++n) {
        LAS bf16* Kg = (LAS bf16*)(F.lds + (n & 1) * 34816); LAS bf16* Vs = Kg + 64 * RSA;
        const float ic = gi + bi, fp = gf + bfg;
        float Fc = logsigmoidf_(fp);
#pragma unroll
        for (int o = 1; o < 64; o <<= 1) { const float t = __shfl_up(Fc, o); if (lane >= o) Fc += t; }
        const float u = ic - Fc;
        float pm = u;
#pragma unroll
        for (int o = 1; o < 64; o <<= 1) { const float t = __shfl_up(pm, o); if (lane >= o) pm = fmaxf(pm, t); }
        const float F_last = __shfl(Fc, 63), pmL = __shfl(pm, 63);
        const float gm = F_last + pmL, m_new = fmaxf(F_last + m_prev, gm);
        const float a_dec = __expf(F_last + m_prev - m_new);
        const float gate = __expf(F_last + u - m_new);
        {
            const int m = dir ? nch - 1 - n : n; const size_t slot = ((size_t)(gc0 + m) * 4 + h) * 2 + dir;
            u32x4* sp = (u32x4*)(F.Ast + slot * 16384) + (w * 4) * 64 + lane;
#pragma unroll
            for (int k = 0; k < 4; ++k) sp[k * 64] = __builtin_bit_cast(u32x4, pack8(st[2 * k], st[2 * k + 1]));
            if (c == 0) *(f32x4*)(F.Anm + slot * 132 + 16 * w + 4 * q) = nst;
            if (tid == 0) F.Anm[slot * 132 + 128] = m_prev;
        }
#pragma unroll
        for (int i = 0; i < 2; ++i) { const int p = tid + 512 * i, r = p >> 4, cp = (p & 15) * 8;
            const float gr = __shfl(gate, r);
            *(LAS u32x4*)(Kg + r * RSA + cp) = scale8(kr[i], gr); *(LAS u32x4*)(Vs + r * RSA + cp) = vr[i]; }
        if (n + 1 < nch) A1_LOAD(n + 1);
        __syncthreads();
        bf16x8 vb[2];
#pragma unroll
        for (int k = 0; k < 2; ++k) vb[k] = tr_frag(Vs, RSA, 32 * k + 8 * q, e0, c);
#pragma unroll
        for (int t = 0; t < 8; ++t) {
            st[t] = st[t] * a_dec;
#pragma unroll
            for (int k = 0; k < 2; ++k) st[t] = MFMA16(tr_frag(Kg, RSA, 32 * k + 8 * q, 16 * t, c), vb[k], st[t]);
        }
        f32x4 nacc = (f32x4){0.f, 0.f, 0.f, 0.f};
#pragma unroll
        for (int k = 0; k < 2; ++k) nacc = MFMA16(tr_frag(Kg, RSA, 32 * k + 8 * q, 16 * w, c), ones, nacc);
        nst = nst * a_dec + nacc;
        m_prev = m_new;
    }
#undef A1_LOAD
    if (s < 32) {
        const size_t sb = (((size_t)s * DEPTH + l) * 2 + dir) * 4 + h;
        float* Co = F.out + O_C + sb * 16384;
#pragma unroll
        for (int t = 0; t < 8; ++t)
#pragma unroll
            for (int r = 0; r < 4; ++r) Co[(size_t)(16 * t + 4 * q + r) * 128 + e0 + c] = st[t][r];
        if (c == 0) *(f32x4*)(F.out + O_N + sb * 128 + 16 * w + 4 * q) = nst;
        if (tid == 0) F.out[O_M + sb] = m_prev;
    }
}

__device__ __forceinline__ void rot8(float (&a)[8], float (&b)[8], int pos, int cp) {
    const float prow = (float)(pos >> 6), pcol = (float)(pos & 63);
#pragma unroll
    for (int x = 0; x < 8; ++x) { const int f = cp + x;
        const float fr = exp2f(-(float)(f & 15) * 0.8304820237218406f);
        const float ang = (f < 16 ? prow : pcol) * fr;
        const float cs = __cosf(ang), sn = __sinf(ang);
        const float t1 = a[x], t2 = b[x]; a[x] = t1 * cs - t2 * sn; b[x] = t1 * sn + t2 * cs; }
}
__device__ __forceinline__ void unpack8(u32x4 v, float (&o)[8]) {
#pragma unroll
    for (int j = 0; j < 4; ++j) { o[2 * j] = bflo(v[j]); o[2 * j + 1] = bfhi(v[j]); } }
__device__ __forceinline__ u32x4 packf8(const float (&a)[8], float g) { u32x4 o; o.x = pk2(a[0] * g, a[1] * g); o.y = pk2(a[2] * g, a[3] * g); o.z = pk2(a[4] * g, a[5] * g); o.w = pk2(a[6] * g, a[7] * g); return o; }

__device__ __forceinline__ void ret_chain(Ctx& F, int l, int s, int h) {
    FRESH_TID(F);
    const int tid = F.tid, lane = F.lane, dir = F.wave >> 2, wl = F.wave & 3, tl = tid & 255, c = lane & 15, q = lane >> 4;
    int row0, L; seq_info(s, row0, L);
    const int nch = L / 64, e0 = 16 * wl, gc0 = row0 >> 6;
    const float lg2 = logsigmoidf_(F.ret_logit[(l * 2 + dir) * 4 + h]) * 1.4426950408889634f;
    const bool rot = s >= 32;
    f32x4 st[4];
    if (s >= 32) {
        const float* S0 = F.st_ret + ((((size_t)(s - 32) * DEPTH + l) * 2 + dir) * 4 + h) * 4096;
#pragma unroll
        for (int t = 0; t < 4; ++t)
#pragma unroll
            for (int r = 0; r < 4; ++r) st[t][r] = S0[(size_t)(16 * t + 4 * q + r) * 64 + e0 + c];
    } else {
#pragma unroll
        for (int t = 0; t < 4; ++t) st[t] = (f32x4){0.f, 0.f, 0.f, 0.f};
    }
    const float g64 = exp2f(64.f * lg2);
    const int r = tl >> 2, cp = (tl & 3) * 8;
    const float gr = exp2f((float)(63 - r) * lg2);
    u32x4 k1, k2, v1, v2;
#define B1_LOAD(nn) do { const int pos_ = dir ? (L - 1 - (64 * (nn) + r)) : (64 * (nn) + r); \
        const bf16* src_ = F.PROJ + (size_t)(row0 + pos_) * DINP + h * 64 + cp; \
        k1 = *(const u32x4*)(src_ + C_BK); k2 = *(const u32x4*)(src_ + C_BK + 32); v1 = *(const u32x4*)(src_ + C_BV); v2 = *(const u32x4*)(src_ + C_BV + 32); } while (0)
    B1_LOAD(0);
    for (int n = 0; n < nch; ++n) {
        LAS bf16* Kg = (LAS bf16*)(F.lds + (dir * 2 + (n & 1)) * 18432); LAS bf16* Vs = Kg + 64 * 72;
        {
            const int m = dir ? nch - 1 - n : n; const size_t slot = ((size_t)(gc0 + m) * 4 + h) * 2 + dir;
            u32x4* sp = (u32x4*)(F.Bst + slot * 4096) + (wl * 2) * 64 + lane;
#pragma unroll
            for (int k = 0; k < 2; ++k) sp[k * 64] = __builtin_bit_cast(u32x4, pack8(st[2 * k], st[2 * k + 1]));
        }
        {
            float ka[8], kb[8]; unpack8(k1, ka); unpack8(k2, kb);
            if (rot) { const int pos = dir ? (L - 1 - (64 * n + r)) : (64 * n + r); rot8(ka, kb, pos, cp); }
            *(LAS u32x4*)(Kg + r * 72 + cp) = packf8(ka, gr); *(LAS u32x4*)(Kg + r * 72 + cp + 32) = packf8(kb, gr);
            *(LAS u32x4*)(Vs + r * 72 + cp) = v1; *(LAS u32x4*)(Vs + r * 72 + cp + 32) = v2;
        }
        if (n + 1 < nch) B1_LOAD(n + 1);
        __syncthreads();
        bf16x8 vb[2];
#pragma unroll
        for (int k = 0; k < 2; ++k) vb[k] = tr_frag(Vs, 72, 32 * k + 8 * q, e0, c);
#pragma unroll
        for (int t = 0; t < 4; ++t) {
            st[t] = st[t] * g64;
#pragma unroll
            for (int k = 0; k < 2; ++k) st[t] = MFMA16(tr_frag(Kg, 72, 32 * k + 8 * q, 16 * t, c), vb[k], st[t]);
        }
    }
#undef B1_LOAD
    if (s < 32) {
        float* So = F.out + O_R + ((((size_t)s * DEPTH + l) * 2 + dir) * 4 + h) * 4096;
#pragma unroll
        for (int t = 0; t < 4; ++t)
#pragma unroll
            for (int rr = 0; rr < 4; ++rr) So[(size_t)(16 * t + 4 * q + rr) * 64 + e0 + c] = st[t][rr];
    }
}

__device__ __forceinline__ void gla_chain(Ctx& F, int l, int s, int h) {
    FRESH_TID(F);
    const int tid = F.tid, lane = F.lane, dir = F.wave >> 2, wl = F.wave & 3, tl = tid & 255, c = lane & 15, q = lane >> 4;
    int row0, L; seq_info(s, row0, L);
    const int nch = L / 32, e0 = 16 * wl, gc0 = row0 >> 5;
    const int dl = lane & 7, jg = lane >> 3, d = 8 * wl + dl;
    float w2r[16];
#pragma unroll
    for (int r = 0; r < 16; ++r) w2r[r] = F.gla_w2[(((size_t)l * 2 + dir) * 16 + r) * 128 + h * 32 + d];
    const float b2v = F.gla_b2[((size_t)l * 2 + dir) * 128 + h * 32 + d];
    f32x4 st[2];
    if (s >= 32) {
        const float* S0 = F.st_gla + ((((size_t)(s - 32) * DEPTH + l) * 2 + dir) * 4 + h) * 2048;
#pragma unroll
        for (int t = 0; t < 2; ++t)
#pragma unroll
            for (int r = 0; r < 4; ++r) st[t][r] = S0[(size_t)(16 * t + 4 * q + r) * 64 + e0 + c];
    } else { st[0] = (f32x4){0.f, 0.f, 0.f, 0.f}; st[1] = st[0]; }
    u32x4 cl[4][2], vr; float kv[4];
    const int vrow = tl >> 3, vcp = (tl & 7) * 8;
#define C1_LOAD(nn) do { \
        _Pragma("unroll") for (int x_ = 0; x_ < 4; ++x_) { const int j_ = 4 * jg + x_; const int pos_ = dir ? (L - 1 - (32 * (nn) + j_)) : (32 * (nn) + j_); \
            const bf16* src_ = F.PROJ + (size_t)(row0 + pos_) * DINP; \
            cl[x_][0] = *(const u32x4*)(src_ + C_CLR + dir * 16); cl[x_][1] = *(const u32x4*)(src_ + C_CLR + dir * 16 + 8); kv[x_] = bf2f(src_[C_CK + h * 32 + d]); } \
        { const int pos_ = dir ? (L - 1 - (32 * (nn) + vrow)) : (32 * (nn) + vrow); vr = *(const u32x4*)(F.PROJ + (size_t)(row0 + pos_) * DINP + C_CV + h * 64 + vcp); } } while (0)
    C1_LOAD(0);
    for (int n = 0; n < nch; ++n) {
        LAS bf16* Ku = (LAS bf16*)(F.lds + (dir * 2 + (n & 1)) * 7296); LAS bf16* Vs = Ku + 32 * 40; LAS float* dec = (LAS float*)(Vs + 32 * 72);
        {
            const int m = dir ? nch - 1 - n : n; const size_t slot = ((size_t)(gc0 + m) * 4 + h) * 2 + dir;
            u32x4* sp = (u32x4*)(F.Cst + slot * 2048) + wl * 64 + lane;
            sp[0] = __builtin_bit_cast(u32x4, pack8(st[0], st[1]));
        }
        float pb[4], run = 0.f;
#pragma unroll
        for (int x = 0; x < 4; ++x) { float xx = b2v;
#pragma unroll
            for (int j = 0; j < 4; ++j) { xx += bflo(cl[x][0][j]) * w2r[2 * j] + bfhi(cl[x][0][j]) * w2r[2 * j + 1]; xx += bflo(cl[x][1][j]) * w2r[8 + 2 * j] + bfhi(cl[x][1][j]) * w2r[8 + 2 * j + 1]; }
            run += logsigmoidf_(xx) * 0.0625f; pb[x] = run; }
        float tot = run;
#pragma unroll
        for (int o = 8; o < 64; o <<= 1) { const float t = __shfl_up(tot, o); if (lane >= o) tot += t; }
        const float off = tot - run, blast = __shfl(tot, 56 + dl);
#pragma unroll
        for (int x = 0; x < 4; ++x) Ku[(4 * jg + x) * 40 + d] = (bf16)f2bf(kv[x] * __expf(blast - (off + pb[x])));
        if (jg == 0) dec[d] = __expf(blast);
        *(LAS u32x4*)(Vs + vrow * 72 + vcp) = vr;
        if (n + 1 < nch) C1_LOAD(n + 1);
        __syncthreads();
        const bf16x8 vb = tr_frag(Vs, 72, 8 * q, e0, c);
#pragma unroll
        for (int t = 0; t < 2; ++t) {
            const f32x4 dv = *(const LAS f32x4*)(dec + 16 * t + 4 * q);
            st[t] = MFMA16(tr_frag(Ku, 40, 8 * q, 16 * t, c), vb, st[t] * dv);
        }
    }
#undef C1_LOAD
    if (s < 32) {
        float* So = F.out + O_G + ((((size_t)s * DEPTH + l) * 2 + dir) * 4 + h) * 2048;
#pragma unroll
        for (int t = 0; t < 2; ++t)
#pragma unroll
            for (int r = 0; r < 4; ++r) So[(size_t)(16 * t + 4 * q + r) * 64 + e0 + c] = st[t][r];
    }
}

__device__ __forceinline__ void mixer_pass1(Ctx& F, int l, int qslot) {
    LAS int* slot = (LAS int*)(F.lds + 147456 - 64);
    unsigned* qc = F.ctl + CW_QUEUE + 64 * qslot;
    for (;;) {
        if (F.tid == 0) slot[0] = (int)__hip_atomic_fetch_add(qc, 1u, __ATOMIC_RELAXED, __HIP_MEMORY_SCOPE_AGENT);
        __syncthreads();
        const int u = slot[0];
        __syncthreads();
        if (u >= 640) break;
        int typ, s, h, dir = 0;
        if (u < 64) { typ = 0; s = 32 + (u >> 3); h = (u >> 1) & 3; dir = u & 1; }
        else if (u < 96) { const int v = u - 64; typ = 2; s = 32 + (v >> 2); h = v & 3; }
        else if (u < 128) { const int v = u - 96; typ = 1; s = 32 + (v >> 2); h = v & 3; }
        else if (u < 384) { const int v = u - 128; typ = 0; s = v >> 3; h = (v >> 1) & 3; dir = v & 1; }
        else if (u < 512) { const int v = u - 384; typ = 2; s = v >> 2; h = v & 3; }
        else { const int v = u - 512; typ = 1; s = v >> 2; h = v & 3; }
        if (typ == 0) mlstm_chain(F, l, s, h, dir); else if (typ == 1) ret_chain(F, l, s, h); else gla_chain(F, l, s, h);
    }
}

constexpr int T2_UF = 0, T2_MXF = 64, T2_UB = 128, T2_MXB = 192, T2_WAF = 256, T2_WAB = 320, T2_EMF = 384, T2_EMB = 448, T2_DPF = 512, T2_DPB = 768, T2_QNF = 1024, T2_QNB = 1088,
              T2_NVF = 1152, T2_NVB = 1280, T2_SSP = 1408;
__device__ __forceinline__ void mlstm_out(Ctx& F, int l, int s, int h, int m) {
    FRESH_TID(F);
    const int tid = F.tid, lane = F.lane, w = F.wave, c = lane & 15, q = lane >> 4;
    LAS bf16* Qs = (LAS bf16*)(F.lds); LAS bf16* Ks = (LAS bf16*)(F.lds + 17408); LAS bf16* Vs = (LAS bf16*)(F.lds + 34816);
    LAS bf16* Pf = (LAS bf16*)(F.lds + 52224); LAS bf16* Pb = (LAS bf16*)(F.lds + 61440); LAS float* tab = (LAS float*)(F.lds + 70656);
    int row0, L; seq_info(s, row0, L);
    const int e0 = 16 * w, gc = (row0 >> 6) + m, rowb = row0 + 64 * m;
    const size_t slot_f = ((size_t)gc * 4 + h) * 2, slot_b = slot_f + 1;
    u32x4 cff[4], cfb[4];
    { const u32x4* pf_ = (const u32x4*)(F.Ast + slot_f * 16384) + (w * 4) * 64 + lane; const u32x4* pb_ = (const u32x4*)(F.Ast + slot_b * 16384) + (w * 4) * 64 + lane;
#pragma unroll
      for (int k = 0; k < 4; ++k) { cff[k] = pf_[k * 64]; cfb[k] = pb_[k * 64]; } }
    const bf16* gp = F.PROJ + (size_t)(rowb + lane) * DINP + C_AG + h;
    const float i_f = bf2f(gp[0]) + F.gate_b[l * 16 + h], f_f = bf2f(gp[4]) + F.gate_b[l * 16 + 4 + h], i_b = bf2f(gp[8]) + F.gate_b[l * 16 + 8 + h], f_b = bf2f(gp[12]) + F.gate_b[l * 16 + 12 + h];
    const float mpf = F.Anm[slot_f * 132 + 128], mpb = F.Anm[slot_b * 132 + 128];
#pragma unroll
    for (int i = 0; i < 2; ++i) { const int p = tid + 512 * i, r = p >> 4, cp = (p & 15) * 8;
        const bf16* src = F.PROJ + (size_t)(rowb + r) * DINP + h * 128 + cp;
        *(LAS u32x4*)(Qs + r * RSA + cp) = *(const u32x4*)(src + C_AQ); *(LAS u32x4*)(Ks + r * RSA + cp) = *(const u32x4*)(src + C_AK); *(LAS u32x4*)(Vs + r * RSA + cp) = *(const u32x4*)(src + C_AV); }
    if (tid < 128) tab[T2_NVF + tid] = F.Anm[slot_f * 132 + tid]; else if (tid < 256) tab[T2_NVB + tid - 128] = F.Anm[slot_b * 132 + tid - 128];
    float Ff = logsigmoidf_(f_f), Fb = logsigmoidf_(f_b);
#pragma unroll
    for (int o = 1; o < 64; o <<= 1) { const float t = __shfl_up(Ff, o); if (lane >= o) Ff += t; const float t2 = __shfl_down(Fb, o); if (lane + o < 64) Fb += t2; }
    const float uf = i_f - Ff, ub = i_b - Fb;
    float pmf = uf, pmb = ub;
#pragma unroll
    for (int o = 1; o < 64; o <<= 1) { const float t = __shfl_up(pmf, o); if (lane >= o) pmf = fmaxf(pmf, t); const float t2 = __shfl_down(pmb, o); if (lane + o < 64) pmb = fmaxf(pmb, t2); }
    const float mxf = fmaxf(mpf, pmf), mxb = fmaxf(mpb, pmb);
    if (w == 0) { tab[T2_UF + lane] = uf; tab[T2_MXF + lane] = mxf; tab[T2_UB + lane] = ub; tab[T2_MXB + lane] = mxb;
        tab[T2_WAF + lane] = __expf(mpf - mxf); tab[T2_WAB + lane] = __expf(mpb - mxb); tab[T2_EMF + lane] = __expf(-(Ff + mxf)); tab[T2_EMB + lane] = __expf(-(Fb + mxb)); }
    __syncthreads();
#pragma unroll
    for (int x = 0; x < 2; ++x) {
        const int tix = w + 8 * x, jt = tix & 3, it = tix >> 2;
        f32x4 acc = (f32x4){0.f, 0.f, 0.f, 0.f};
#pragma unroll
        for (int k = 0; k < 4; ++k) acc = MFMA16(*(const LAS bf16x8*)(Ks + (16 * jt + c) * RSA + 32 * k + 8 * q), *(const LAS bf16x8*)(Qs + (16 * it + c) * RSA + 32 * k + 8 * q), acc);
        const int i = 16 * it + c, j0 = 16 * jt + 4 * q;
        const float mxfi = tab[T2_MXF + i], mxbi = tab[T2_MXB + i];
        const f32x4 ufj = *(const LAS f32x4*)(tab + T2_UF + j0), ubj = *(const LAS f32x4*)(tab + T2_UB + j0);
        float pf[4], pb[4], dsf = 0.f, dsb = 0.f;
#pragma unroll
        for (int r = 0; r < 4; ++r) { pf[r] = (j0 + r <= i) ? acc[r] * __expf(ufj[r] - mxfi) : 0.f; pb[r] = (j0 + r >= i) ? acc[r] * __expf(ubj[r] - mxbi) : 0.f; dsf += pf[r]; dsb += pb[r]; }
        dsf += __shfl_xor(dsf, 16); dsf += __shfl_xor(dsf, 32); dsb += __shfl_xor(dsb, 16); dsb += __shfl_xor(dsb, 32);
        if (q == 0) { tab[T2_DPF + jt * 64 + i] = dsf; tab[T2_DPB + jt * 64 + i] = dsb; }
        u32x2 pw; pw.x = pk2(pf[0], pf[1]); pw.y = pk2(pf[2], pf[3]); *(LAS u32x2*)(Pf + i * 72 + j0) = pw;
        pw.x = pk2(pb[0], pb[1]); pw.y = pk2(pb[2], pb[3]); *(LAS u32x2*)(Pb + i * 72 + j0) = pw;
    }
    {
        const int i = tid >> 3, d0 = (tid & 7) * 16;
        const u32x4 qa = *(const LAS u32x4*)(Qs + i * RSA + d0), qb = *(const LAS u32x4*)(Qs + i * RSA + d0 + 8);
        float sf = 0.f, sb = 0.f;
#pragma unroll
        for (int j = 0; j < 4; ++j) { const float a0 = bflo(qa[j]), a1 = bfhi(qa[j]), b0 = bflo(qb[j]), b1 = bfhi(qb[j]);
            sf += a0 * tab[T2_NVF + d0 + 2 * j] + a1 * tab[T2_NVF + d0 + 2 * j + 1] + b0 * tab[T2_NVF + d0 + 8 + 2 * j] + b1 * tab[T2_NVF + d0 + 8 + 2 * j + 1];
            sb += a0 * tab[T2_NVB + d0 + 2 * j] + a1 * tab[T2_NVB + d0 + 2 * j + 1] + b0 * tab[T2_NVB + d0 + 8 + 2 * j] + b1 * tab[T2_NVB + d0 + 8 + 2 * j + 1]; }
        sf += __shfl_xor(sf, 1); sf += __shfl_xor(sf, 2); sf += __shfl_xor(sf, 4); sb += __shfl_xor(sb, 1); sb += __shfl_xor(sb, 2); sb += __shfl_xor(sb, 4);
        if ((tid & 7) == 0) { tab[T2_QNF + i] = sf; tab[T2_QNB + i] = sb; }
    }
    __syncthreads();
    bf16x8 vf[2];
#pragma unroll
    for (int k = 0; k < 2; ++k) vf[k] = tr_frag(Vs, RSA, 32 * k + 8 * q, e0, c);
    f32x4 ya[4];
#pragma unroll
    for (int it = 0; it < 4; ++it) {
        const int i = 16 * it + c;
        f32x4 aof = (f32x4){0.f, 0.f, 0.f, 0.f}, aob = aof, aif = aof, aib = aof;
        aof = MFMA16(vf[0], *(const LAS bf16x8*)(Pf + i * 72 + 8 * q), aof);
        if (it >= 2) aof = MFMA16(vf[1], *(const LAS bf16x8*)(Pf + i * 72 + 32 + 8 * q), aof);
        aob = MFMA16(vf[1], *(const LAS bf16x8*)(Pb + i * 72 + 32 + 8 * q), aob);
        if (it < 2) aob = MFMA16(vf[0], *(const LAS bf16x8*)(Pb + i * 72 + 8 * q), aob);
#pragma unroll
        for (int k = 0; k < 4; ++k) {
            const bf16x8 qp = mk8(*(const LAS bf16x4*)(Qs + i * RSA + 32 * k + 4 * q), *(const LAS bf16x4*)(Qs + i * RSA + 32 * k + 16 + 4 * q));
            aif = MFMA16(__builtin_bit_cast(bf16x8, cff[k]), qp, aif); aib = MFMA16(__builtin_bit_cast(bf16x8, cfb[k]), qp, aib); }
        const float waf = tab[T2_WAF + i], wab = tab[T2_WAB + i];
        const float denf = tab[T2_DPF + i] + tab[T2_DPF + 64 + i] + tab[T2_DPF + 128 + i] + tab[T2_DPF + 192 + i] + waf * tab[T2_QNF + i];
        const float denb = tab[T2_DPB + i] + tab[T2_DPB + 64 + i] + tab[T2_DPB + 128 + i] + tab[T2_DPB + 192 + i] + wab * tab[T2_QNB + i];
        const float rdf = 1.0f / fmaxf(fabsf(denf), tab[T2_EMF + i]), rdb = 1.0f / fmaxf(fabsf(denb), tab[T2_EMB + i]);
        const f32x4 hv = (aof + aif * waf) * rdf + (aob + aib * wab) * rdb;
        const u32x2 og = *(const u32x2*)(F.PROJ + (size_t)(rowb + i) * DINP + C_AO + h * 128 + e0 + 4 * q);
        f32x4 y; y[0] = hv[0] * sigmoidf_(bflo(og.x)); y[1] = hv[1] * sigmoidf_(bfhi(og.x)); y[2] = hv[2] * sigmoidf_(bflo(og.y)); y[3] = hv[3] * sigmoidf_(bfhi(og.y));
        ya[it] = y;
        float ss = (y[0] * y[0] + y[1] * y[1]) + (y[2] * y[2] + y[3] * y[3]);
        ss += __shfl_xor(ss, 16); ss += __shfl_xor(ss, 32);
        if (q == 0) tab[T2_SSP + w * 64 + i] = ss;
    }
    __syncthreads();
    const f32x4 hg = *(const f32x4*)(F.hn_g + l * 1024 + h * 128 + e0 + 4 * q);
#pragma unroll
    for (int it = 0; it < 4; ++it) {
        const int i = 16 * it + c;
        float ss = 0.f;
#pragma unroll
        for (int ww = 0; ww < 8; ++ww) ss += tab[T2_SSP + ww * 64 + i];
        const float rs = 1.0f / sqrtf(ss * (1.f / 128.f) + EPS);
        const u32x2 zg = *(const u32x2*)(F.PROJ + (size_t)(rowb + i) * DINP + C_AZ + h * 128 + e0 + 4 * q);
        const f32x4 y = ya[it] * rs * hg;
        u32x2 o; o.x = pk2(y[0] * siluf_(bflo(zg.x)), y[1] * siluf_(bfhi(zg.x))); o.y = pk2(y[2] * siluf_(bflo(zg.y)), y[3] * siluf_(bfhi(zg.y)));
        *(u32x2*)(F.R1 + (size_t)(rowb + i) * 1024 + h * 128 + e0 + 4 * q) = o;
    }
}

constexpr int RSB = 264;
__device__ __forceinline__ void ret_out(Ctx& F, int l, int s, int m) {
    FRESH_TID(F);
    const int tid = F.tid, lane = F.lane, w = F.wave, hh = w >> 1, ih = w & 1, c = lane & 15, q = lane >> 4;
    LAS bf16* Qs = (LAS bf16*)(F.lds); LAS bf16* Ks = (LAS bf16*)(F.lds + 33792); LAS bf16* Vs = (LAS bf16*)(F.lds + 67584); LAS bf16* Pw = (LAS bf16*)(F.lds + 101376 + w * 4608);
    int row0, L; seq_info(s, row0, L);
    const int gc = (row0 >> 6) + m, rowb = row0 + 64 * m;
    const bool rot = s >= 32;
    const float lgf = logsigmoidf_(F.ret_logit[(l * 2 + 0) * 4 + hh]) * 1.4426950408889634f, lgb = logsigmoidf_(F.ret_logit[(l * 2 + 1) * 4 + hh]) * 1.4426950408889634f;
    u32x4 cff[4][2], cfb[4][2];
    { const size_t slot_f = ((size_t)gc * 4 + hh) * 2;
      const u32x4* pf_ = (const u32x4*)(F.Bst + slot_f * 4096) + lane; const u32x4* pb_ = (const u32x4*)(F.Bst + (slot_f + 1) * 4096) + lane;
#pragma unroll
      for (int es = 0; es < 4; ++es)
#pragma unroll
          for (int k = 0; k < 2; ++k) { cff[es][k] = pf_[(es * 2 + k) * 64]; cfb[es][k] = pb_[(es * 2 + k) * 64]; } }
#pragma unroll
    for (int i = 0; i < 2; ++i) {
        const int item = tid + 512 * i, r = item >> 4, hd = (item >> 2) & 3, cp = (item & 3) * 8;
        const bf16* src = F.PROJ + (size_t)(rowb + r) * DINP + hd * 64 + cp;
        float qa[8], qb[8], ka[8], kb[8];
        unpack8(*(const u32x4*)(src + C_BQ), qa); unpack8(*(const u32x4*)(src + C_BQ + 32), qb); unpack8(*(const u32x4*)(src + C_BK), ka); unpack8(*(const u32x4*)(src + C_BK + 32), kb);
        if (rot) { rot8(qa, qb, 64 * m + r, cp); rot8(ka, kb, 64 * m + r, cp); }
        *(LAS u32x4*)(Qs + r * RSB + hd * 64 + cp) = packf8(qa, 1.f); *(LAS u32x4*)(Qs + r * RSB + hd * 64 + cp + 32) = packf8(qb, 1.f);
        *(LAS u32x4*)(Ks + r * RSB + hd * 64 + cp) = packf8(ka, 1.f); *(LAS u32x4*)(Ks + r * RSB + hd * 64 + cp + 32) = packf8(kb, 1.f);
    }
#pragma unroll
    for (int i = 0; i < 4; ++i) { const int p = tid + 512 * i, r = p >> 5, cp = (p & 31) * 8;
        *(LAS u32x4*)(Vs + r * RSB + cp) = *(const u32x4*)(F.PROJ + (size_t)(rowb + r) * DINP + C_BV + cp); }
    __syncthreads();
#pragma unroll
    for (int itl = 0; itl < 2; ++itl)
#pragma unroll
        for (int jt = 0; jt < 4; ++jt) {
            const int it = 2 * ih + itl;
            f32x4 acc = (f32x4){0.f, 0.f, 0.f, 0.f};
#pragma unroll
            for (int k = 0; k < 2; ++k) acc = MFMA16(*(const LAS bf16x8*)(Ks + (16 * jt + c) * RSB + hh * 64 + 32 * k + 8 * q), *(const LAS bf16x8*)(Qs + (16 * it + c) * RSB + hh * 64 + 32 * k + 8 * q), acc);
            const int i = 16 * it + c, j0 = 16 * jt + 4 * q;
            float p[4];
#pragma unroll
            for (int r = 0; r < 4; ++r) { const int j = j0 + r; const float wf = (j <= i) ? exp2f((float)(i - j) * lgf) : 0.f, wb = (j >= i) ? exp2f((float)(j - i) * lgb) : 0.f; p[r] = acc[r] * (wf + wb); }
            u32x2 pw; pw.x = pk2(p[0], p[1]); pw.y = pk2(p[2], p[3]);
            *(LAS u32x2*)(Pw + (16 * itl + c) * 72 + j0) = pw;
        }
    __syncthreads();
    bf16x8 vf[4][2];
#pragma unroll
    for (int es = 0; es < 4; ++es)
#pragma unroll
        for (int k = 0; k < 2; ++k) vf[es][k] = tr_frag(Vs, RSB, 32 * k + 8 * q, hh * 64 + 16 * es, c);
#pragma unroll
    for (int itl = 0; itl < 2; ++itl) {
        const int i = 16 * (2 * ih + itl) + c;
        const float wqf = exp2f((float)(i + 1) * lgf), wqb = exp2f((float)(64 - i) * lgb);
        bf16x8 qp[2], pp[2];
#pragma unroll
        for (int k = 0; k < 2; ++k) { qp[k] = mk8(*(const LAS bf16x4*)(Qs + i * RSB + hh * 64 + 32 * k + 4 * q), *(const LAS bf16x4*)(Qs + i * RSB + hh * 64 + 32 * k + 16 + 4 * q));
            pp[k] = *(const LAS bf16x8*)(Pw + (16 * itl + c) * 72 + 32 * k + 8 * q); }
        f32x4 yb[4]; float ss = 0.f;
#pragma unroll
        for (int es = 0; es < 4; ++es) {
            f32x4 ao = (f32x4){0.f, 0.f, 0.f, 0.f}, af = ao, ab = ao;
#pragma unroll
            for (int k = 0; k < 2; ++k) { ao = MFMA16(vf[es][k], pp[k], ao); af = MFMA16(__builtin_bit_cast(bf16x8, cff[es][k]), qp[k], af); ab = MFMA16(__builtin_bit_cast(bf16x8, cfb[es][k]), qp[k], ab); }
            const f32x4 y = ao + af * wqf + ab * wqb; yb[es] = y;
            ss += (y[0] * y[0] + y[1] * y[1]) + (y[2] * y[2] + y[3] * y[3]);
        }
        ss += __shfl_xor(ss, 16); ss += __shfl_xor(ss, 32);
        const float rs = 1.0f / sqrtf(ss * (1.f / 64.f) + EPS);
#pragma unroll
        for (int es = 0; es < 4; ++es) {
            const int col = hh * 64 + 16 * es + 4 * q;
            const u32x2 zg = *(const u32x2*)(F.PROJ + (size_t)(rowb + i) * DINP + C_BZ + col);
            const f32x4 hg = *(const f32x4*)(F.hn_g + l * 1024 + 512 + col);
            const f32x4 y = yb[es] * rs * hg;
            u32x2 o; o.x = pk2(y[0] * siluf_(bflo(zg.x)), y[1] * siluf_(bfhi(zg.x))); o.y = pk2(y[2] * siluf_(bflo(zg.y)), y[3] * siluf_(bfhi(zg.y)));
            *(u32x2*)(F.R1 + (size_t)(rowb + i) * 1024 + 512 + col) = o;
        }
    }
}

__device__ __forceinline__ void gla_out(Ctx& F, int l, int s, int m) {
    FRESH_TID(F);
    const int lane = F.lane, w = F.wave, hh = w >> 1, c32 = w & 1, c = lane & 15, q = lane >> 4;
    LAS bf16* base = (LAS bf16*)(F.lds + w * 17408);
    LAS bf16* Qf = base; LAS bf16* Kf = base + 1280; LAS bf16* Qb = base + 2560; LAS bf16* Kb = base + 3840; LAS bf16* Vs = base + 5120; LAS bf16* Pw = base + 7424;
    int row0, L; seq_info(s, row0, L);
    const int rowc = row0 + 64 * m + 32 * c32, gc32 = (row0 >> 5) + 2 * m + c32;
    const int dl = lane & 7, jg = lane >> 3;
    u32x4 cff[4], cfb[4];
    { const size_t slot_f = ((size_t)gc32 * 4 + hh) * 2;
      const u32x4* pf_ = (const u32x4*)(F.Cst + slot_f * 2048) + lane; const u32x4* pb_ = (const u32x4*)(F.Cst + (slot_f + 1) * 2048) + lane;
#pragma unroll
      for (int es = 0; es < 4; ++es) { cff[es] = pf_[es * 64]; cfb[es] = pb_[es * 64]; } }
    u32x4 cl[4][4];
#pragma unroll
    for (int x = 0; x < 4; ++x) { const bf16* src = F.PROJ + (size_t)(rowc + 4 * jg + x) * DINP + C_CLR;
#pragma unroll
        for (int y = 0; y < 4; ++y) cl[x][y] = *(const u32x4*)(src + 8 * y); }
#pragma unroll
    for (int i = 0; i < 4; ++i) { const int p = lane + 64 * i, r = p >> 3, cp = (p & 7) * 8;
        *(LAS u32x4*)(Vs + r * 72 + cp) = *(const u32x4*)(F.PROJ + (size_t)(rowc + r) * DINP + C_CV + hh * 64 + cp); }
#pragma unroll 1
    for (int dg = 0; dg < 4; ++dg) {
        const int d = 8 * dg + dl;
        float bfw[4], bbw[4];
        {
            const float* w2 = F.gla_w2 + (((size_t)l * 2 + 0) * 16) * 128 + hh * 32 + d; const float b2v = F.gla_b2[((size_t)l * 2 + 0) * 128 + hh * 32 + d];
            float w2r[16];
#pragma unroll
            for (int r = 0; r < 16; ++r) w2r[r] = w2[r * 128];
            float run = 0.f;
#pragma unroll
            for (int x = 0; x < 4; ++x) { float xx = b2v;
#pragma unroll
                for (int j = 0; j < 4; ++j) { xx += bflo(cl[x][0][j]) * w2r[2 * j] + bfhi(cl[x][0][j]) * w2r[2 * j + 1]; xx += bflo(cl[x][1][j]) * w2r[8 + 2 * j] + bfhi(cl[x][1][j]) * w2r[8 + 2 * j + 1]; }
                run += logsigmoidf_(xx) * 0.0625f; bfw[x] = run; }
            float tot = run;
#pragma unroll
            for (int o = 8; o < 64; o <<= 1) { const float t = __shfl_up(tot, o); if (lane >= o) tot += t; }
            const float off = tot - run;
#pragma unroll
            for (int x = 0; x < 4; ++x) bfw[x] += off;
        }
        {
            const float* w2 = F.gla_w2 + (((size_t)l * 2 + 1) * 16) * 128 + hh * 32 + d; const float b2v = F.gla_b2[((size_t)l * 2 + 1) * 128 + hh * 32 + d];
            float w2r[16];
#pragma unroll
            for (int r = 0; r < 16; ++r) w2r[r] = w2[r * 128];
            float la[4];
#pragma unroll
            for (int x = 0; x < 4; ++x) { float xx = b2v;
#pragma unroll
                for (int j = 0; j < 4; ++j) { xx += bflo(cl[x][2][j]) * w2r[2 * j] + bfhi(cl[x][2][j]) * w2r[2 * j + 1]; xx += bflo(cl[x][3][j]) * w2r[8 + 2 * j] + bfhi(cl[x][3][j]) * w2r[8 + 2 * j + 1]; }
                la[x] = logsigmoidf_(xx) * 0.0625f; }
            float run = 0.f;
#pragma unroll
            for (int x = 3; x >= 0; --x) { run += la[x]; bbw[x] = run; }
            float tot = run;
#pragma unroll
            for (int o = 8; o < 64; o <<= 1) { const float t = __shfl_down(tot, o); if (lane + o < 64) tot += t; }
            const float off = tot - run;
#pragma unroll
            for (int x = 0; x < 4; ++x) bbw[x] += off;
        }
#pragma unroll
        for (int x = 0; x < 4; ++x) { const int p = 4 * jg + x;
            const bf16* src = F.PROJ + (size_t)(rowc + p) * DINP + hh * 32 + d;
            const float qv = bf2f(src[C_CQ]), kv = bf2f(src[C_CK]);
            Qf[p * 40 + d] = (bf16)f2bf(qv * __expf(bfw[x])); Kf[p * 40 + d] = (bf16)f2bf(kv * __expf(-bfw[x]));
            Qb[p * 40 + d] = (bf16)f2bf(qv * __expf(bbw[x])); Kb[p * 40 + d] = (bf16)f2bf(kv * __expf(-bbw[x])); }
    }
    __syncthreads();
#pragma unroll
    for (int it = 0; it < 2; ++it)
#pragma unroll
        for (int jt = 0; jt < 2; ++jt) {
            const f32x4 z = (f32x4){0.f, 0.f, 0.f, 0.f};
            const f32x4 af = MFMA16(*(const LAS bf16x8*)(Kf + (16 * jt + c) * 40 + 8 * q), *(const LAS bf16x8*)(Qf + (16 * it + c) * 40 + 8 * q), z);
            const f32x4 ab = MFMA16(*(const LAS bf16x8*)(Kb + (16 * jt + c) * 40 + 8 * q), *(const LAS bf16x8*)(Qb + (16 * it + c) * 40 + 8 * q), z);
            const int i = 16 * it + c, j0 = 16 * jt + 4 * q;
            float p[4];
#pragma unroll
            for (int r = 0; r < 4; ++r) p[r] = ((j0 + r <= i) ? af[r] : 0.f) + ((j0 + r >= i) ? ab[r] : 0.f);
            u32x2 pw; pw.x = pk2(p[0], p[1]); pw.y = pk2(p[2], p[3]);
            *(LAS u32x2*)(Pw + i * 40 + j0) = pw;
        }
    __syncthreads();
    bf16x8 vf[4];
#pragma unroll
    for (int es = 0; es < 4; ++es) vf[es] = tr_frag(Vs, 72, 8 * q, 16 * es, c);
#pragma unroll
    for (int it = 0; it < 2; ++it) {
        const int i = 16 * it + c;
        const bf16x8 pp = *(const LAS bf16x8*)(Pw + i * 40 + 8 * q);
        const bf16x8 qpf = mk8(*(const LAS bf16x4*)(Qf + i * 40 + 4 * q), *(const LAS bf16x4*)(Qf + i * 40 + 16 + 4 * q));
        const bf16x8 qpb = mk8(*(const LAS bf16x4*)(Qb + i * 40 + 4 * q), *(const LAS bf16x4*)(Qb + i * 40 + 16 + 4 * q));
        f32x4 yc[4]; float ss = 0.f;
#pragma unroll
        for (int es = 0; es < 4; ++es) {
            f32x4 ao = (f32x4){0.f, 0.f, 0.f, 0.f};
            ao = MFMA16(vf[es], pp, ao); ao = MFMA16(__builtin_bit_cast(bf16x8, cff[es]), qpf, ao); ao = MFMA16(__builtin_bit_cast(bf16x8, cfb[es]), qpb, ao);
            yc[es] = ao; ss += (ao[0] * ao[0] + ao[1] * ao[1]) + (ao[2] * ao[2] + ao[3] * ao[3]);
        }
        ss += __shfl_xor(ss, 16); ss += __shfl_xor(ss, 32);
        const float rs = 1.0f / sqrtf(ss * (1.f / 64.f) + EPS);
#pragma unroll
        for (int es = 0; es < 4; ++es) {
            const int col = hh * 64 + 16 * es + 4 * q;
            const u32x2 zg = *(const u32x2*)(F.PROJ + (size_t)(rowc + i) * DINP + C_CZ + col);
            const f32x4 hg = *(const f32x4*)(F.hn_g + l * 1024 + 768 + col);
            const f32x4 y = yc[es] * rs * hg;
            u32x2 o; o.x = pk2(y[0] * siluf_(bflo(zg.x)), y[1] * siluf_(bfhi(zg.x))); o.y = pk2(y[2] * siluf_(bflo(zg.y)), y[3] * siluf_(bfhi(zg.y)));
            *(u32x2*)(F.R1 + (size_t)(rowc + i) * 1024 + 768 + col) = o;
        }
    }
}

__device__ __forceinline__ void mixer_pass2(Ctx& F, int l, int qslot) {
    LAS int* slot = (LAS int*)(F.lds + 147456 - 64);
    unsigned* qc = F.ctl + CW_QUEUE + 64 * qslot;
    for (;;) {
        if (F.tid == 0) slot[0] = (int)__hip_atomic_fetch_add(qc, 1u, __ATOMIC_RELAXED, __HIP_MEMORY_SCOPE_AGENT);
        __syncthreads();
        const int u = slot[0];
        __syncthreads();
        if (u >= 1536) break;
        const int gc = u < 1024 ? (u >> 2) : ((u - 1024) & 255);
        int s, m; if (gc < 128) { s = gc >> 2; m = gc & 3; } else { s = 32 + ((gc - 128) >> 4); m = (gc - 128) & 15; }
        if (u < 1024) mlstm_out(F, l, s, u & 3, m); else if (u < 1280) ret_out(F, l, s, m); else gla_out(F, l, s, m);
    }
}

__global__ void __launch_bounds__(512, 2) fwd_kernel(Args args) {
    extern __shared__ __attribute__((aligned(16))) unsigned char lds_raw[];
    Ctx F;
    F.lds = (LAS unsigned char*)lds_raw;
    F.tid = threadIdx.x; F.lane = F.tid & 63; F.wave = __builtin_amdgcn_readfirstlane(F.tid >> 6); F.G = gridDim.x; F.bid = blockIdx.x;
    F.x_prompt = args.in[0]; F.x_sample = args.in[1]; F.st_C = args.in[2]; F.st_n = args.in[3]; F.st_m = args.in[4]; F.st_ret = args.in[5]; F.st_gla = args.in[6];
    F.cvec = args.in[7]; F.c_ctx = args.in[8]; F.norm_g = args.in[9]; F.w_ada = args.in[10]; F.b_ada = args.in[11]; F.w_in = args.in[12]; F.gate_b = args.in[13];
    F.ret_logit = args.in[14]; F.gla_w2 = args.in[15]; F.gla_b2 = args.in[16]; F.hn_g = args.in[17]; F.w_out = args.in[18]; F.final_g = args.in[19];
    F.out = args.out; unsigned char* ws = args.ws;
    F.ctl = (unsigned*)(ws + WS_CTL); F.mod = (float*)(ws + WS_MOD); F.WinT = (bf16*)(ws + WS_WIN); F.WoutT = (bf16*)(ws + WS_WOUT);
    F.R1 = (bf16*)(ws + WS_R1); F.PROJ = (bf16*)(ws + WS_PROJ); F.Ast = (bf16*)(ws + WS_AST); F.Bst = (bf16*)(ws + WS_BST); F.Cst = (bf16*)(ws + WS_CST); F.Anm = (float*)(ws + WS_ANM);
    const int lo = args.ph_lo, hi = args.ph_hi;
#if N_LAUNCH_MODE == 1
    cg::grid_group grid = cg::this_grid();
    if (F.tid < 8) ((LAS unsigned*)(F.lds + LDS_BYTES - 32))[F.tid] = 0u;
    __syncthreads();
    const XcdBarrier xbar = xcd_barrier_post(F.ctl + CW_BAR, (volatile LAS unsigned*)(F.lds + LDS_BYTES - 32));
#define SEAM(k) do { if (lo <= (k) && (k) + 1 < hi) { if ((k) == 0) grid.sync(); else xcd_barrier(xbar); } } while (0)
#else
#define SEAM(k) do { } while (0)
#endif
#define IN(k) (lo <= (k) && (k) < hi)
    int ph = 0;
    if (IN(ph)) { p0_prologue(F); } SEAM(ph); ++ph;
    for (int l = 0; l < DEPTH; ++l) {
        if (IN(ph)) { hprep_phase(F, l); } SEAM(ph); ++ph;
        if (IN(ph)) {
            pg8::Gemm g{F.R1, F.WinT + (size_t)l * DINP * 1024, NTOK, DINP, 1024}; pg8::StaticOrder S; S.init(NTOK, DINP, F.G, F.bid);
            pg8::EpiBf16 E{F.PROJ, DINP};
            pg8::gemm_phase<pg8::EpiBf16, pg8::StaticOrder, true, true>(F.lds, g, S, E);
#ifdef PROBE_GEMM2
            xcd_barrier(xbar); pg8::gemm_phase<pg8::EpiBf16, pg8::StaticOrder, true, true>(F.lds, g, S, E);
#endif
        } SEAM(ph); ++ph;
        if (IN(ph)) { mixer_pass1(F, l, l); } SEAM(ph); ++ph;
        if (IN(ph)) { mixer_pass2(F, l, l + 4); } SEAM(ph); ++ph;
        if (IN(ph)) {
            pg8::Gemm g{F.R1, F.WoutT + (size_t)l * 1024 * 1024, NTOK, 1024, 1024}; pg8::StaticOrder S; S.init(NTOK, 1024, F.G, F.bid);
            pg8::EpiResid E{l == 0 ? F.x_prompt : F.out, l == 0 ? F.x_sample : F.out + (size_t)NCTX * 1024, F.out, F.mod + (size_t)l * 9 * 3072 + 2048};
            pg8::gemm_phase<pg8::EpiResid, pg8::StaticOrder, true, true>(F.lds, g, S, E);
        } SEAM(ph); ++ph;
    }
    if (IN(ph)) { final_phase(F); }
}

extern "C" void kernel_launch(void* const* d_in, const int* in_sizes, int n_in, void* d_out, int out_size, void* d_ws, size_t ws_size, hipStream_t stream) {
    static int grid = 0;
    if (grid == 0) {
        if (n_in != 20 || out_size != (int)O_END || ws_size < WS_END) { fprintf(stderr, "kernel_launch: unexpected shapes: n_in %d out %d ws %zu\n", n_in, out_size, ws_size); grid = -1; return; }
        int dev = 0, cus = 0, per_cu = 0;
        if (hipGetDevice(&dev) != hipSuccess || hipDeviceGetAttribute(&cus, hipDeviceAttributeMultiprocessorCount, dev) != hipSuccess) { grid = -1; return; }
        if (hipFuncSetAttribute((const void*)fwd_kernel, hipFuncAttributeMaxDynamicSharedMemorySize, LDS_BYTES) != hipSuccess) { fprintf(stderr, "kernel_launch: hipFuncSetAttribute failed\n"); grid = -1; return; }
        if (hipOccupancyMaxActiveBlocksPerMultiprocessor(&per_cu, (const void*)fwd_kernel, 512, LDS_BYTES) != hipSuccess || per_cu < 1) { fprintf(stderr, "kernel_launch: occupancy query says %d blocks per CU\n", per_cu); per_cu = 1; }
        (void)hipGetLastError();
        grid = cus;
    }
    if (grid < 0) return;
    (void)hipMemsetAsync((char*)d_ws + WS_CTL, 0, CTL_ZERO_BYTES, stream);
    Args a{};
    for (int i = 0; i < 20; ++i) a.in[i] = (const float*)d_in[i];
    a.out = (float*)d_out; a.ws = (unsigned char*)d_ws;
#if N_LAUNCH_MODE == 1
    a.ph_lo = 0; a.ph_hi = NPHASE;
    void* kargs[] = {&a};
    hipError_t e = hipLaunchCooperativeKernel((const void*)fwd_kernel, dim3(grid), dim3(512), kargs, LDS_BYTES, stream);
    if (e != hipSuccess) fprintf(stderr, "kernel_launch: cooperative launch failed: %s (grid %d)\n", hipGetErrorString(e), grid);
#else
    for (int p = 0; p < NPHASE; ++p) { a.ph_lo = p; a.ph_hi = p + 1; hipLaunchKernelGGL(fwd_kernel, dim3(grid), dim3(512), LDS_BYTES, stream, a); }
#endif
}
```

```cpp
#include <hip/hip_runtime.h>
#include <hip/hip_cooperative_groups.h>
#include <cstdio>
#include <cstdint>
namespace cg = cooperative_groups;

#ifndef N_LAUNCH_MODE
#define N_LAUNCH_MODE 1
#endif

#define LAS __attribute__((address_space(3)))
typedef unsigned short bf16;
typedef short bf16x8 __attribute__((ext_vector_type(8)));
typedef short bf16x4 __attribute__((ext_vector_type(4)));
typedef float f32x4 __attribute__((ext_vector_type(4)));
typedef unsigned u32x4 __attribute__((ext_vector_type(4)));
typedef unsigned u32x2 __attribute__((ext_vector_type(2)));

namespace pg8 {
#define PG8_LAS __attribute__((address_space(3)))
typedef unsigned short bf16_t;
constexpr int BM = 256, BK = 64, HALF = 128, HTB = HALF * BK * 2, STAGE_BYTES = 8 * HTB, NXCD = 8, WGM = 8;

__host__ __device__ __forceinline__ int lds_byte(int r, int c) { const int st = (r >> 4) * 2 + (c >> 5), rr = r & 15, cc = c & 31, ob = rr * 64 + cc * 2; return st * 1024 + (ob ^ (((ob >> 9) & 1) << 5)); }
__host__ __device__ __forceinline__ void stage_rc(int b, int& R, int& C) { const int st = b / 1024, sb = b % 1024, swz = sb ^ (((sb >> 9) & 1) << 5); R = (st >> 1) * 16 + swz / 64; C = (st & 1) * 32 + (swz % 64) / 2; }
__host__ __device__ __forceinline__ int perm32(int rho) { const int n = rho >> 4, i = rho & 15; return 8 * (i >> 2) + 4 * n + (i & 3); }

struct Unit { int pm, pn; };
struct Gemm { const bf16_t* A; const bf16_t* Bt; int M, N, K; };

struct StaticOrder {
    int nM, nN, nwg, G, c;
    __host__ __device__ void init(int M, int N, int G_, int c_) { nM = M / BM; nN = N / BM; nwg = nM * nN; G = G_; c = c_; }
    __host__ __device__ bool next(int i, Unit& u) const {
        const long L = (long)i * G + c; if (L >= nwg) return false;
        int wgid = (int)L; { const int q = nwg / NXCD, r = nwg % NXCD, xcd = wgid % NXCD, off = wgid / NXCD; wgid = (xcd < r ? xcd * (q + 1) : r * (q + 1) + (xcd - r) * q) + off; }
        const int nig = WGM * nN, gid = wgid / nig, fm = gid * WGM, gsz = (nM - fm) < WGM ? (nM - fm) : WGM;
        u.pm = fm + ((wgid % nig) % gsz); u.pn = (wgid % nig) / gsz; return true;
    }
    __device__ __forceinline__ void a_ready(const Unit&) const {}
    __device__ __forceinline__ void done(const Unit&) const {}
};

__device__ __forceinline__ unsigned cvt_pk_bf16(float lo, float hi) { unsigned r; asm volatile("v_cvt_pk_bf16_f32 %0, %1, %2" : "=v"(r) : "v"(lo), "v"(hi)); return r; }

struct EpiBf16 {
    static constexpr bool PERM = true, AFTER_DRAIN = false;
    bf16_t* O; int ldc;
    __device__ __forceinline__ void operator()(const f32x4 (&acc)[2][2][4][2], const Unit& u, int wr, int wc, int fr, int fq) const {
        const int row0 = u.pm * BM + wr * 64 + fr; const int col0 = u.pn * BM + wc * 32 + 8 * fq;
#pragma unroll
        for (int ai = 0; ai < 2; ++ai)
#pragma unroll
            for (int m = 0; m < 4; ++m) { bf16_t* rowp = O + (size_t)(row0 + ai * HALF + m * 16) * ldc + col0;
#pragma unroll
                for (int bj = 0; bj < 2; ++bj) { const f32x4 v0 = acc[ai][bj][m][0], v1 = acc[ai][bj][m][1];
                    u32x4 w; w.x = cvt_pk_bf16(v0[0], v0[1]); w.y = cvt_pk_bf16(v0[2], v0[3]); w.z = cvt_pk_bf16(v1[0], v1[1]); w.w = cvt_pk_bf16(v1[2], v1[3]);
                    *(u32x4*)(rowp + bj * HALF) = w; } }
    }
};
struct EpiResid {
    static constexpr bool PERM = false, AFTER_DRAIN = false;
    const float* xin0; const float* xin1;
    float* xout; const float* gate;
    __device__ __forceinline__ void operator()(const f32x4 (&acc)[2][2][4][2], const Unit& u, int wr, int wc, int fr, int fq) const {
        const int row0 = u.pm * BM + wr * 64 + fr, col0 = u.pn * BM + wc * 32 + 4 * fq;
#pragma unroll
        for (int ai = 0; ai < 2; ++ai)
#pragma unroll
            for (int m = 0; m < 4; ++m) { const int row = row0 + ai * HALF + m * 16;
                const float* xr = (row < 8192 ? xin0 + (size_t)row * 1024 : xin1 + (size_t)(row - 8192) * 1024) + col0;
                const float* gr = gate + (size_t)(row < 8192 ? 0 : 1 + ((row - 8192) >> 10)) * 3072 + col0;
                float* orow = xout + (size_t)row * 1024 + col0;
#pragma unroll
                for (int bj = 0; bj < 2; ++bj)
#pragma unroll
                    for (int n = 0; n < 2; ++n) { const f32x4 xv = *(const f32x4*)(xr + bj * HALF + n * 16), gv = *(const f32x4*)(gr + bj * HALF + n * 16);
                        *(f32x4*)(orow + bj * HALF + n * 16) = xv + gv * acc[ai][bj][m][n]; } }
    }
};

template <class Epi, class Sched, bool ALIGN_EPI = false, bool SP2 = false>
__device__ __forceinline__ void gemm_phase(PG8_LAS unsigned char* lds, const Gemm g, const Sched& S, const Epi& E) {
    int tid_ = threadIdx.x; asm volatile("" : "+v"(tid_));
    const int tid = tid_, wid = __builtin_amdgcn_readfirstlane(tid >> 6), lane = tid & 63, wr = wid >> 2, wc = wid & 3, fr = lane & 15, fq = lane >> 4;
    const int K = g.K, nt = K / BK;
    unsigned voffA[2], voffB[2];
#pragma unroll
    for (int i = 0; i < 2; ++i) { int R, C; stage_rc(tid * 16 + i * 8192, R, C); const int Rb = Epi::PERM ? ((R & ~31) + perm32(R & 31)) : R;
        voffA[i] = (unsigned)(R * K + C) * 2u; voffB[i] = (unsigned)(Rb * K + C) * 2u; }
    const size_t kstep = (size_t)(BK * 2);
    const size_t hstep = (size_t)HALF * K * 2;
    const size_t tstep = 2 * hstep;
    const unsigned ldsw = (unsigned)wid * 1024u;
    const int aoff = lds_byte(wr * 64 + fr, fq * 8), boff = lds_byte(wc * 32 + fr, fq * 8);
#define PG8_SA(b, h) (((b) * 2 + (h)) * HTB)
#define PG8_SB(b, h) ((4 + (b) * 2 + (h)) * HTB)
#define PG8_STAGE(bufoff, gbase, voff) do { _Pragma("unroll") for (int _i = 0; _i < 2; ++_i) \
        __builtin_amdgcn_global_load_lds((const unsigned*)((const char*)(gbase) + (voff)[_i]), (PG8_LAS unsigned*)(lds + (bufoff) + ldsw + _i * 8192), 16, 0, 0); } while (0)
#define PG8_LDA(dst, b, h) do { _Pragma("unroll") for (int m = 0; m < 4; ++m) _Pragma("unroll") for (int k = 0; k < 2; ++k) dst[m][k] = *(const PG8_LAS bf16x8*)(lds + PG8_SA(b, h) + aoff + m * 2048 + k * 1024); } while (0)
#define PG8_LDB(dst, b, h) do { _Pragma("unroll") for (int n = 0; n < 2; ++n) _Pragma("unroll") for (int k = 0; k < 2; ++k) dst[n][k] = *(const PG8_LAS bf16x8*)(lds + PG8_SB(b, h) + boff + n * 2048 + k * 1024); } while (0)
#define PG8_MMA(ai, bj, At, Bt) do { __builtin_amdgcn_s_setprio(1); _Pragma("unroll") for (int m = 0; m < 4; ++m) _Pragma("unroll") for (int n = 0; n < 2; ++n) _Pragma("unroll") for (int k = 0; k < 2; ++k) \
        acc[ai][bj][m][n] = __builtin_amdgcn_mfma_f32_16x16x32_bf16(Bt[n][k], At[m][k], acc[ai][bj][m][n], 0, 0, 0); __builtin_amdgcn_s_setprio(0); } while (0)
#define PG8_WAIT_V(n) asm volatile("s_waitcnt vmcnt(" #n ")" ::: "memory")
#define PG8_WAIT_L(n) asm volatile("s_waitcnt lgkmcnt(" #n ")" ::: "memory")
#define PG8_BAR __builtin_amdgcn_s_barrier()
#define PG8_SCHED __builtin_amdgcn_sched_barrier(0)
    Unit cur, nxt; int ui = 0;
    if (!S.next(0, cur)) return;
    f32x4 acc[2][2][4][2];
#pragma unroll
    for (int a = 0; a < 2; ++a)
#pragma unroll
        for (int b = 0; b < 2; ++b)
#pragma unroll
            for (int m = 0; m < 4; ++m)
#pragma unroll
                for (int n = 0; n < 2; ++n) acc[a][b][m][n] = (f32x4){0.f, 0.f, 0.f, 0.f};
    bf16x8 At[4][2], B0[2][2], B1[2][2];
    const char* cA = (const char*)g.A + (size_t)cur.pm * tstep; const char* cB = (const char*)g.Bt + (size_t)cur.pn * tstep;
    S.a_ready(cur);
    if constexpr (SP2) {
        PG8_STAGE(PG8_SB(0, 0), cB, voffB); PG8_STAGE(PG8_SB(0, 1), cB + hstep, voffB); PG8_STAGE(PG8_SA(0, 0), cA, voffA); PG8_STAGE(PG8_SA(0, 1), cA + hstep, voffA);
        if (wr == 1) PG8_BAR;
        PG8_WAIT_V(2); PG8_BAR;
        PG8_STAGE(PG8_SB(1, 0), cB + kstep, voffB); PG8_STAGE(PG8_SA(1, 0), cA + kstep, voffA); PG8_STAGE(PG8_SB(1, 1), cB + hstep + kstep, voffB);
        PG8_WAIT_V(6); PG8_BAR;
    } else {
        PG8_STAGE(PG8_SB(0, 0), cB, voffB); PG8_STAGE(PG8_SA(0, 0), cA, voffA); PG8_STAGE(PG8_SB(0, 1), cB + hstep, voffB); PG8_STAGE(PG8_SA(0, 1), cA + hstep, voffA);
        if (wr == 1) PG8_BAR;
        PG8_WAIT_V(4); PG8_BAR;
        PG8_STAGE(PG8_SB(1, 0), cB + kstep, voffB); PG8_STAGE(PG8_SA(1, 0), cA + kstep, voffA); PG8_STAGE(PG8_SB(1, 1), cB + hstep + kstep, voffB);
        PG8_WAIT_V(6); PG8_BAR;
    }
    for (;;) {
        const bool has_next = S.next(ui + 1, nxt);
        const char* nA = has_next ? (const char*)g.A + (size_t)nxt.pm * tstep : cA; const char* nB = has_next ? (const char*)g.Bt + (size_t)nxt.pn * tstep : cB;
        for (int t = 0; t < nt; t += 2) {
            const bool last = (t == nt - 2);
            const char* a1 = cA + (size_t)(t + 1) * kstep;
            const char* a2 = last ? nA : cA + (size_t)(t + 2) * kstep; const char* b2 = last ? nB : cB + (size_t)(t + 2) * kstep;
            const char* a3 = a2 + kstep; const char* b3 = b2 + kstep;
            if (last && has_next) S.a_ready(nxt);
            if constexpr (SP2) {
            PG8_LDB(B0, 0, 0); PG8_LDB(B1, 0, 1); PG8_SCHED; PG8_LDA(At, 0, 0); PG8_STAGE(PG8_SA(1, 1), a1 + hstep, voffA);
            PG8_WAIT_V(8); PG8_WAIT_L(0); PG8_BAR; PG8_MMA(0, 0, At, B0); PG8_MMA(0, 1, At, B1); PG8_BAR; PG8_SCHED;
            PG8_LDA(At, 0, 1); PG8_STAGE(PG8_SB(0, 0), b2, voffB); PG8_STAGE(PG8_SB(0, 1), b2 + hstep, voffB); PG8_STAGE(PG8_SA(0, 0), a2, voffA);
            PG8_WAIT_V(8); PG8_WAIT_L(0); PG8_BAR; PG8_MMA(1, 0, At, B0); PG8_MMA(1, 1, At, B1); PG8_BAR; PG8_SCHED;
            PG8_LDB(B0, 1, 0); PG8_LDB(B1, 1, 1); PG8_SCHED; PG8_LDA(At, 1, 0); PG8_STAGE(PG8_SA(0, 1), a2 + hstep, voffA);
            PG8_WAIT_V(8); PG8_WAIT_L(0); PG8_BAR; PG8_MMA(0, 0, At, B0); PG8_MMA(0, 1, At, B1); PG8_BAR; PG8_SCHED;
            PG8_LDA(At, 1, 1); PG8_STAGE(PG8_SB(1, 0), b3, voffB); PG8_STAGE(PG8_SB(1, 1), b3 + hstep, voffB); PG8_STAGE(PG8_SA(1, 0), a3, voffA);
            PG8_WAIT_V(8); PG8_WAIT_L(0); PG8_BAR; PG8_MMA(1, 0, At, B0); PG8_MMA(1, 1, At, B1); PG8_BAR; PG8_SCHED;
            } else {
            PG8_LDB(B0, 0, 0); PG8_SCHED; PG8_LDA(At, 0, 0); PG8_STAGE(PG8_SA(1, 1), a1 + hstep, voffA);
            PG8_WAIT_L(8); PG8_BAR; PG8_WAIT_L(0); PG8_MMA(0, 0, At, B0); PG8_BAR; PG8_SCHED;
            PG8_LDB(B1, 0, 1); PG8_STAGE(PG8_SB(0, 0), b2, voffB);
            PG8_BAR; PG8_WAIT_L(0); PG8_MMA(0, 1, At, B1); PG8_BAR;
            PG8_LDA(At, 0, 1); PG8_STAGE(PG8_SA(0, 0), a2, voffA);
            PG8_BAR; PG8_WAIT_L(0); PG8_MMA(1, 0, At, B0); PG8_BAR; PG8_SCHED;
            PG8_STAGE(PG8_SB(0, 1), b2 + hstep, voffB);
            PG8_WAIT_V(6); PG8_BAR; PG8_MMA(1, 1, At, B1); PG8_BAR;
            PG8_LDB(B0, 1, 0); PG8_SCHED; PG8_LDA(At, 1, 0); PG8_STAGE(PG8_SA(0, 1), a2 + hstep, voffA);
            PG8_WAIT_L(8); PG8_BAR; PG8_WAIT_L(0); PG8_MMA(0, 0, At, B0); PG8_BAR; PG8_SCHED;
            PG8_LDB(B1, 1, 1); PG8_STAGE(PG8_SB(1, 0), b3, voffB);
            PG8_BAR; PG8_WAIT_L(0); PG8_MMA(0, 1, At, B1); PG8_BAR;
            PG8_LDA(At, 1, 1); PG8_STAGE(PG8_SA(1, 0), a3, voffA);
            PG8_BAR; PG8_WAIT_L(0); PG8_MMA(1, 0, At, B0); PG8_BAR; PG8_SCHED;
            PG8_STAGE(PG8_SB(1, 1), b3 + hstep, voffB);
            PG8_WAIT_V(6); PG8_BAR; PG8_MMA(1, 1, At, B1); PG8_BAR;
            }
        }
        if constexpr (ALIGN_EPI) { if (wr == 0) PG8_BAR; }
        if constexpr (!Epi::AFTER_DRAIN) { E(acc, cur, wr, wc, fr, fq); S.done(cur); }
        if (!has_next) break;
#pragma unroll
        for (int a = 0; a < 2; ++a)
#pragma unroll
            for (int b = 0; b < 2; ++b)
#pragma unroll
                for (int m = 0; m < 4; ++m)
#pragma unroll
                    for (int n = 0; n < 2; ++n) acc[a][b][m][n] = (f32x4){0.f, 0.f, 0.f, 0.f};
        cur = nxt; cA = nA; cB = nB; ++ui;
        if constexpr (ALIGN_EPI) { if (wr == 1) PG8_BAR; }
    }
    PG8_WAIT_V(0);
    if constexpr (!ALIGN_EPI) { if (wr == 0) PG8_BAR; }
    PG8_BAR;
#undef PG8_SA
#undef PG8_SB
#undef PG8_STAGE
#undef PG8_LDA
#undef PG8_LDB
#undef PG8_MMA
#undef PG8_WAIT_V
#undef PG8_WAIT_L
#undef PG8_BAR
#undef PG8_SCHED
}
}


#define XB_TMO      128
#define XB_XCNT(j)  (256  + 64 * (j))
#define XB_XSUB(j)  (1280 + 64 * (j))
#define XB_XGEN(j)  (2304 + 64 * (j))
#define XB_TOP      3328
#define XB_TOPGEN   3392
#define XCD_BAR_WORDS 3456
#define XB_SPIN_CAP (1u << 18)
__device__ __forceinline__ unsigned xb_ld(unsigned* p)              { return __hip_atomic_load(p, __ATOMIC_RELAXED, __HIP_MEMORY_SCOPE_AGENT); }
__device__ __forceinline__ unsigned xb_add(unsigned* p, unsigned v) { return __hip_atomic_fetch_add(p, v, __ATOMIC_RELAXED, __HIP_MEMORY_SCOPE_AGENT); }
__device__ __forceinline__ unsigned xb_xcc_id() { return (unsigned)__builtin_amdgcn_s_getreg((3 << 11) | 20) & 0xFu; }
#define XB_SPIN(cond, bar) do { unsigned _sp = 0; while (cond) { __builtin_amdgcn_s_sleep(1); \
    if ((++_sp & 255u) == 0u) { if (xb_ld(&(bar)[XB_TMO])) break; if (_sp > XB_SPIN_CAP) { atomicAdd(&(bar)[XB_TMO], 1u); break; } } } } while (0)
struct XcdBarrier { unsigned* bar; unsigned x; volatile LAS unsigned* st; };
__device__ __forceinline__ XcdBarrier xcd_barrier_post(unsigned* bar, volatile LAS unsigned* st) {
    XcdBarrier b; b.bar = bar; b.x = xb_xcc_id(); b.st = st;
    if (threadIdx.x == 0) (void)xb_add(&bar[XB_XCNT(b.x)], 1u);
    return b;
}
__device__ __forceinline__ void xcd_barrier_complete(unsigned* bar, unsigned x, unsigned& nloc, unsigned& nx) {
    const unsigned G = gridDim.x * gridDim.y * gridDim.z;
    unsigned sum, cnt, mine, sp = 0u;
    for (;;) {
        sum = 0u; cnt = 0u; mine = 0u;
#pragma unroll
        for (unsigned j = 0; j < 16; ++j) { const unsigned c = xb_ld(&bar[XB_XCNT(j)]); sum += c; cnt += (c > 0u) ? 1u : 0u; mine = (j == x) ? c : mine; }
        if (sum == G) break;
        __builtin_amdgcn_s_sleep(1);
        if ((++sp & 255u) == 0u) { if (xb_ld(&bar[XB_TMO])) break; if (sp > XB_SPIN_CAP) { atomicAdd(&bar[XB_TMO], 1u); break; } }
    }
    nloc = mine > 0u ? mine : 1u; nx = cnt > 0u ? cnt : 1u;
}
__device__ __forceinline__ void xcd_barrier(const XcdBarrier& b) {
    asm volatile("s_waitcnt vmcnt(0)" ::: "memory");
    __syncthreads();
    if (threadIdx.x == 0) {
        unsigned* bar = b.bar;
        __builtin_amdgcn_s_waitcnt(0);
        unsigned nloc = b.st[0], nx = b.st[1];
        if (nloc == 0u) { xcd_barrier_complete(bar, b.x, nloc, nx); b.st[0] = nloc; b.st[1] = nx; }
        const unsigned old = xb_add(&bar[XB_XSUB(b.x)], 1u);
        const unsigned gen = old / nloc;
        if (old + 1u == (gen + 1u) * nloc) {
            __builtin_amdgcn_fence(__ATOMIC_RELEASE, "agent");
            asm volatile("s_waitcnt vmcnt(0)" ::: "memory");
            const unsigned og = xb_add(&bar[XB_TOP], 1u);
            const unsigned tg = og / nx;
            if (og + 1u == (tg + 1u) * nx) xb_add(&bar[XB_TOPGEN], 1u);
            else XB_SPIN(xb_ld(&bar[XB_TOPGEN]) == tg, bar);
            __builtin_amdgcn_fence(__ATOMIC_ACQUIRE, "agent");
            xb_add(&bar[XB_XGEN(b.x)], 1u);
            asm volatile("s_waitcnt vmcnt(0)" ::: "memory");
        } else {
            XB_SPIN(xb_ld(&bar[XB_XGEN(b.x)]) == gen, bar);
            __builtin_amdgcn_fence(__ATOMIC_ACQUIRE, "agent");
            asm volatile("s_waitcnt vmcnt(0)" ::: "memory");
        }
    }
    __syncthreads();
}

constexpr int DM = 1024, DEPTH = 4, NTOK = 16384, NCTX = 8192;
constexpr int DIN = 4400, DINP = 4608;
constexpr int NSEQ = 40;
constexpr int C_AQ = 0, C_AK = 512, C_AV = 1024, C_AO = 1536, C_AZ = 2048, C_AG = 2560, C_BQ = 2576, C_BK = 2832, C_BV = 3088, C_BZ = 3344,
              C_CQ = 3600, C_CK = 3728, C_CV = 3856, C_CZ = 4112, C_CLR = 4368;
constexpr float EPS = 1e-6f;
constexpr size_t O_Y = 0, O_C = 16777216, O_N = O_C + 16777216, O_M = O_N + 131072, O_R = O_M + 1024, O_G = O_R + 4194304, O_END = O_G + 2097152;
constexpr size_t MiB = 1u << 20;
constexpr size_t WS_CTL = 0, CTL_ZERO_BYTES = 64 * 1024;
constexpr size_t WS_MOD = 1 * MiB;
constexpr size_t WS_WIN = 2 * MiB;
constexpr size_t WS_WOUT = 38 * MiB;
constexpr size_t WS_R1 = 46 * MiB;
constexpr size_t WS_PROJ = 78 * MiB;
constexpr size_t WS_AST = 222 * MiB;
constexpr size_t WS_ANM = 286 * MiB;
constexpr size_t WS_BST = 288 * MiB;
constexpr size_t WS_CST = 304 * MiB;
constexpr size_t WS_END = 320 * MiB;
constexpr int CW_QUEUE = 64;
constexpr int CW_BAR = 4096;

constexpr int LDS_BYTES = 147456;
constexpr int NPHASE = 1 + DEPTH * 5 + 1;

__device__ __forceinline__ unsigned f2bf(float f) { unsigned u = __builtin_bit_cast(unsigned, f); return (u + 0x7fffu + ((u >> 16) & 1u)) >> 16; }
__device__ __forceinline__ unsigned pk2(float lo, float hi) { return f2bf(lo) | (f2bf(hi) << 16); }
__device__ __forceinline__ float bf2f(unsigned short b) { return __builtin_bit_cast(float, ((unsigned)b) << 16); }
__device__ __forceinline__ float bflo(unsigned u) { return __builtin_bit_cast(float, u << 16); }
__device__ __forceinline__ float bfhi(unsigned u) { return __builtin_bit_cast(float, u & 0xffff0000u); }
__device__ __forceinline__ float sigmoidf_(float x) { return 1.0f / (1.0f + __expf(-x)); }
__device__ __forceinline__ float siluf_(float x) { return x * sigmoidf_(x); }
__device__ __forceinline__ float logsigmoidf_(float x) { return fminf(x, 0.f) - log1pf(__expf(-fabsf(x))); }
__device__ __forceinline__ float wave_sum(float v) {
#pragma unroll
    for (int o = 1; o < 64; o <<= 1) v += __shfl_xor(v, o);
    return v;
}
__device__ __forceinline__ bf16x8 mk8(bf16x4 lo, bf16x4 hi) { return __builtin_shufflevector(lo, hi, 0, 1, 2, 3, 4, 5, 6, 7); }
__device__ __forceinline__ bf16x8 pack8(f32x4 a, f32x4 b) { u32x4 w; w.x = pk2(a[0], a[1]); w.y = pk2(a[2], a[3]); w.z = pk2(b[0], b[1]); w.w = pk2(b[2], b[3]); return __builtin_bit_cast(bf16x8, w); }
#define MFMA16(a, b, c) __builtin_amdgcn_mfma_f32_16x16x32_bf16((a), (b), (c), 0, 0, 0)

struct Args { const float* in[20]; float* out; unsigned char* ws; int ph_lo, ph_hi; };

struct Ctx {
    LAS unsigned char* lds; int tid, lane, wave, G, bid;
    const float *x_prompt, *x_sample, *st_C, *st_n, *st_m, *st_ret, *st_gla, *cvec, *c_ctx, *norm_g, *w_ada, *b_ada, *w_in, *gate_b, *ret_logit, *gla_w2, *gla_b2, *hn_g, *w_out, *final_g;
    float* out; unsigned* ctl; float* mod; bf16 *WinT, *WoutT, *R1, *PROJ, *Ast, *Bst, *Cst; float* Anm;
};

#define FRESH_TID(F) do { int t_ = threadIdx.x; asm volatile("" : "+v"(t_)); (F).tid = t_; (F).lane = t_ & 63; (F).wave = __builtin_amdgcn_readfirstlane(t_ >> 6); } while (0)
__device__ __forceinline__ void seq_info(int s, int& row0, int& L) { if (s < 32) { row0 = s * 256; L = 256; } else { row0 = NCTX + (s - 32) * 1024; L = 1024; } }

__device__ __forceinline__ float col_scale_in(int n) {
    if (n >= C_AK && n < C_AV) return 0.08838834764831845f;
    if (n >= C_BK && n < C_BV) return 0.125f;
    if (n >= C_CK && n < C_CV) return 0.17677669529663687f;
    return 1.0f;
}
__device__ __forceinline__ void p0_transpose_item(const float* W, int ldn, int nvalid, bool scale_in, bf16* WT, LAS float* scr, int kb, int nb, int lane) {
    const int k0 = 64 * kb, n0 = 32 * nb;
    const int n = n0 + (lane & 31); const float sc = scale_in ? col_scale_in(n) : 1.0f;
#pragma unroll 8
    for (int i = 0; i < 32; ++i) { const int kk = 2 * i + (lane >> 5); scr[kk * 33 + (lane & 31)] = (n < nvalid) ? W[(size_t)(k0 + kk) * ldn + n] * sc : 0.f; }
    asm volatile("s_waitcnt lgkmcnt(0)" ::: "memory");
    const int c = lane & 7;
#pragma unroll
    for (int j = 0; j < 4; ++j) { const int nn = (lane >> 3) + 8 * j; const LAS float* s = scr + (8 * c) * 33 + nn;
        u32x4 o; o.x = pk2(s[0 * 33], s[1 * 33]); o.y = pk2(s[2 * 33], s[3 * 33]); o.z = pk2(s[4 * 33], s[5 * 33]); o.w = pk2(s[6 * 33], s[7 * 33]);
        *(u32x4*)(WT + (size_t)(n0 + nn) * 1024 + k0 + 8 * c) = o; }
    asm volatile("s_waitcnt lgkmcnt(0)" ::: "memory");
}
__device__ __forceinline__ void p0_prologue(Ctx& F) {
    FRESH_TID(F);
    LAS float* scr = (LAS float*)(F.lds + F.wave * 8448);
    const int gw = F.bid * 8 + F.wave, NGW = F.G * 8;
    constexpr int I_IN = 16 * (DINP / 32), I_OUT = 16 * 32, I_L = I_IN + I_OUT;
    for (int it = gw; it < DEPTH * I_L; it += NGW) {
        const int l = it / I_L; int r = it % I_L;
        if (r < I_IN) p0_transpose_item(F.w_in + (size_t)l * 1024 * DIN, DIN, DIN, true, F.WinT + (size_t)l * DINP * 1024, scr, r / (DINP / 32), r % (DINP / 32), F.lane);
        else { r -= I_IN; p0_transpose_item(F.w_out + (size_t)l * 1024 * 1024, 1024, 1024, false, F.WoutT + (size_t)l * 1024 * 1024, scr, r / 32, r % 32, F.lane); }
    }
    __syncthreads();
    LAS float* sl = (LAS float*)(F.lds + 69632);
    LAS float* red = (LAS float*)(F.lds + 106496);
    bool have_sl = false;
    for (int it = F.bid; it < DEPTH * 48; it += F.G) {
        if (!have_sl) {
            for (int i = F.tid; i < 9 * 1024; i += 512) { const int r = i >> 10, k = i & 1023; const float v = r == 0 ? F.c_ctx[k] : F.cvec[(r - 1) * 1024 + k]; sl[i] = siluf_(v); }
            have_sl = true; __syncthreads();
        }
        const int l = it / 48, e0 = (it % 48) * 64, c = F.tid & 63, kg = F.tid >> 6;
        const float* wp = F.w_ada + ((size_t)l * 1024 + kg * 128) * 3072 + e0 + c;
        float acc[9];
#pragma unroll
        for (int r = 0; r < 9; ++r) acc[r] = 0.f;
#pragma unroll 4
        for (int k = 0; k < 128; ++k) { const float w = wp[(size_t)k * 3072];
#pragma unroll
            for (int r = 0; r < 9; ++r) acc[r] += sl[r * 1024 + kg * 128 + k] * w; }
#pragma unroll
        for (int r = 0; r < 9; ++r) red[(kg * 9 + r) * 64 + c] = acc[r];
        __syncthreads();
        for (int o = F.tid; o < 9 * 64; o += 512) { const int r = o >> 6, cc = o & 63; float s = F.b_ada[l * 3072 + e0 + cc];
#pragma unroll
            for (int g = 0; g < 8; ++g) s += red[(g * 9 + r) * 64 + cc];
            F.mod[((size_t)l * 9 + r) * 3072 + e0 + cc] = s; }
        __syncthreads();
    }
}

__device__ __forceinline__ void hprep_phase(Ctx& F, int l) {
    FRESH_TID(F);
    const int gw = F.bid * 8 + F.wave, NGW = F.G * 8;
    const float* g = F.norm_g + l * 1024;
    for (int m = gw; m < NTOK; m += NGW) {
        const float* xrow = (l == 0) ? (m < NCTX ? F.x_prompt + (size_t)m * 1024 : F.x_sample + (size_t)(m - NCTX) * 1024) : F.out + (size_t)m * 1024;
        const int mr = m < NCTX ? 0 : 1 + ((m - NCTX) >> 10);
        const float* md = F.mod + ((size_t)l * 9 + mr) * 3072;
        const f32x4* xr = (const f32x4*)xrow + F.lane;
        f32x4 v[4]; float s = 0.f;
#pragma unroll
        for (int j = 0; j < 4; ++j) { v[j] = xr[64 * j]; s += (v[j].x * v[j].x + v[j].y * v[j].y) + (v[j].z * v[j].z + v[j].w * v[j].w); }
        const float rstd = 1.0f / sqrtf(wave_sum(s) * (1.f / 1024.f) + EPS);
        unsigned long long* o8 = (unsigned long long*)(F.R1 + (size_t)m * 1024) + F.lane;
#pragma unroll
        for (int j = 0; j < 4; ++j) { const int c = 4 * F.lane + 256 * j;
            const f32x4 gg = *(const f32x4*)(g + c), sh = *(const f32x4*)(md + c), sc = *(const f32x4*)(md + 1024 + c);
            const f32x4 h = v[j] * rstd * gg * (sc + 1.0f) + sh;
            o8[64 * j] = (unsigned long long)pk2(h.x, h.y) | ((unsigned long long)pk2(h.z, h.w) << 32); }
    }
}
__device__ __forceinline__ void final_phase(Ctx& F) {
    FRESH_TID(F);
    const int gw = F.bid * 8 + F.wave, NGW = F.G * 8;
    for (int m = gw; m < NTOK; m += NGW) {
        f32x4* xr = (f32x4*)(F.out + (size_t)m * 1024) + F.lane;
        f32x4 v[4]; float s = 0.f;
#pragma unroll
        for (int j = 0; j < 4; ++j) { v[j] = xr[64 * j]; s += (v[j].x * v[j].x + v[j].y * v[j].y) + (v[j].z * v[j].z + v[j].w * v[j].w); }
        const float rstd = 1.0f / sqrtf(wave_sum(s) * (1.f / 1024.f) + EPS);
#pragma unroll
        for (int j = 0; j < 4; ++j) { const f32x4 gg = *(const f32x4*)(F.final_g + 4 * F.lane + 256 * j); xr[64 * j] = v[j] * rstd * gg; }
    }
}

__device__ __forceinline__ bf16x8 tr_frag(const LAS bf16* base, int RS, int row0, int col0, int c) {
    const LAS bf16* p = base + (row0 + (c >> 2)) * RS + col0 + 4 * (c & 3);
    const bf16x4 lo = __builtin_amdgcn_ds_read_tr16_b64_v4i16((LAS bf16x4*)p);
    const bf16x4 hi = __builtin_amdgcn_ds_read_tr16_b64_v4i16((LAS bf16x4*)(p + 4 * RS));
    return mk8(lo, hi);
}
__device__ __forceinline__ u32x4 scale8(u32x4 v, float g) { u32x4 o;
#pragma unroll
    for (int j = 0; j < 4; ++j) o[j] = pk2(bflo(v[j]) * g, bfhi(v[j]) * g);
    return o; }

constexpr int RSA = 136;
constexpr int A1_TAB = 69632;
__device__ __forceinline__ void mlstm_chain(Ctx& F, int l, int s, int h, int dir) {
    FRESH_TID(F);
    const int tid = F.tid, lane = F.lane, w = F.wave, c = lane & 15, q = lane >> 4;
    int row0, L; seq_info(s, row0, L);
    const int nch = L / 64, e0 = 16 * w, gc0 = row0 >> 6;
    const float bi = F.gate_b[l * 16 + dir * 8 + h], bfg = F.gate_b[l * 16 + dir * 8 + 4 + h];
    LAS float* gt = (LAS float*)(F.lds + A1_TAB);
    for (int n = w; n < nch; n += 8) {
        const int posl = dir ? (L - 1 - (64 * n + lane)) : (64 * n + lane);
        const bf16* gp = F.PROJ + (size_t)(row0 + posl) * DINP + C_AG + dir * 8 + h;
        const float ic = bf2f(gp[0]) + bi, fp = bf2f(gp[4]) + bfg;
        float Fc = logsigmoidf_(fp);
#pragma unroll
        for (int o = 1; o < 64; o <<= 1) { const float t = __shfl_up(Fc, o); if (lane >= o) Fc += t; }
        const float u = ic - Fc;
        float pm = u;
#pragma unroll
        for (int o = 1; o < 64; o <<= 1) { const float t = __shfl_up(pm, o); if (lane >= o) pm = fmaxf(pm, t); }
        const float F_last = __shfl(Fc, 63), pmL = __shfl(pm, 63);
        gt[n * 64 + lane] = F_last + u;
        if (lane == 0) { gt[1024 + n] = F_last; gt[1040 + n] = F_last + pmL; }
    }
    f32x4 st[8], nst; float m_prev;
    if (s >= 32) {
        const size_t sb = (((size_t)(s - 32) * DEPTH + l) * 2 + dir) * 4 + h;
        const float* C0 = F.st_C + sb * 16384;
#pragma unroll
        for (int t = 0; t < 8; ++t)
#pragma unroll
            for (int r = 0; r < 4; ++r) st[t][r] = C0[(size_t)(16 * t + 4 * q + r) * 128 + e0 + c];
#pragma unroll
        for (int r = 0; r < 4; ++r) nst[r] = F.st_n[sb * 128 + 16 * w + 4 * q + r];
        m_prev = F.st_m[sb];
    } else {
#pragma unroll
        for (int t = 0; t < 8; ++t) st[t] = (f32x4){0.f, 0.f, 0.f, 0.f};
        nst = (f32x4){0.f, 0.f, 0.f, 0.f}; m_prev = 0.f;
    }
    u32x4 kr0[2], vr0[2], kr1[2], vr1[2];
#define A1_LOAD(nn, KR, VR) do { \
        _Pragma("unroll") for (int i_ = 0; i_ < 2; ++i_) { const int p_ = tid + 512 * i_, r_ = p_ >> 4, cp_ = (p_ & 15) * 8; \
            const int pos_ = dir ? (L - 1 - (64 * (nn) + r_)) : (64 * (nn) + r_); \
            const bf16* src_ = F.PROJ + (size_t)(row0 + pos_) * DINP + h * 128 + cp_; \
            KR[i_] = *(const u32x4*)(src_ + C_AK); VR[i_] = *(const u32x4*)(src_ + C_AV); } } while (0)
    A1_LOAD(0, kr0, vr0); A1_LOAD(1, kr1, vr1);
    const u32x4 ones_u = (u32x4){0x3f803f80u, 0x3f803f80u, 0x3f803f80u, 0x3f803f80u};
    const bf16x8 ones = __builtin_bit_cast(bf16x8, ones_u);
    __syncthreads();
#define A1_STEP(nn, KR, VR, BUF) do { \
        LAS bf16* Kg = (LAS bf16*)(F.lds + (BUF) * 34816); LAS bf16* Vs = Kg + 64 * RSA; \
        const float FLn = gt[1024 + (nn)], GMn = gt[1040 + (nn)]; \
        const float m_new = fmaxf(FLn + m_prev, GMn), a_dec = __expf(FLn + m_prev - m_new); \
        { const int m_ = dir ? nch - 1 - (nn) : (nn); const size_t slot = ((size_t)(gc0 + m_) * 4 + h) * 2 + dir; \
          u32x4* sp = (u32x4*)(F.Ast + slot * 16384) + (w * 4) * 64 + lane; \
          _Pragma("unroll") for (int k = 0; k < 4; ++k) sp[k * 64] = __builtin_bit_cast(u32x4, pack8(st[2 * k], st[2 * k + 1])); \
          if (c == 0) *(f32x4*)(F.Anm + slot * 132 + 16 * w + 4 * q) = nst; \
          if (tid == 0) F.Anm[slot * 132 + 128] = m_prev; } \
        _Pragma("unroll") for (int i = 0; i < 2; ++i) { const int p = tid + 512 * i, r = p >> 4, cp = (p & 15) * 8; \
            const float gr = __expf(gt[(nn) * 64 + r] - m_new); \
            *(LAS u32x4*)(Kg + r * RSA + cp) = scale8(KR[i], gr); *(LAS u32x4*)(Vs + r * RSA + cp) = VR[i]; } \
        if ((nn) + 2 < nch) A1_LOAD((nn) + 2, KR, VR); \
        __syncthreads(); \
        bf16x8 vb[2]; \
        _Pragma("unroll") for (int k = 0; k < 2; ++k) vb[k] = tr_frag(Vs, RSA, 32 * k + 8 * q, e0, c); \
        _Pragma("unroll") for (int t = 0; t < 8; ++t) { st[t] = st[t] * a_dec; \
            _Pragma("unroll") for (int k = 0; k < 2; ++k) st[t] = MFMA16(tr_frag(Kg, RSA, 32 * k + 8 * q, 16 * t, c), vb[k], st[t]); } \
        f32x4 nacc = (f32x4){0.f, 0.f, 0.f, 0.f}; \
        _Pragma("unroll") for (int k = 0; k < 2; ++k) nacc = MFMA16(tr_frag(Kg, RSA, 32 * k + 8 * q, 16 * w, c), ones, nacc); \
        nst = nst * a_dec + nacc; m_prev = m_new; } while (0)
    for (int n = 0; n < nch; n += 2) { A1_STEP(n, kr0, vr0, 0); A1_STEP(n + 1, kr1, vr1, 1); }
#undef A1_STEP
#undef A1_LOAD
    if (s < 32) {
        const size_t sb = (((size_t)s * DEPTH + l) * 2 + dir) * 4 + h;
        float* Co = F.out + O_C + sb * 16384;
#pragma unroll
        for (int t = 0; t < 8; ++t)
#pragma unroll
            for (int r = 0; r < 4; ++r) Co[(size_t)(16 * t + 4 * q + r) * 128 + e0 + c] = st[t][r];
        if (c == 0) *(f32x4*)(F.out + O_N + sb * 128 + 16 * w + 4 * q) = nst;
        if (tid == 0) F.out[O_M + sb] = m_prev;
    }
    __syncthreads();
}

__device__ __forceinline__ void rot8(float (&a)[8], float (&b)[8], int pos, int cp) {
    const float prow = (float)(pos >> 6), pcol = (float)(pos & 63);
#pragma unroll
    for (int x = 0; x < 8; ++x) { const int f = cp + x;
        const float fr = exp2f(-(float)(f & 15) * 0.8304820237218406f);
        const float ang = (f < 16 ? prow : pcol) * fr;
        const float cs = __cosf(ang), sn = __sinf(ang);
        const float t1 = a[x], t2 = b[x]; a[x] = t1 * cs - t2 * sn; b[x] = t1 * sn + t2 * cs; }
}
__device__ __forceinline__ void unpack8(u32x4 v, float (&o)[8]) {
#pragma unroll
    for (int j = 0; j < 4; ++j) { o[2 * j] = bflo(v[j]); o[2 * j + 1] = bfhi(v[j]); } }
__device__ __forceinline__ u32x4 packf8(const float (&a)[8], float g) { u32x4 o; o.x = pk2(a[0] * g, a[1] * g); o.y = pk2(a[2] * g, a[3] * g); o.z = pk2(a[4] * g, a[5] * g); o.w = pk2(a[6] * g, a[7] * g); return o; }

__device__ __forceinline__ void ret_chain(Ctx& F, int l, int s, int h) {
    FRESH_TID(F);
    const int tid = F.tid, lane = F.lane, dir = F.wave >> 2, wl = F.wave & 3, tl = tid & 255, c = lane & 15, q = lane >> 4;
    int row0, L; seq_info(s, row0, L);
    const int nch = L / 64, e0 = 16 * wl, gc0 = row0 >> 6;
    const float lg2 = logsigmoidf_(F.ret_logit[(l * 2 + dir) * 4 + h]) * 1.4426950408889634f;
    const bool rot = s >= 32;
    f32x4 st[4];
    if (s >= 32) {
        const float* S0 = F.st_ret + ((((size_t)(s - 32) * DEPTH + l) * 2 + dir) * 4 + h) * 4096;
#pragma unroll
        for (int t = 0; t < 4; ++t)
#pragma unroll
            for (int r = 0; r < 4; ++r) st[t][r] = S0[(size_t)(16 * t + 4 * q + r) * 64 + e0 + c];
    } else {
#pragma unroll
        for (int t = 0; t < 4; ++t) st[t] = (f32x4){0.f, 0.f, 0.f, 0.f};
    }
    const float g64 = exp2f(64.f * lg2);
    const int r = tl >> 2, cp = (tl & 3) * 8;
    const float gr = exp2f((float)(63 - r) * lg2);
    u32x4 ka0, kb0, va0, vb0, ka1, kb1, va1, vb1;
#define B1_LOAD(nn, K1, K2, V1, V2) do { const int pos_ = dir ? (L - 1 - (64 * (nn) + r)) : (64 * (nn) + r); \
        const bf16* src_ = F.PROJ + (size_t)(row0 + pos_) * DINP + h * 64 + cp; \
        K1 = *(const u32x4*)(src_ + C_BK); K2 = *(const u32x4*)(src_ + C_BK + 32); V1 = *(const u32x4*)(src_ + C_BV); V2 = *(const u32x4*)(src_ + C_BV + 32); } while (0)
    B1_LOAD(0, ka0, kb0, va0, vb0); B1_LOAD(1, ka1, kb1, va1, vb1);
#define B1_STEP(nn, K1, K2, V1, V2, BUF) do { \
        LAS bf16* Kg = (LAS bf16*)(F.lds + (dir * 2 + (BUF)) * 18432); LAS bf16* Vs = Kg + 64 * 72; \
        { const int m_ = dir ? nch - 1 - (nn) : (nn); const size_t slot = ((size_t)(gc0 + m_) * 4 + h) * 2 + dir; \
          u32x4* sp = (u32x4*)(F.Bst + slot * 4096) + (wl * 2) * 64 + lane; \
          _Pragma("unroll") for (int k = 0; k < 2; ++k) sp[k * 64] = __builtin_bit_cast(u32x4, pack8(st[2 * k], st[2 * k + 1])); } \
        { float ka[8], kb[8]; unpack8(K1, ka); unpack8(K2, kb); \
          if (rot) { const int pos = dir ? (L - 1 - (64 * (nn) + r)) : (64 * (nn) + r); rot8(ka, kb, pos, cp); } \
          *(LAS u32x4*)(Kg + r * 72 + cp) = packf8(ka, gr); *(LAS u32x4*)(Kg + r * 72 + cp + 32) = packf8(kb, gr); \
          *(LAS u32x4*)(Vs + r * 72 + cp) = V1; *(LAS u32x4*)(Vs + r * 72 + cp + 32) = V2; } \
        if ((nn) + 2 < nch) B1_LOAD((nn) + 2, K1, K2, V1, V2); \
        __syncthreads(); \
        bf16x8 vb[2]; \
        _Pragma("unroll") for (int k = 0; k < 2; ++k) vb[k] = tr_frag(Vs, 72, 32 * k + 8 * q, e0, c); \
        _Pragma("unroll") for (int t = 0; t < 4; ++t) { st[t] = st[t] * g64; \
            _Pragma("unroll") for (int k = 0; k < 2; ++k) st[t] = MFMA16(tr_frag(Kg, 72, 32 * k + 8 * q, 16 * t, c), vb[k], st[t]); } } while (0)
    for (int n = 0; n < nch; n += 2) { B1_STEP(n, ka0, kb0, va0, vb0, 0); B1_STEP(n + 1, ka1, kb1, va1, vb1, 1); }
#undef B1_STEP
#undef B1_LOAD
    if (s < 32) {
        float* So = F.out + O_R + ((((size_t)s * DEPTH + l) * 2 + dir) * 4 + h) * 4096;
#pragma unroll
        for (int t = 0; t < 4; ++t)
#pragma unroll
            for (int rr = 0; rr < 4; ++rr) So[(size_t)(16 * t + 4 * q + rr) * 64 + e0 + c] = st[t][rr];
    }
}

__device__ __forceinline__ void gla_chain(Ctx& F, int l, int s, int h) {
    FRESH_TID(F);
    const int tid = F.tid, lane = F.lane, dir = F.wave >> 2, wl = F.wave & 3, tl = tid & 255, c = lane & 15, q = lane >> 4;
    int row0, L; seq_info(s, row0, L);
    const int nch = L / 32, nss = nch / 4, e0 = 16 * wl, gc0 = row0 >> 5;
    const int dl = lane & 7, jg = lane >> 3, d = 8 * wl + dl;
    LAS bf16* CL = (LAS bf16*)(F.lds + dir * 43520); LAS bf16* KR = CL + 2048; LAS bf16* Ku = CL + 7168; LAS bf16* Vs = CL + 12288; LAS float* dec = (LAS float*)(CL + 21504);
    float w2r[16];
#pragma unroll
    for (int r = 0; r < 16; ++r) w2r[r] = F.gla_w2[(((size_t)l * 2 + dir) * 16 + r) * 128 + h * 32 + d];
    const float b2v = F.gla_b2[((size_t)l * 2 + dir) * 128 + h * 32 + d];
    f32x4 st[2];
    if (s >= 32) {
        const float* S0 = F.st_gla + ((((size_t)(s - 32) * DEPTH + l) * 2 + dir) * 4 + h) * 2048;
#pragma unroll
        for (int t = 0; t < 2; ++t)
#pragma unroll
            for (int r = 0; r < 4; ++r) st[t][r] = S0[(size_t)(16 * t + 4 * q + r) * 64 + e0 + c];
    } else { st[0] = (f32x4){0.f, 0.f, 0.f, 0.f}; st[1] = st[0]; }
    u32x4 pc, pk[2], pv[4];
#define C1_LOAD(ss) do { \
        { const int j_ = tl >> 1; const int pos_ = dir ? (L - 1 - (128 * (ss) + j_)) : (128 * (ss) + j_); \
          pc = *(const u32x4*)(F.PROJ + (size_t)(row0 + pos_) * DINP + C_CLR + dir * 16 + (tl & 1) * 8); } \
        _Pragma("unroll") for (int i_ = 0; i_ < 2; ++i_) { const int p_ = tl + 256 * i_, j_ = p_ >> 2; const int pos_ = dir ? (L - 1 - (128 * (ss) + j_)) : (128 * (ss) + j_); \
          pk[i_] = *(const u32x4*)(F.PROJ + (size_t)(row0 + pos_) * DINP + C_CK + h * 32 + (p_ & 3) * 8); } \
        _Pragma("unroll") for (int i_ = 0; i_ < 4; ++i_) { const int p_ = tl + 256 * i_, j_ = p_ >> 3; const int pos_ = dir ? (L - 1 - (128 * (ss) + j_)) : (128 * (ss) + j_); \
          pv[i_] = *(const u32x4*)(F.PROJ + (size_t)(row0 + pos_) * DINP + C_CV + h * 64 + (p_ & 7) * 8); } } while (0)
    C1_LOAD(0);
    for (int ss = 0; ss < nss; ++ss) {
        *(LAS u32x4*)(CL + (tl >> 1) * 16 + (tl & 1) * 8) = pc;
#pragma unroll
        for (int i = 0; i < 2; ++i) { const int p = tl + 256 * i; *(LAS u32x4*)(KR + (p >> 2) * 40 + (p & 3) * 8) = pk[i]; }
#pragma unroll
        for (int i = 0; i < 4; ++i) { const int p = tl + 256 * i; *(LAS u32x4*)(Vs + (p >> 3) * 72 + (p & 7) * 8) = pv[i]; }
        if (ss + 1 < nss) C1_LOAD(ss + 1);
        __syncthreads();
#pragma unroll
        for (int cc = 0; cc < 4; ++cc) {
            float pb[4], kv[4], run = 0.f;
#pragma unroll
            for (int x = 0; x < 4; ++x) { const int j = 32 * cc + 4 * jg + x;
                const u32x4 c0 = *(const LAS u32x4*)(CL + j * 16), c1 = *(const LAS u32x4*)(CL + j * 16 + 8);
                float xx = b2v;
#pragma unroll
                for (int y = 0; y < 4; ++y) { xx += bflo(c0[y]) * w2r[2 * y] + bfhi(c0[y]) * w2r[2 * y + 1]; xx += bflo(c1[y]) * w2r[8 + 2 * y] + bfhi(c1[y]) * w2r[8 + 2 * y + 1]; }
                run += logsigmoidf_(xx) * 0.0625f; pb[x] = run; kv[x] = bf2f(KR[j * 40 + d]); }
            float tot = run;
#pragma unroll
            for (int o = 8; o < 64; o <<= 1) { const float t = __shfl_up(tot, o); if (lane >= o) tot += t; }
            const float off = tot - run, blast = __shfl(tot, 56 + dl);
#pragma unroll
            for (int x = 0; x < 4; ++x) Ku[(32 * cc + 4 * jg + x) * 40 + d] = (bf16)f2bf(kv[x] * __expf(blast - (off + pb[x])));
            if (jg == 0) dec[cc * 32 + d] = __expf(blast);
        }
        __syncthreads();
#pragma unroll
        for (int cc = 0; cc < 4; ++cc) {
            const int n = 4 * ss + cc;
            { const int m = dir ? nch - 1 - n : n; const size_t slot = ((size_t)(gc0 + m) * 4 + h) * 2 + dir;
              u32x4* sp = (u32x4*)(F.Cst + slot * 2048) + wl * 64 + lane; sp[0] = __builtin_bit_cast(u32x4, pack8(st[0], st[1])); }
            const bf16x8 vb = tr_frag(Vs, 72, 32 * cc + 8 * q, e0, c);
#pragma unroll
            for (int t = 0; t < 2; ++t) { const f32x4 dv = *(const LAS f32x4*)(dec + cc * 32 + 16 * t + 4 * q);
                st[t] = MFMA16(tr_frag(Ku, 40, 32 * cc + 8 * q, 16 * t, c), vb, st[t] * dv); }
        }
        __syncthreads();
    }
#undef C1_LOAD
    if (s < 32) {
        float* So = F.out + O_G + ((((size_t)s * DEPTH + l) * 2 + dir) * 4 + h) * 2048;
#pragma unroll
        for (int t = 0; t < 2; ++t)
#pragma unroll
            for (int r = 0; r < 4; ++r) So[(size_t)(16 * t + 4 * q + r) * 64 + e0 + c] = st[t][r];
    }
}

__device__ __forceinline__ void mixer_pass1(Ctx& F, int l, int qslot) {
    LAS int* slot = (LAS int*)(F.lds + 147456 - 64);
    unsigned* qc = F.ctl + CW_QUEUE + 64 * qslot;
    for (;;) {
        if (F.tid == 0) slot[0] = (int)__hip_atomic_fetch_add(qc, 1u, __ATOMIC_RELAXED, __HIP_MEMORY_SCOPE_AGENT);
        __syncthreads();
        const int u = slot[0];
        __syncthreads();
        if (u >= 640) break;
        int typ, s, h, dir = 0;
        if (u < 64) { typ = 0; s = 32 + (u >> 3); h = (u >> 1) & 3; dir = u & 1; }
        else if (u < 96) { const int v = u - 64; typ = 2; s = 32 + (v >> 2); h = v & 3; }
        else if (u < 128) { const int v = u - 96; typ = 1; s = 32 + (v >> 2); h = v & 3; }
        else if (u < 384) { const int v = u - 128; typ = 0; s = v >> 3; h = (v >> 1) & 3; dir = v & 1; }
        else if (u < 512) { const int v = u - 384; typ = 2; s = v >> 2; h = v & 3; }
        else { const int v = u - 512; typ = 1; s = v >> 2; h = v & 3; }
        if (typ == 0) mlstm_chain(F, l, s, h, dir); else if (typ == 1) ret_chain(F, l, s, h); else gla_chain(F, l, s, h);
    }
}

constexpr int T2_UF = 0, T2_MXF = 64, T2_UB = 128, T2_MXB = 192, T2_WAF = 256, T2_WAB = 320, T2_EMF = 384, T2_EMB = 448, T2_DPF = 512, T2_DPB = 768, T2_QNF = 1024, T2_QNB = 1088,
              T2_NVF = 1152, T2_NVB = 1280, T2_SSP = 1408;
__device__ __forceinline__ void mlstm_out(Ctx& F, int l, int s, int h, int m) {
    FRESH_TID(F);
    const int tid = F.tid, lane = F.lane, w = F.wave, c = lane & 15, q = lane >> 4;
    LAS bf16* Qs = (LAS bf16*)(F.lds); LAS bf16* Ks = (LAS bf16*)(F.lds + 17408); LAS bf16* Vs = (LAS bf16*)(F.lds + 34816);
    LAS bf16* Pf = (LAS bf16*)(F.lds + 52224); LAS bf16* Pb = (LAS bf16*)(F.lds + 61440); LAS float* tab = (LAS float*)(F.lds + 70656);
    int row0, L; seq_info(s, row0, L);
    const int e0 = 16 * w, gc = (row0 >> 6) + m, rowb = row0 + 64 * m;
    const size_t slot_f = ((size_t)gc * 4 + h) * 2, slot_b = slot_f + 1;
    u32x4 cff[4], cfb[4];
    { const u32x4* pf_ = (const u32x4*)(F.Ast + slot_f * 16384) + (w * 4) * 64 + lane; const u32x4* pb_ = (const u32x4*)(F.Ast + slot_b * 16384) + (w * 4) * 64 + lane;
#pragma unroll
      for (int k = 0; k < 4; ++k) { cff[k] = pf_[k * 64]; cfb[k] = pb_[k * 64]; } }
    const bf16* gp = F.PROJ + (size_t)(rowb + lane) * DINP + C_AG + h;
    const float i_f = bf2f(gp[0]) + F.gate_b[l * 16 + h], f_f = bf2f(gp[4]) + F.gate_b[l * 16 + 4 + h], i_b = bf2f(gp[8]) + F.gate_b[l * 16 + 8 + h], f_b = bf2f(gp[12]) + F.gate_b[l * 16 + 12 + h];
    const float mpf = F.Anm[slot_f * 132 + 128], mpb = F.Anm[slot_b * 132 + 128];
#pragma unroll
    for (int i = 0; i < 2; ++i) { const int p = tid + 512 * i, r = p >> 4, cp = (p & 15) * 8;
        const bf16* src = F.PROJ + (size_t)(rowb + r) * DINP + h * 128 + cp;
        *(LAS u32x4*)(Qs + r * RSA + cp) = *(const u32x4*)(src + C_AQ); *(LAS u32x4*)(Ks + r * RSA + cp) = *(const u32x4*)(src + C_AK); *(LAS u32x4*)(Vs + r * RSA + cp) = *(const u32x4*)(src + C_AV); }
    if (tid < 128) tab[T2_NVF + tid] = F.Anm[slot_f * 132 + tid]; else if (tid < 256) tab[T2_NVB + tid - 128] = F.Anm[slot_b * 132 + tid - 128];
    float Ff = logsigmoidf_(f_f), Fb = logsigmoidf_(f_b);
#pragma unroll
    for (int o = 1; o < 64; o <<= 1) { const float t = __shfl_up(Ff, o); if (lane >= o) Ff += t; const float t2 = __shfl_down(Fb, o); if (lane + o < 64) Fb += t2; }
    const float uf = i_f - Ff, ub = i_b - Fb;
    float pmf = uf, pmb = ub;
#pragma unroll
    for (int o = 1; o < 64; o <<= 1) { const float t = __shfl_up(pmf, o); if (lane >= o) pmf = fmaxf(pmf, t); const float t2 = __shfl_down(pmb, o); if (lane + o < 64) pmb = fmaxf(pmb, t2); }
    const float mxf = fmaxf(mpf, pmf), mxb = fmaxf(mpb, pmb);
    if (w == 0) { tab[T2_UF + lane] = uf; tab[T2_MXF + lane] = mxf; tab[T2_UB + lane] = ub; tab[T2_MXB + lane] = mxb;
        tab[T2_WAF + lane] = __expf(mpf - mxf); tab[T2_WAB + lane] = __expf(mpb - mxb); tab[T2_EMF + lane] = __expf(-(Ff + mxf)); tab[T2_EMB + lane] = __expf(-(Fb + mxb)); }
    __syncthreads();
#pragma unroll
    for (int x = 0; x < 2; ++x) {
        const int tix = w + 8 * x, jt = tix & 3, it = tix >> 2;
        f32x4 acc = (f32x4){0.f, 0.f, 0.f, 0.f};
#pragma unroll
        for (int k = 0; k < 4; ++k) acc = MFMA16(*(const LAS bf16x8*)(Ks + (16 * jt + c) * RSA + 32 * k + 8 * q), *(const LAS bf16x8*)(Qs + (16 * it + c) * RSA + 32 * k + 8 * q), acc);
        const int i = 16 * it + c, j0 = 16 * jt + 4 * q;
        const float mxfi = tab[T2_MXF + i], mxbi = tab[T2_MXB + i];
        const f32x4 ufj = *(const LAS f32x4*)(tab + T2_UF + j0), ubj = *(const LAS f32x4*)(tab + T2_UB + j0);
        float pf[4], pb[4], dsf = 0.f, dsb = 0.f;
#pragma unroll
        for (int r = 0; r < 4; ++r) { pf[r] = (j0 + r <= i) ? acc[r] * __expf(ufj[r] - mxfi) : 0.f; pb[r] = (j0 + r >= i) ? acc[r] * __expf(ubj[r] - mxbi) : 0.f; dsf += pf[r]; dsb += pb[r]; }
        dsf += __shfl_xor(dsf, 16); dsf += __shfl_xor(dsf, 32); dsb += __shfl_xor(dsb, 16); dsb += __shfl_xor(dsb, 32);
        if (q == 0) { tab[T2_DPF + jt * 64 + i] = dsf; tab[T2_DPB + jt * 64 + i] = dsb; }
        u32x2 pw; pw.x = pk2(pf[0], pf[1]); pw.y = pk2(pf[2], pf[3]); *(LAS u32x2*)(Pf + i * 72 + j0) = pw;
        pw.x = pk2(pb[0], pb[1]); pw.y = pk2(pb[2], pb[3]); *(LAS u32x2*)(Pb + i * 72 + j0) = pw;
    }
    {
        const int i = tid >> 3, d0 = (tid & 7) * 16;
        const u32x4 qa = *(const LAS u32x4*)(Qs + i * RSA + d0), qb = *(const LAS u32x4*)(Qs + i * RSA + d0 + 8);
        float sf = 0.f, sb = 0.f;
#pragma unroll
        for (int j = 0; j < 4; ++j) { const float a0 = bflo(qa[j]), a1 = bfhi(qa[j]), b0 = bflo(qb[j]), b1 = bfhi(qb[j]);
            sf += a0 * tab[T2_NVF + d0 + 2 * j] + a1 * tab[T2_NVF + d0 + 2 * j + 1] + b0 * tab[T2_NVF + d0 + 8 + 2 * j] + b1 * tab[T2_NVF + d0 + 8 + 2 * j + 1];
            sb += a0 * tab[T2_NVB + d0 + 2 * j] + a1 * tab[T2_NVB + d0 + 2 * j + 1] + b0 * tab[T2_NVB + d0 + 8 + 2 * j] + b1 * tab[T2_NVB + d0 + 8 + 2 * j + 1]; }
        sf += __shfl_xor(sf, 1); sf += __shfl_xor(sf, 2); sf += __shfl_xor(sf, 4); sb += __shfl_xor(sb, 1); sb += __shfl_xor(sb, 2); sb += __shfl_xor(sb, 4);
        if ((tid & 7) == 0) { tab[T2_QNF + i] = sf; tab[T2_QNB + i] = sb; }
    }
    __syncthreads();
    bf16x8 vf[2];
#pragma unroll
    for (int k = 0; k < 2; ++k) vf[k] = tr_frag(Vs, RSA, 32 * k + 8 * q, e0, c);
    f32x4 ya[4];
#pragma unroll
    for (int it = 0; it < 4; ++it) {
        const int i = 16 * it + c;
        f32x4 aof = (f32x4){0.f, 0.f, 0.f, 0.f}, aob = aof, aif = aof, aib = aof;
        aof = MFMA16(vf[0], *(const LAS bf16x8*)(Pf + i * 72 + 8 * q), aof);
        if (it >= 2) aof = MFMA16(vf[1], *(const LAS bf16x8*)(Pf + i * 72 + 32 + 8 * q), aof);
        aob = MFMA16(vf[1], *(const LAS bf16x8*)(Pb + i * 72 + 32 + 8 * q), aob);
        if (it < 2) aob = MFMA16(vf[0], *(const LAS bf16x8*)(Pb + i * 72 + 8 * q), aob);
#pragma unroll
        for (int k = 0; k < 4; ++k) {
            const bf16x8 qp = mk8(*(const LAS bf16x4*)(Qs + i * RSA + 32 * k + 4 * q), *(const LAS bf16x4*)(Qs + i * RSA + 32 * k + 16 + 4 * q));
            aif = MFMA16(__builtin_bit_cast(bf16x8, cff[k]), qp, aif); aib = MFMA16(__builtin_bit_cast(bf16x8, cfb[k]), qp, aib); }
        const float waf = tab[T2_WAF + i], wab = tab[T2_WAB + i];
        const float denf = tab[T2_DPF + i] + tab[T2_DPF + 64 + i] + tab[T2_DPF + 128 + i] + tab[T2_DPF + 192 + i] + waf * tab[T2_QNF + i];
        const float denb = tab[T2_DPB + i] + tab[T2_DPB + 64 + i] + tab[T2_DPB + 128 + i] + tab[T2_DPB + 192 + i] + wab * tab[T2_QNB + i];
        const float rdf = 1.0f / fmaxf(fabsf(denf), tab[T2_EMF + i]), rdb = 1.0f / fmaxf(fabsf(denb), tab[T2_EMB + i]);
        const f32x4 hv = (aof + aif * waf) * rdf + (aob + aib * wab) * rdb;
        const u32x2 og = *(const u32x2*)(F.PROJ + (size_t)(rowb + i) * DINP + C_AO + h * 128 + e0 + 4 * q);
        f32x4 y; y[0] = hv[0] * sigmoidf_(bflo(og.x)); y[1] = hv[1] * sigmoidf_(bfhi(og.x)); y[2] = hv[2] * sigmoidf_(bflo(og.y)); y[3] = hv[3] * sigmoidf_(bfhi(og.y));
        ya[it] = y;
        float ss = (y[0] * y[0] + y[1] * y[1]) + (y[2] * y[2] + y[3] * y[3]);
        ss += __shfl_xor(ss, 16); ss += __shfl_xor(ss, 32);
        if (q == 0) tab[T2_SSP + w * 64 + i] = ss;
    }
    __syncthreads();
    const f32x4 hg = *(const f32x4*)(F.hn_g + l * 1024 + h * 128 + e0 + 4 * q);
#pragma unroll
    for (int it = 0; it < 4; ++it) {
        const int i = 16 * it + c;
        float ss = 0.f;
#pragma unroll
        for (int ww = 0; ww < 8; ++ww) ss += tab[T2_SSP + ww * 64 + i];
        const float rs = 1.0f / sqrtf(ss * (1.f / 128.f) + EPS);
        const u32x2 zg = *(const u32x2*)(F.PROJ + (size_t)(rowb + i) * DINP + C_AZ + h * 128 + e0 + 4 * q);
        const f32x4 y = ya[it] * rs * hg;
        u32x2 o; o.x = pk2(y[0] * siluf_(bflo(zg.x)), y[1] * siluf_(bfhi(zg.x))); o.y = pk2(y[2] * siluf_(bflo(zg.y)), y[3] * siluf_(bfhi(zg.y)));
        *(u32x2*)(F.R1 + (size_t)(rowb + i) * 1024 + h * 128 + e0 + 4 * q) = o;
    }
}

constexpr int RSB = 264;
__device__ __forceinline__ void ret_out(Ctx& F, int l, int s, int m) {
    FRESH_TID(F);
    const int tid = F.tid, lane = F.lane, w = F.wave, hh = w >> 1, ih = w & 1, c = lane & 15, q = lane >> 4;
    LAS bf16* Qs = (LAS bf16*)(F.lds); LAS bf16* Ks = (LAS bf16*)(F.lds + 33792); LAS bf16* Vs = (LAS bf16*)(F.lds + 67584); LAS bf16* Pw = (LAS bf16*)(F.lds + 101376 + w * 4608);
    int row0, L; seq_info(s, row0, L);
    const int gc = (row0 >> 6) + m, rowb = row0 + 64 * m;
    const bool rot = s >= 32;
    const float lgf = logsigmoidf_(F.ret_logit[(l * 2 + 0) * 4 + hh]) * 1.4426950408889634f, lgb = logsigmoidf_(F.ret_logit[(l * 2 + 1) * 4 + hh]) * 1.4426950408889634f;
    u32x4 cff[4][2], cfb[4][2];
    { const size_t slot_f = ((size_t)gc * 4 + hh) * 2;
      const u32x4* pf_ = (const u32x4*)(F.Bst + slot_f * 4096) + lane; const u32x4* pb_ = (const u32x4*)(F.Bst + (slot_f + 1) * 4096) + lane;
#pragma unroll
      for (int es = 0; es < 4; ++es)
#pragma unroll
          for (int k = 0; k < 2; ++k) { cff[es][k] = pf_[(es * 2 + k) * 64]; cfb[es][k] = pb_[(es * 2 + k) * 64]; } }
#pragma unroll
    for (int i = 0; i < 2; ++i) {
        const int item = tid + 512 * i, r = item >> 4, hd = (item >> 2) & 3, cp = (item & 3) * 8;
        const bf16* src = F.PROJ + (size_t)(rowb + r) * DINP + hd * 64 + cp;
        float qa[8], qb[8], ka[8], kb[8];
        unpack8(*(const u32x4*)(src + C_BQ), qa); unpack8(*(const u32x4*)(src + C_BQ + 32), qb); unpack8(*(const u32x4*)(src + C_BK), ka); unpack8(*(const u32x4*)(src + C_BK + 32), kb);
        if (rot) { rot8(qa, qb, 64 * m + r, cp); rot8(ka, kb, 64 * m + r, cp); }
        *(LAS u32x4*)(Qs + r * RSB + hd * 64 + cp) = packf8(qa, 1.f); *(LAS u32x4*)(Qs + r * RSB + hd * 64 + cp + 32) = packf8(qb, 1.f);
        *(LAS u32x4*)(Ks + r * RSB + hd * 64 + cp) = packf8(ka, 1.f); *(LAS u32x4*)(Ks + r * RSB + hd * 64 + cp + 32) = packf8(kb, 1.f);
    }
#pragma unroll
    for (int i = 0; i < 4; ++i) { const int p = tid + 512 * i, r = p >> 5, cp = (p & 31) * 8;
        *(LAS u32x4*)(Vs + r * RSB + cp) = *(const u32x4*)(F.PROJ + (size_t)(rowb + r) * DINP + C_BV + cp); }
    __syncthreads();
#pragma unroll
    for (int itl = 0; itl < 2; ++itl)
#pragma unroll
        for (int jt = 0; jt < 4; ++jt) {
            const int it = 2 * ih + itl;
            f32x4 acc = (f32x4){0.f, 0.f, 0.f, 0.f};
#pragma unroll
            for (int k = 0; k < 2; ++k) acc = MFMA16(*(const LAS bf16x8*)(Ks + (16 * jt + c) * RSB + hh * 64 + 32 * k + 8 * q), *(const LAS bf16x8*)(Qs + (16 * it + c) * RSB + hh * 64 + 32 * k + 8 * q), acc);
            const int i = 16 * it + c, j0 = 16 * jt + 4 * q;
            float p[4];
#pragma unroll
            for (int r = 0; r < 4; ++r) { const int j = j0 + r; const float wf = (j <= i) ? exp2f((float)(i - j) * lgf) : 0.f, wb = (j >= i) ? exp2f((float)(j - i) * lgb) : 0.f; p[r] = acc[r] * (wf + wb); }
            u32x2 pw; pw.x = pk2(p[0], p[1]); pw.y = pk2(p[2], p[3]);
            *(LAS u32x2*)(Pw + (16 * itl + c) * 72 + j0) = pw;
        }
    __syncthreads();
    bf16x8 vf[4][2];
#pragma unroll
    for (int es = 0; es < 4; ++es)
#pragma unroll
        for (int k = 0; k < 2; ++k) vf[es][k] = tr_frag(Vs, RSB, 32 * k + 8 * q, hh * 64 + 16 * es, c);
#pragma unroll
    for (int itl = 0; itl < 2; ++itl) {
        const int i = 16 * (2 * ih + itl) + c;
        const float wqf = exp2f((float)(i + 1) * lgf), wqb = exp2f((float)(64 - i) * lgb);
        bf16x8 qp[2], pp[2];
#pragma unroll
        for (int k = 0; k < 2; ++k) { qp[k] = mk8(*(const LAS bf16x4*)(Qs + i * RSB + hh * 64 + 32 * k + 4 * q), *(const LAS bf16x4*)(Qs + i * RSB + hh * 64 + 32 * k + 16 + 4 * q));
            pp[k] = *(const LAS bf16x8*)(Pw + (16 * itl + c) * 72 + 32 * k + 8 * q); }
        f32x4 yb[4]; float ss = 0.f;
#pragma unroll
        for (int es = 0; es < 4; ++es) {
            f32x4 ao = (f32x4){0.f, 0.f, 0.f, 0.f}, af = ao, ab = ao;
#pragma unroll
            for (int k = 0; k < 2; ++k) { ao = MFMA16(vf[es][k], pp[k], ao); af = MFMA16(__builtin_bit_cast(bf16x8, cff[es][k]), qp[k], af); ab = MFMA16(__builtin_bit_cast(bf16x8, cfb[es][k]), qp[k], ab); }
            const f32x4 y = ao + af * wqf + ab * wqb; yb[es] = y;
            ss += (y[0] * y[0] + y[1] * y[1]) + (y[2] * y[2] + y[3] * y[3]);
        }
        ss += __shfl_xor(ss, 16); ss += __shfl_xor(ss, 32);
        const float rs = 1.0f / sqrtf(ss * (1.f / 64.f) + EPS);
#pragma unroll
        for (int es = 0; es < 4; ++es) {
            const int col = hh * 64 + 16 * es + 4 * q;
            const u32x2 zg = *(const u32x2*)(F.PROJ + (size_t)(rowb + i) * DINP + C_BZ + col);
            const f32x4 hg = *(const f32x4*)(F.hn_g + l * 1024 + 512 + col);
            const f32x4 y = yb[es] * rs * hg;
            u32x2 o; o.x = pk2(y[0] * siluf_(bflo(zg.x)), y[1] * siluf_(bfhi(zg.x))); o.y = pk2(y[2] * siluf_(bflo(zg.y)), y[3] * siluf_(bfhi(zg.y)));
            *(u32x2*)(F.R1 + (size_t)(rowb + i) * 1024 + 512 + col) = o;
        }
    }
}

__device__ __forceinline__ void gla_out(Ctx& F, int l, int s, int m) {
    FRESH_TID(F);
    const int lane = F.lane, w = F.wave, hh = w >> 1, c32 = w & 1, c = lane & 15, q = lane >> 4;
    LAS bf16* base = (LAS bf16*)(F.lds + w * 17408);
    LAS bf16* Qf = base; LAS bf16* Kf = base + 1280; LAS bf16* Qb = base + 2560; LAS bf16* Kb = base + 3840; LAS bf16* Vs = base + 5120; LAS bf16* Pw = base + 7424;
    int row0, L; seq_info(s, row0, L);
    const int rowc = row0 + 64 * m + 32 * c32, gc32 = (row0 >> 5) + 2 * m + c32;
    const int dl = lane & 7, jg = lane >> 3;
    u32x4 cff[4], cfb[4];
    { const size_t slot_f = ((size_t)gc32 * 4 + hh) * 2;
      const u32x4* pf_ = (const u32x4*)(F.Cst + slot_f * 2048) + lane; const u32x4* pb_ = (const u32x4*)(F.Cst + (slot_f + 1) * 2048) + lane;
#pragma unroll
      for (int es = 0; es < 4; ++es) { cff[es] = pf_[es * 64]; cfb[es] = pb_[es * 64]; } }
    u32x4 cl[4][4];
#pragma unroll
    for (int x = 0; x < 4; ++x) { const bf16* src = F.PROJ + (size_t)(rowc + 4 * jg + x) * DINP + C_CLR;
#pragma unroll
        for (int y = 0; y < 4; ++y) cl[x][y] = *(const u32x4*)(src + 8 * y); }
#pragma unroll
    for (int i = 0; i < 4; ++i) { const int p = lane + 64 * i, r = p >> 3, cp = (p & 7) * 8;
        *(LAS u32x4*)(Vs + r * 72 + cp) = *(const u32x4*)(F.PROJ + (size_t)(rowc + r) * DINP + C_CV + hh * 64 + cp); }
#pragma unroll 1
    for (int dg = 0; dg < 4; ++dg) {
        const int d = 8 * dg + dl;
        float bfw[4], bbw[4];
        {
            const float* w2 = F.gla_w2 + (((size_t)l * 2 + 0) * 16) * 128 + hh * 32 + d; const float b2v = F.gla_b2[((size_t)l * 2 + 0) * 128 + hh * 32 + d];
            float w2r[16];
#pragma unroll
            for (int r = 0; r < 16; ++r) w2r[r] = w2[r * 128];
            float run = 0.f;
#pragma unroll
            for (int x = 0; x < 4; ++x) { float xx = b2v;
#pragma unroll
                for (int j = 0; j < 4; ++j) { xx += bflo(cl[x][0][j]) * w2r[2 * j] + bfhi(cl[x][0][j]) * w2r[2 * j + 1]; xx += bflo(cl[x][1][j]) * w2r[8 + 2 * j] + bfhi(cl[x][1][j]) * w2r[8 + 2 * j + 1]; }
                run += logsigmoidf_(xx) * 0.0625f; bfw[x] = run; }
            float tot = run;
#pragma unroll
            for (int o = 8; o < 64; o <<= 1) { const float t = __shfl_up(tot, o); if (lane >= o) tot += t; }
            const float off = tot - run;
#pragma unroll
            for (int x = 0; x < 4; ++x) bfw[x] += off;
        }
        {
            const float* w2 = F.gla_w2 + (((size_t)l * 2 + 1) * 16) * 128 + hh * 32 + d; const float b2v = F.gla_b2[((size_t)l * 2 + 1) * 128 + hh * 32 + d];
            float w2r[16];
#pragma unroll
            for (int r = 0; r < 16; ++r) w2r[r] = w2[r * 128];
            float la[4];
#pragma unroll
            for (int x = 0; x < 4; ++x) { float xx = b2v;
#pragma unroll
                for (int j = 0; j < 4; ++j) { xx += bflo(cl[x][2][j]) * w2r[2 * j] + bfhi(cl[x][2][j]) * w2r[2 * j + 1]; xx += bflo(cl[x][3][j]) * w2r[8 + 2 * j] + bfhi(cl[x][3][j]) * w2r[8 + 2 * j + 1]; }
                la[x] = logsigmoidf_(xx) * 0.0625f; }
            float run = 0.f;
#pragma unroll
            for (int x = 3; x >= 0; --x) { run += la[x]; bbw[x] = run; }
            float tot = run;
#pragma unroll
            for (int o = 8; o < 64; o <<= 1) { const float t = __shfl_down(tot, o); if (lane + o < 64) tot += t; }
            const float off = tot - run;
#pragma unroll
            for (int x = 0; x < 4; ++x) bbw[x] += off;
        }
#pragma unroll
        for (int x = 0; x < 4; ++x) { const int p = 4 * jg + x;
            const bf16* src = F.PROJ + (size_t)(rowc + p) * DINP + hh * 32 + d;
            const float qv = bf2f(src[C_CQ]), kv = bf2f(src[C_CK]);
            Qf[p * 40 + d] = (bf16)f2bf(qv * __expf(bfw[x])); Kf[p * 40 + d] = (bf16)f2bf(kv * __expf(-bfw[x]));
            Qb[p * 40 + d] = (bf16)f2bf(qv * __expf(bbw[x])); Kb[p * 40 + d] = (bf16)f2bf(kv * __expf(-bbw[x])); }
    }
    __syncthreads();
#pragma unroll
    for (int it = 0; it < 2; ++it)
#pragma unroll
        for (int jt = 0; jt < 2; ++jt) {
            const f32x4 z = (f32x4){0.f, 0.f, 0.f, 0.f};
            const f32x4 af = MFMA16(*(const LAS bf16x8*)(Kf + (16 * jt + c) * 40 + 8 * q), *(const LAS bf16x8*)(Qf + (16 * it + c) * 40 + 8 * q), z);
            const f32x4 ab = MFMA16(*(const LAS bf16x8*)(Kb + (16 * jt + c) * 40 + 8 * q), *(const LAS bf16x8*)(Qb + (16 * it + c) * 40 + 8 * q), z);
            const int i = 16 * it + c, j0 = 16 * jt + 4 * q;
            float p[4];
#pragma unroll
            for (int r = 0; r < 4; ++r) p[r] = ((j0 + r <= i) ? af[r] : 0.f) + ((j0 + r >= i) ? ab[r] : 0.f);
            u32x2 pw; pw.x = pk2(p[0], p[1]); pw.y = pk2(p[2], p[3]);
            *(LAS u32x2*)(Pw + i * 40 + j0) = pw;
        }
    __syncthreads();
    bf16x8 vf[4];
#pragma unroll
    for (int es = 0; es < 4; ++es) vf[es] = tr_frag(Vs, 72, 8 * q, 16 * es, c);
#pragma unroll
    for (int it = 0; it < 2; ++it) {
        const int i = 16 * it + c;
        const bf16x8 pp = *(const LAS bf16x8*)(Pw + i * 40 + 8 * q);
        const bf16x8 qpf = mk8(*(const LAS bf16x4*)(Qf + i * 40 + 4 * q), *(const LAS bf16x4*)(Qf + i * 40 + 16 + 4 * q));
        const bf16x8 qpb = mk8(*(const LAS bf16x4*)(Qb + i * 40 + 4 * q), *(const LAS bf16x4*)(Qb + i * 40 + 16 + 4 * q));
        f32x4 yc[4]; float ss = 0.f;
#pragma unroll
        for (int es = 0; es < 4; ++es) {
            f32x4 ao = (f32x4){0.f, 0.f, 0.f, 0.f};
            ao = MFMA16(vf[es], pp, ao); ao = MFMA16(__builtin_bit_cast(bf16x8, cff[es]), qpf, ao); ao = MFMA16(__builtin_bit_cast(bf16x8, cfb[es]), qpb, ao);
            yc[es] = ao; ss += (ao[0] * ao[0] + ao[1] * ao[1]) + (ao[2] * ao[2] + ao[3] * ao[3]);
        }
        ss += __shfl_xor(ss, 16); ss += __shfl_xor(ss, 32);
        const float rs = 1.0f / sqrtf(ss * (1.f / 64.f) + EPS);
#pragma unroll
        for (int es = 0; es < 4; ++es) {
            const int col = hh * 64 + 16 * es + 4 * q;
            const u32x2 zg = *(const u32x2*)(F.PROJ + (size_t)(rowc + i) * DINP + C_CZ + col);
            const f32x4 hg = *(const f32x4*)(F.hn_g + l * 1024 + 768 + col);
            const f32x4 y = yc[es] * rs * hg;
            u32x2 o; o.x = pk2(y[0] * siluf_(bflo(zg.x)), y[1] * siluf_(bfhi(zg.x))); o.y = pk2(y[2] * siluf_(bflo(zg.y)), y[3] * siluf_(bfhi(zg.y)));
            *(u32x2*)(F.R1 + (size_t)(rowc + i) * 1024 + 768 + col) = o;
        }
    }
}

__device__ __forceinline__ void mixer_pass2(Ctx& F, int l, int qslot) {
    LAS int* slot = (LAS int*)(F.lds + 147456 - 64);
    unsigned* qc = F.ctl + CW_QUEUE + 64 * qslot;
    for (;;) {
        if (F.tid == 0) slot[0] = (int)__hip_atomic_fetch_add(qc, 1u, __ATOMIC_RELAXED, __HIP_MEMORY_SCOPE_AGENT);
        __syncthreads();
        const int u = slot[0];
        __syncthreads();
        if (u >= 1536) break;
        const int gc = u < 1024 ? (u >> 2) : ((u - 1024) & 255);
        int s, m; if (gc < 128) { s = gc >> 2; m = gc & 3; } else { s = 32 + ((gc - 128) >> 4); m = (gc - 128) & 15; }
        if (u < 1024) mlstm_out(F, l, s, u & 3, m); else if (u < 1280) ret_out(F, l, s, m); else gla_out(F, l, s, m);
    }
}

__global__ void __launch_bounds__(512, 2) fwd_kernel(Args args) {
    extern __shared__ __attribute__((aligned(16))) unsigned char lds_raw[];
    Ctx F;
    F.lds = (LAS unsigned char*)lds_raw;
    F.tid = threadIdx.x; F.lane = F.tid & 63; F.wave = __builtin_amdgcn_readfirstlane(F.tid >> 6); F.G = gridDim.x; F.bid = blockIdx.x;
    F.x_prompt = args.in[0]; F.x_sample = args.in[1]; F.st_C = args.in[2]; F.st_n = args.in[3]; F.st_m = args.in[4]; F.st_ret = args.in[5]; F.st_gla = args.in[6];
    F.cvec = args.in[7]; F.c_ctx = args.in[8]; F.norm_g = args.in[9]; F.w_ada = args.in[10]; F.b_ada = args.in[11]; F.w_in = args.in[12]; F.gate_b = args.in[13];
    F.ret_logit = args.in[14]; F.gla_w2 = args.in[15]; F.gla_b2 = args.in[16]; F.hn_g = args.in[17]; F.w_out = args.in[18]; F.final_g = args.in[19];
    F.out = args.out; unsigned char* ws = args.ws;
    F.ctl = (unsigned*)(ws + WS_CTL); F.mod = (float*)(ws + WS_MOD); F.WinT = (bf16*)(ws + WS_WIN); F.WoutT = (bf16*)(ws + WS_WOUT);
    F.R1 = (bf16*)(ws + WS_R1); F.PROJ = (bf16*)(ws + WS_PROJ); F.Ast = (bf16*)(ws + WS_AST); F.Bst = (bf16*)(ws + WS_BST); F.Cst = (bf16*)(ws + WS_CST); F.Anm = (float*)(ws + WS_ANM);
    const int lo = args.ph_lo, hi = args.ph_hi;
#if N_LAUNCH_MODE == 1
    cg::grid_group grid = cg::this_grid();
    if (F.tid < 8) ((LAS unsigned*)(F.lds + LDS_BYTES - 32))[F.tid] = 0u;
    __syncthreads();
    const XcdBarrier xbar = xcd_barrier_post(F.ctl + CW_BAR, (volatile LAS unsigned*)(F.lds + LDS_BYTES - 32));
#define SEAM(k) do { if (lo <= (k) && (k) + 1 < hi) { if ((k) == 0) grid.sync(); else xcd_barrier(xbar); } } while (0)
#else
#define SEAM(k) do { } while (0)
#endif
#define IN(k) (lo <= (k) && (k) < hi)
    int ph = 0;
    if (IN(ph)) { p0_prologue(F); } SEAM(ph); ++ph;
    for (int l = 0; l < DEPTH; ++l) {
        if (IN(ph)) { hprep_phase(F, l); } SEAM(ph); ++ph;
        if (IN(ph)) {
            pg8::Gemm g{F.R1, F.WinT + (size_t)l * DINP * 1024, NTOK, DINP, 1024}; pg8::StaticOrder S; S.init(NTOK, DINP, F.G, F.bid);
            pg8::EpiBf16 E{F.PROJ, DINP};
            pg8::gemm_phase<pg8::EpiBf16, pg8::StaticOrder, true, true>(F.lds, g, S, E);
#ifdef PROBE_GEMM2
            xcd_barrier(xbar); pg8::gemm_phase<pg8::EpiBf16, pg8::StaticOrder, true, true>(F.lds, g, S, E);
#endif
        } SEAM(ph); ++ph;
        if (IN(ph)) { mixer_pass1(F, l, l);
#ifdef PROBE_P1X2
            xcd_barrier(xbar); mixer_pass1(F, l, l + 8);
#endif
        } SEAM(ph); ++ph;
        if (IN(ph)) { mixer_pass2(F, l, l + 4);
#ifdef PROBE_P2X2
            xcd_barrier(xbar); mixer_pass2(F, l, l + 12);
#endif
        } SEAM(ph); ++ph;
        if (IN(ph)) {
            pg8::Gemm g{F.R1, F.WoutT + (size_t)l * 1024 * 1024, NTOK, 1024, 1024}; pg8::StaticOrder S; S.init(NTOK, 1024, F.G, F.bid);
            pg8::EpiResid E{l == 0 ? F.x_prompt : F.out, l == 0 ? F.x_sample : F.out + (size_t)NCTX * 1024, F.out, F.mod + (size_t)l * 9 * 3072 + 2048};
            pg8::gemm_phase<pg8::EpiResid, pg8::StaticOrder, true, true>(F.lds, g, S, E);
        } SEAM(ph); ++ph;
    }
    if (IN(ph)) { final_phase(F); }
}

extern "C" void kernel_launch(void* const* d_in, const int* in_sizes, int n_in, void* d_out, int out_size, void* d_ws, size_t ws_size, hipStream_t stream) {
    static int grid = 0;
    if (grid == 0) {
        if (n_in != 20 || out_size != (int)O_END || ws_size < WS_END) { fprintf(stderr, "kernel_launch: unexpected shapes: n_in %d out %d ws %zu\n", n_in, out_size, ws_size); grid = -1; return; }
        int dev = 0, cus = 0, per_cu = 0;
        if (hipGetDevice(&dev) != hipSuccess || hipDeviceGetAttribute(&cus, hipDeviceAttributeMultiprocessorCount, dev) != hipSuccess) { grid = -1; return; }
        if (hipFuncSetAttribute((const void*)fwd_kernel, hipFuncAttributeMaxDynamicSharedMemorySize, LDS_BYTES) != hipSuccess) { fprintf(stderr, "kernel_launch: hipFuncSetAttribute failed\n"); grid = -1; return; }
        if (hipOccupancyMaxActiveBlocksPerMultiprocessor(&per_cu, (const void*)fwd_kernel, 512, LDS_BYTES) != hipSuccess || per_cu < 1) { fprintf(stderr, "kernel_launch: occupancy query says %d blocks per CU\n", per_cu); per_cu = 1; }
        (void)hipGetLastError();
        grid = cus;
    }
    if (grid < 0) return;
    (void)hipMemsetAsync((char*)d_ws + WS_CTL, 0, CTL_ZERO_BYTES, stream);
    Args a{};
    for (int i = 0; i < 20; ++i) a.in[i] = (const float*)d_in[i];
    a.out = (float*)d_out; a.ws = (unsigned char*)d_ws;
#if N_LAUNCH_MODE == 1
    a.ph_lo = 0; a.ph_hi = NPHASE;
    void* kargs[] = {&a};
    hipError_t e = hipLaunchCooperativeKernel((const void*)fwd_kernel, dim3(grid), dim3(512), kargs, LDS_BYTES, stream);
    if (e != hipSuccess) fprintf(stderr, "kernel_launch: cooperative launch failed: %s (grid %d)\n", hipGetErrorString(e), grid);
#else
    for (int p = 0; p < NPHASE; ++p) { a.ph_lo = p; a.ph_hi = p + 1; hipLaunchKernelGGL(fwd_kernel, dim3(grid), dim3(512), LDS_BYTES, stream, a); }
#endif
}
```

```cpp
#include <hip/hip_runtime.h>
#include <hip/hip_cooperative_groups.h>
#include <cstdio>
#include <cstdint>
namespace cg = cooperative_groups;

#define TM_XA 0
#define TM_XB 1
#define TM_YA 0
#define TM_YB 1
#define TM_UNIT1 0
#define TM_UNIT2 0
#ifndef USE_CG_SYNC
#define USE_CG_SYNC 0
#endif
#ifndef N_LAUNCH_MODE
#define N_LAUNCH_MODE 1
#endif

#define LAS __attribute__((address_space(3)))
typedef unsigned short bf16;
typedef short bf16x8 __attribute__((ext_vector_type(8)));
typedef short bf16x4 __attribute__((ext_vector_type(4)));
typedef float f32x4 __attribute__((ext_vector_type(4)));
typedef unsigned u32x4 __attribute__((ext_vector_type(4)));
typedef unsigned u32x2 __attribute__((ext_vector_type(2)));

__device__ __forceinline__ float qsum4(float v) {
    unsigned u = __builtin_bit_cast(unsigned, v);
    auto r = __builtin_amdgcn_permlane16_swap(u, u, false, false);
    v = __builtin_bit_cast(float, (unsigned)r[0]) + __builtin_bit_cast(float, (unsigned)r[1]);
    u = __builtin_bit_cast(unsigned, v);
    auto r2 = __builtin_amdgcn_permlane32_swap(u, u, false, false);
    return __builtin_bit_cast(float, (unsigned)r2[0]) + __builtin_bit_cast(float, (unsigned)r2[1]);
}
namespace pg8 {
#define PG8_LAS __attribute__((address_space(3)))
typedef unsigned short bf16_t;
constexpr int BM = 256, BK = 64, HALF = 128, HTB = HALF * BK * 2, STAGE_BYTES = 8 * HTB, NXCD = 8, WGM = 8;

__host__ __device__ __forceinline__ int lds_byte(int r, int c) { const int st = (r >> 4) * 2 + (c >> 5), rr = r & 15, cc = c & 31, ob = rr * 64 + cc * 2; return st * 1024 + (ob ^ (((ob >> 9) & 1) << 5)); }
__host__ __device__ __forceinline__ void stage_rc(int b, int& R, int& C) { const int st = b / 1024, sb = b % 1024, swz = sb ^ (((sb >> 9) & 1) << 5); R = (st >> 1) * 16 + swz / 64; C = (st & 1) * 32 + (swz % 64) / 2; }
__host__ __device__ __forceinline__ int perm32(int rho) { const int n = rho >> 4, i = rho & 15; return 8 * (i >> 2) + 4 * n + (i & 3); }

struct Unit { int pm, pn; };
struct Gemm { const bf16_t* A; const bf16_t* Bt; int M, N, K; };

struct StaticOrder {
    int nM, nN, nwg, G, c, one_pm, one_pn;
    int grp_w, grp_r, grp_pm0, grp_units;
    int late_pn;
    unsigned* arrive; int arrive_pn, arrive_rel;
    __host__ __device__ void init(int M, int N, int G_, int c_) { nM = M / BM; nN = N / BM; nwg = nM * nN; G = G_; c = c_; one_pm = -1; one_pn = 0; grp_w = 0; grp_r = 0; grp_pm0 = 0; grp_units = 0;
        late_pn = -1; arrive = nullptr; arrive_pn = -1; arrive_rel = 0; }
    __host__ __device__ bool next(int i, Unit& u) const {
        if (one_pm >= 0) { if (i != 0) return false; u.pm = one_pm; u.pn = one_pn; return true; }
        if (grp_w > 0) { const int j = i * grp_w + grp_r;
            if (j >= grp_units) { if (late_pn >= 0 && j < grp_units + grp_w) { u.pm = grp_pm0 + (grp_r & 3); u.pn = late_pn; return true; } return false; }
            u.pm = grp_pm0 + (j & 3); u.pn = j >> 2; return true; }
        const long L = (long)i * G + c; if (L >= nwg) return false;
        int wgid = (int)L; { const int q = nwg / NXCD, r = nwg % NXCD, xcd = wgid % NXCD, off = wgid / NXCD; wgid = (xcd < r ? xcd * (q + 1) : r * (q + 1) + (xcd - r) * q) + off; }
        const int nig = WGM * nN, gid = wgid / nig, fm = gid * WGM, gsz = (nM - fm) < WGM ? (nM - fm) : WGM;
        u.pm = fm + ((wgid % nig) % gsz); u.pn = (wgid % nig) / gsz; return true;
    }
    __device__ __forceinline__ void a_ready(const Unit&) const {}
    __device__ __forceinline__ void done(const Unit& u) const {
        if (arrive != nullptr && u.pn == arrive_pn) {
            asm volatile("s_waitcnt vmcnt(0)" ::: "memory");
            if (arrive_rel) { __builtin_amdgcn_fence(__ATOMIC_RELEASE, "agent"); asm volatile("s_waitcnt vmcnt(0)" ::: "memory"); }
            if ((threadIdx.x & 63) == 0) (void)__hip_atomic_fetch_add(arrive, 1u, __ATOMIC_RELAXED, __HIP_MEMORY_SCOPE_AGENT);
        }
    }
};

__device__ __forceinline__ unsigned cvt_pk_bf16(float lo, float hi) { unsigned r; asm volatile("v_cvt_pk_bf16_f32 %0, %1, %2" : "=v"(r) : "v"(lo), "v"(hi)); return r; }

struct EpiBf16 {
    static constexpr bool PERM = true, AFTER_DRAIN = false;
    bf16_t* O; int ldc; const float* sumsq; const float* sw;
    __device__ __forceinline__ void operator()(const f32x4 (&acc)[2][2][4][2], const Unit& u, int wr, int wc, int fr, int fq) const {
        const int row0 = u.pm * BM + wr * 64 + fr; const int col0 = u.pn * BM + wc * 32 + 8 * fq;
        const int mr = (u.pm < 32) ? 0 : 1 + ((u.pm - 32) >> 2);
        const float* swr = sw + (size_t)mr * ldc + col0;
        f32x4 s0[2], s1[2];
#pragma unroll
        for (int bj = 0; bj < 2; ++bj) { s0[bj] = *(const f32x4*)(swr + bj * HALF); s1[bj] = *(const f32x4*)(swr + bj * HALF + 4); }
        float rsv[2][4];
#pragma unroll
        for (int ai = 0; ai < 2; ++ai)
#pragma unroll
            for (int m = 0; m < 4; ++m) rsv[ai][m] = sumsq[row0 + ai * HALF + m * 16];
#pragma unroll
        for (int ai = 0; ai < 2; ++ai)
#pragma unroll
            for (int m = 0; m < 4; ++m) { const int row = row0 + ai * HALF + m * 16; bf16_t* rowp = O + (size_t)row * ldc + col0;
                const float rs = __builtin_amdgcn_rsqf(rsv[ai][m] * (1.f / 1024.f) + 1e-6f);
#pragma unroll
                for (int bj = 0; bj < 2; ++bj) { const f32x4 v0 = acc[ai][bj][m][0] * rs + s0[bj], v1 = acc[ai][bj][m][1] * rs + s1[bj];
                    u32x4 w; w.x = cvt_pk_bf16(v0[0], v0[1]); w.y = cvt_pk_bf16(v0[2], v0[3]); w.z = cvt_pk_bf16(v1[0], v1[1]); w.w = cvt_pk_bf16(v1[2], v1[3]);
                    *(u32x4*)(rowp + bj * HALF) = w; } }
    }
};
struct EpiResid {
    static constexpr bool PERM = true, AFTER_DRAIN = false;
    const float* xin0; const float* xin1;
    const bf16_t* xinb;
    float* xout; bf16_t* xoutb;
    const float* gate;
    const float* gn; const float* scn; bf16_t* An; float* ssn;
    __device__ __forceinline__ void operator()(const f32x4 (&acc)[2][2][4][2], const Unit& u, int wr, int wc, int fr, int fq) const {
        const int row0 = u.pm * BM + wr * 64 + fr, col0 = u.pn * BM + wc * 32 + 8 * fq;
        const int mr = (u.pm < 32) ? 0 : 1 + ((u.pm - 32) >> 2);
        const float* gr = gate + (size_t)mr * 3072 + col0;
        f32x4 gv[2][2], gs[2][2];
#pragma unroll
        for (int bj = 0; bj < 2; ++bj)
#pragma unroll
            for (int n = 0; n < 2; ++n) { gv[bj][n] = *(const f32x4*)(gr + bj * HALF + n * 4);
                if (gn) { const f32x4 g4 = *(const f32x4*)(gn + col0 + bj * HALF + n * 4), s4 = *(const f32x4*)(scn + (size_t)mr * 3072 + col0 + bj * HALF + n * 4); gs[bj][n] = g4 * (s4 + 1.0f); }
                else gs[bj][n] = (f32x4){0.f, 0.f, 0.f, 0.f}; }
#pragma unroll
        for (int ai = 0; ai < 2; ++ai)
#pragma unroll
            for (int m = 0; m < 4; ++m) { const int row = row0 + ai * HALF + m * 16;
                float ss = 0.f;
#pragma unroll
                for (int bj = 0; bj < 2; ++bj) {
                    f32x4 x0, x1;
                    if (xinb) { const u32x4 xb = *(const u32x4*)(xinb + (size_t)row * 1024 + col0 + bj * HALF);
                        x0 = (f32x4){__builtin_bit_cast(float, xb.x << 16), __builtin_bit_cast(float, xb.x & 0xffff0000u), __builtin_bit_cast(float, xb.y << 16), __builtin_bit_cast(float, xb.y & 0xffff0000u)};
                        x1 = (f32x4){__builtin_bit_cast(float, xb.z << 16), __builtin_bit_cast(float, xb.z & 0xffff0000u), __builtin_bit_cast(float, xb.w << 16), __builtin_bit_cast(float, xb.w & 0xffff0000u)}; }
                    else { const float* xr = (row < 8192 ? xin0 + (size_t)row * 1024 : xin1 + (size_t)(row - 8192) * 1024) + col0 + bj * HALF; x0 = __builtin_nontemporal_load((const f32x4*)xr); x1 = __builtin_nontemporal_load((const f32x4*)(xr + 4)); }
                    const f32x4 n0 = x0 + gv[bj][0] * acc[ai][bj][m][0], n1 = x1 + gv[bj][1] * acc[ai][bj][m][1];
                    if (xoutb) { u32x4 w; w.x = cvt_pk_bf16(n0[0], n0[1]); w.y = cvt_pk_bf16(n0[2], n0[3]); w.z = cvt_pk_bf16(n1[0], n1[1]); w.w = cvt_pk_bf16(n1[2], n1[3]);
                        *(u32x4*)(xoutb + (size_t)row * 1024 + col0 + bj * HALF) = w; }
                    else { float* orow = xout + (size_t)row * 1024 + col0 + bj * HALF; *(f32x4*)orow = n0; *(f32x4*)(orow + 4) = n1; }
                    ss += ((n0[0] * n0[0] + n0[1] * n0[1]) + (n0[2] * n0[2] + n0[3] * n0[3])) + ((n1[0] * n1[0] + n1[1] * n1[1]) + (n1[2] * n1[2] + n1[3] * n1[3]));
                    if (gn) { const f32x4 a0 = n0 * gs[bj][0], a1 = n1 * gs[bj][1];
                        u32x4 w; w.x = cvt_pk_bf16(a0[0], a0[1]); w.y = cvt_pk_bf16(a0[2], a0[3]); w.z = cvt_pk_bf16(a1[0], a1[1]); w.w = cvt_pk_bf16(a1[2], a1[3]);
                        *(u32x4*)(An + (size_t)row * 1024 + col0 + bj * HALF) = w; } }
                ss = qsum4(ss);
                if (fq == 0) atomicAdd(ssn + row, ss); }
    }
};

template <class Epi, class Sched, bool ALIGN_EPI = false, bool SP2 = false>
__device__ __forceinline__ void gemm_phase(PG8_LAS unsigned char* lds, const Gemm g, const Sched& S, const Epi& E) {
    int tid_ = threadIdx.x; asm volatile("" : "+v"(tid_));
    const int tid = tid_, wid = __builtin_amdgcn_readfirstlane(tid >> 6), lane = tid & 63, wr = wid >> 2, wc = wid & 3, fr = lane & 15, fq = lane >> 4;
    const int K = g.K, nt = K / BK;
    unsigned voffA[2], voffB[2];
#pragma unroll
    for (int i = 0; i < 2; ++i) { int R, C; stage_rc(tid * 16 + i * 8192, R, C); const int Rb = Epi::PERM ? ((R & ~31) + perm32(R & 31)) : R;
        voffA[i] = (unsigned)(R * K + C) * 2u; voffB[i] = (unsigned)(Rb * K + C) * 2u; }
    const size_t kstep = (size_t)(BK * 2);
    const size_t hstep = (size_t)HALF * K * 2;
    const size_t tstep = 2 * hstep;
    const unsigned ldsw = (unsigned)wid * 1024u;
    const int aoff = lds_byte(wr * 64 + fr, fq * 8), boff = lds_byte(wc * 32 + fr, fq * 8);
#define PG8_SA(b, h) (((b) * 2 + (h)) * HTB)
#define PG8_SB(b, h) ((4 + (b) * 2 + (h)) * HTB)
#define PG8_STAGE(bufoff, gbase, voff) do { _Pragma("unroll") for (int _i = 0; _i < 2; ++_i) \
        __builtin_amdgcn_global_load_lds((const unsigned*)((const char*)(gbase) + (voff)[_i]), (PG8_LAS unsigned*)(lds + (bufoff) + ldsw + _i * 8192), 16, 0, 0); } while (0)
#define PG8_LDA(dst, b, h) do { _Pragma("unroll") for (int m = 0; m < 4; ++m) _Pragma("unroll") for (int k = 0; k < 2; ++k) dst[m][k] = *(const PG8_LAS bf16x8*)(lds + PG8_SA(b, h) + aoff + m * 2048 + k * 1024); } while (0)
#define PG8_LDB(dst, b, h) do { _Pragma("unroll") for (int n = 0; n < 2; ++n) _Pragma("unroll") for (int k = 0; k < 2; ++k) dst[n][k] = *(const PG8_LAS bf16x8*)(lds + PG8_SB(b, h) + boff + n * 2048 + k * 1024); } while (0)
#define PG8_MMA(ai, bj, At, Bt) do { __builtin_amdgcn_s_setprio(1); _Pragma("unroll") for (int m = 0; m < 4; ++m) _Pragma("unroll") for (int n = 0; n < 2; ++n) _Pragma("unroll") for (int k = 0; k < 2; ++k) \
        acc[ai][bj][m][n] = __builtin_amdgcn_mfma_f32_16x16x32_bf16(Bt[n][k], At[m][k], acc[ai][bj][m][n], 0, 0, 0); __builtin_amdgcn_s_setprio(0); } while (0)
#define PG8_WAIT_V(n) asm volatile("s_waitcnt vmcnt(" #n ")" ::: "memory")
#define PG8_WAIT_L(n) asm volatile("s_waitcnt lgkmcnt(" #n ")" ::: "memory")
#define PG8_BAR __builtin_amdgcn_s_barrier()
#define PG8_SCHED __builtin_amdgcn_sched_barrier(0)
    Unit cur, nxt; int ui = 0;
    if (!S.next(0, cur)) return;
    f32x4 acc[2][2][4][2];
#pragma unroll
    for (int a = 0; a < 2; ++a)
#pragma unroll
        for (int b = 0; b < 2; ++b)
#pragma unroll
            for (int m = 0; m < 4; ++m)
#pragma unroll
                for (int n = 0; n < 2; ++n) acc[a][b][m][n] = (f32x4){0.f, 0.f, 0.f, 0.f};
    bf16x8 At[4][2], B0[2][2], B1[2][2];
    const char* cA = (const char*)g.A + (size_t)cur.pm * tstep; const char* cB = (const char*)g.Bt + (size_t)cur.pn * tstep;
    S.a_ready(cur);
    if constexpr (SP2) {
        PG8_STAGE(PG8_SB(0, 0), cB, voffB); PG8_STAGE(PG8_SB(0, 1), cB + hstep, voffB); PG8_STAGE(PG8_SA(0, 0), cA, voffA); PG8_STAGE(PG8_SA(0, 1), cA + hstep, voffA);
        if (wr == 1) PG8_BAR;
        PG8_WAIT_V(2); PG8_BAR;
        PG8_STAGE(PG8_SB(1, 0), cB + kstep, voffB); PG8_STAGE(PG8_SA(1, 0), cA + kstep, voffA); PG8_STAGE(PG8_SB(1, 1), cB + hstep + kstep, voffB);
        PG8_WAIT_V(6); PG8_BAR;
    } else {
        PG8_STAGE(PG8_SB(0, 0), cB, voffB); PG8_STAGE(PG8_SA(0, 0), cA, voffA); PG8_STAGE(PG8_SB(0, 1), cB + hstep, voffB); PG8_STAGE(PG8_SA(0, 1), cA + hstep, voffA);
        if (wr == 1) PG8_BAR;
        PG8_WAIT_V(4); PG8_BAR;
        PG8_STAGE(PG8_SB(1, 0), cB + kstep, voffB); PG8_STAGE(PG8_SA(1, 0), cA + kstep, voffA); PG8_STAGE(PG8_SB(1, 1), cB + hstep + kstep, voffB);
        PG8_WAIT_V(6); PG8_BAR;
    }
    for (;;) {
        const bool has_next = S.next(ui + 1, nxt);
        const char* nA = has_next ? (const char*)g.A + (size_t)nxt.pm * tstep : cA; const char* nB = has_next ? (const char*)g.Bt + (size_t)nxt.pn * tstep : cB;
        for (int t = 0; t < nt; t += 2) {
            const bool last = (t == nt - 2);
            const char* a1 = cA + (size_t)(t + 1) * kstep;
            const char* a2 = last ? nA : cA + (size_t)(t + 2) * kstep; const char* b2 = last ? nB : cB + (size_t)(t + 2) * kstep;
            const char* a3 = a2 + kstep; const char* b3 = b2 + kstep;
            if (last && has_next) S.a_ready(nxt);
            if constexpr (SP2) {
            PG8_LDB(B0, 0, 0); PG8_LDB(B1, 0, 1); PG8_SCHED; PG8_LDA(At, 0, 0); PG8_STAGE(PG8_SA(1, 1), a1 + hstep, voffA);
            PG8_WAIT_V(8); PG8_WAIT_L(0); PG8_BAR; PG8_MMA(0, 0, At, B0); PG8_MMA(0, 1, At, B1); PG8_BAR; PG8_SCHED;
            PG8_LDA(At, 0, 1); PG8_STAGE(PG8_SB(0, 0), b2, voffB); PG8_STAGE(PG8_SB(0, 1), b2 + hstep, voffB); PG8_STAGE(PG8_SA(0, 0), a2, voffA);
            PG8_WAIT_V(8); PG8_WAIT_L(0); PG8_BAR; PG8_MMA(1, 0, At, B0); PG8_MMA(1, 1, At, B1); PG8_BAR; PG8_SCHED;
            PG8_LDB(B0, 1, 0); PG8_LDB(B1, 1, 1); PG8_SCHED; PG8_LDA(At, 1, 0); PG8_STAGE(PG8_SA(0, 1), a2 + hstep, voffA);
            PG8_WAIT_V(8); PG8_WAIT_L(0); PG8_BAR; PG8_MMA(0, 0, At, B0); PG8_MMA(0, 1, At, B1); PG8_BAR; PG8_SCHED;
            PG8_LDA(At, 1, 1); PG8_STAGE(PG8_SB(1, 0), b3, voffB); PG8_STAGE(PG8_SB(1, 1), b3 + hstep, voffB); PG8_STAGE(PG8_SA(1, 0), a3, voffA);
            PG8_WAIT_V(8); PG8_WAIT_L(0); PG8_BAR; PG8_MMA(1, 0, At, B0); PG8_MMA(1, 1, At, B1); PG8_BAR; PG8_SCHED;
            } else {
            PG8_LDB(B0, 0, 0); PG8_SCHED; PG8_LDA(At, 0, 0); PG8_STAGE(PG8_SA(1, 1), a1 + hstep, voffA);
            PG8_WAIT_L(8); PG8_BAR; PG8_WAIT_L(0); PG8_MMA(0, 0, At, B0); PG8_BAR; PG8_SCHED;
            PG8_LDB(B1, 0, 1); PG8_STAGE(PG8_SB(0, 0), b2, voffB);
            PG8_BAR; PG8_WAIT_L(0); PG8_MMA(0, 1, At, B1); PG8_BAR;
            PG8_LDA(At, 0, 1); PG8_STAGE(PG8_SA(0, 0), a2, voffA);
            PG8_BAR; PG8_WAIT_L(0); PG8_MMA(1, 0, At, B0); PG8_BAR; PG8_SCHED;
            PG8_STAGE(PG8_SB(0, 1), b2 + hstep, voffB);
            PG8_WAIT_V(6); PG8_BAR; PG8_MMA(1, 1, At, B1); PG8_BAR;
            PG8_LDB(B0, 1, 0); PG8_SCHED; PG8_LDA(At, 1, 0); PG8_STAGE(PG8_SA(0, 1), a2 + hstep, voffA);
            PG8_WAIT_L(8); PG8_BAR; PG8_WAIT_L(0); PG8_MMA(0, 0, At, B0); PG8_BAR; PG8_SCHED;
            PG8_LDB(B1, 1, 1); PG8_STAGE(PG8_SB(1, 0), b3, voffB);
            PG8_BAR; PG8_WAIT_L(0); PG8_MMA(0, 1, At, B1); PG8_BAR;
            PG8_LDA(At, 1, 1); PG8_STAGE(PG8_SA(1, 0), a3, voffA);
            PG8_BAR; PG8_WAIT_L(0); PG8_MMA(1, 0, At, B0); PG8_BAR; PG8_SCHED;
            PG8_STAGE(PG8_SB(1, 1), b3 + hstep, voffB);
            PG8_WAIT_V(6); PG8_BAR; PG8_MMA(1, 1, At, B1); PG8_BAR;
            }
        }
        if constexpr (ALIGN_EPI) { if (wr == 0) PG8_BAR; }
        if constexpr (!Epi::AFTER_DRAIN) { E(acc, cur, wr, wc, fr, fq); S.done(cur); }
        if (!has_next) break;
#pragma unroll
        for (int a = 0; a < 2; ++a)
#pragma unroll
            for (int b = 0; b < 2; ++b)
#pragma unroll
                for (int m = 0; m < 4; ++m)
#pragma unroll
                    for (int n = 0; n < 2; ++n) acc[a][b][m][n] = (f32x4){0.f, 0.f, 0.f, 0.f};
        cur = nxt; cA = nA; cB = nB; ++ui;
        if constexpr (ALIGN_EPI) { if (wr == 1) PG8_BAR; }
    }
    PG8_WAIT_V(0);
    if constexpr (!ALIGN_EPI) { if (wr == 0) PG8_BAR; }
    PG8_BAR;
#undef PG8_SA
#undef PG8_SB
#undef PG8_STAGE
#undef PG8_LDA
#undef PG8_LDB
#undef PG8_MMA
#undef PG8_WAIT_V
#undef PG8_WAIT_L
#undef PG8_BAR
#undef PG8_SCHED
}
}


#define XB_TMO      128
#define XB_XCNT(j)  (256  + 64 * (j))
#define XB_XSUB(j)  (1280 + 64 * (j))
#define XB_XGEN(j)  (2304 + 64 * (j))
#define XB_TOP      3328
#define XB_TOPGEN   3392
#define XCD_BAR_WORDS 3456
#define XB_SPIN_CAP (1u << 18)
__device__ __forceinline__ unsigned xb_ld(unsigned* p)              { return __hip_atomic_load(p, __ATOMIC_RELAXED, __HIP_MEMORY_SCOPE_AGENT); }
__device__ __forceinline__ unsigned xb_add(unsigned* p, unsigned v) { return __hip_atomic_fetch_add(p, v, __ATOMIC_RELAXED, __HIP_MEMORY_SCOPE_AGENT); }
__device__ __forceinline__ unsigned xb_xcc_id() { return (unsigned)__builtin_amdgcn_s_getreg((3 << 11) | 20) & 0xFu; }
#define XB_SPIN(cond, bar) do { unsigned _sp = 0; while (cond) { __builtin_amdgcn_s_sleep(1); \
    if ((++_sp & 255u) == 0u) { if (xb_ld(&(bar)[XB_TMO])) break; if (_sp > XB_SPIN_CAP) { atomicAdd(&(bar)[XB_TMO], 1u); break; } } } } while (0)
struct XcdBarrier { unsigned* bar; unsigned x; volatile LAS unsigned* st; };
__device__ __forceinline__ XcdBarrier xcd_barrier_post(unsigned* bar, volatile LAS unsigned* st) {
    XcdBarrier b; b.bar = bar; b.x = xb_xcc_id(); b.st = st;
    if (threadIdx.x == 0) st[2] = xb_add(&bar[XB_XCNT(b.x)], 1u);
    return b;
}
__device__ __forceinline__ void xcd_barrier_complete(unsigned* bar, unsigned x, unsigned& nloc, unsigned& nx) {
    const unsigned G = gridDim.x * gridDim.y * gridDim.z;
    unsigned sum, cnt, mine, sp = 0u;
    for (;;) {
        sum = 0u; cnt = 0u; mine = 0u;
#pragma unroll
        for (unsigned j = 0; j < 16; ++j) { const unsigned c = xb_ld(&bar[XB_XCNT(j)]); sum += c; cnt += (c > 0u) ? 1u : 0u; mine = (j == x) ? c : mine; }
        if (sum == G) break;
        __builtin_amdgcn_s_sleep(1);
        if ((++sp & 255u) == 0u) { if (xb_ld(&bar[XB_TMO])) break; if (sp > XB_SPIN_CAP) { atomicAdd(&bar[XB_TMO], 1u); break; } }
    }
    nloc = mine > 0u ? mine : 1u; nx = cnt > 0u ? cnt : 1u;
}
__device__ __forceinline__ void xcd_barrier(const XcdBarrier& b) {
    asm volatile("s_waitcnt vmcnt(0)" ::: "memory");
    __syncthreads();
    if (threadIdx.x == 0) {
        unsigned* bar = b.bar;
        __builtin_amdgcn_s_waitcnt(0);
        unsigned nloc = b.st[0], nx = b.st[1];
        if (nloc == 0u) { xcd_barrier_complete(bar, b.x, nloc, nx); b.st[0] = nloc; b.st[1] = nx; }
        const unsigned old = xb_add(&bar[XB_XSUB(b.x)], 1u);
        const unsigned gen = old / nloc;
        if (old + 1u == (gen + 1u) * nloc) {
            __builtin_amdgcn_fence(__ATOMIC_RELEASE, "agent");
            asm volatile("s_waitcnt vmcnt(0)" ::: "memory");
            const unsigned og = xb_add(&bar[XB_TOP], 1u);
            const unsigned tg = og / nx;
            if (og + 1u == (tg + 1u) * nx) xb_add(&bar[XB_TOPGEN], 1u);
            else XB_SPIN(xb_ld(&bar[XB_TOPGEN]) == tg, bar);
            __builtin_amdgcn_fence(__ATOMIC_ACQUIRE, "agent");
            xb_add(&bar[XB_XGEN(b.x)], 1u);
            asm volatile("s_waitcnt vmcnt(0)" ::: "memory");
        } else {
            XB_SPIN(xb_ld(&bar[XB_XGEN(b.x)]) == gen, bar);
            __builtin_amdgcn_fence(__ATOMIC_ACQUIRE, "agent");
            asm volatile("s_waitcnt vmcnt(0)" ::: "memory");
        }
    }
    __syncthreads();
}

constexpr int DM = 1024, DEPTH = 4, NTOK = 16384, NCTX = 8192;
constexpr int DIN = 4400, DINP = 4608;
constexpr int NSEQ = 40;
constexpr int C_AQ = 0, C_AK = 512, C_AV = 1024, C_AO = 1536, C_BQ = 2048, C_BK = 2304, C_BV = 2560, C_BZ = 2816,
              C_CQ = 3072, C_CK = 3200, C_CV = 3328, C_CZ = 3584, C_CLR = 3840, C_AG = 3872, C_PAD = 3888, C_AZ = 4096;
constexpr int DIN_EARLY = 4096;
__host__ __device__ __forceinline__ int src_col(int n) { return n < 2048 ? n : (n < C_AG ? n + 528 : (n < C_PAD ? n - 1312 : (n < C_AZ ? -1 : n - 2048))); }
constexpr float EPS = 1e-6f;
constexpr size_t O_Y = 0, O_C = 16777216, O_N = O_C + 16777216, O_M = O_N + 131072, O_R = O_M + 1024, O_G = O_R + 4194304, O_END = O_G + 2097152;
constexpr size_t MiB = 1u << 20;
constexpr size_t WS_CTL = 0, CTL_ZERO_BYTES = 512 * 1024;
constexpr size_t WS_MOD = 1 * MiB;
constexpr size_t WS_WIN = 2 * MiB;
constexpr size_t WS_WOUT = 38 * MiB;
constexpr size_t WS_R1 = 46 * MiB;
constexpr size_t WS_PROJ = 78 * MiB;
constexpr size_t WS_AST = 222 * MiB;
constexpr size_t WS_ANM = 286 * MiB;
constexpr size_t WS_BST = 288 * MiB;
constexpr size_t WS_CST = 304 * MiB;
constexpr size_t WS_AG = 320 * MiB;
constexpr size_t WS_CB = 322 * MiB;
constexpr size_t WS_R3 = 338 * MiB;
constexpr size_t WS_SW = 370 * MiB;
constexpr size_t WS_XB = 372 * MiB;
constexpr size_t WS_END = 404 * MiB;
constexpr int CW_QUEUE = 64;
constexpr int CW_BAR = 4096;
constexpr int CW_GQ = 9216;
constexpr int CW_GB = 10240;
constexpr int CW_GA = 12288;
constexpr int CW_GTMO = 11264;

constexpr int LDS_BYTES = 147456;
constexpr int NPHASE = 2 + DEPTH * 4 + 1;
constexpr int CW_SUMSQ = 16384;

typedef float f32x2_ __attribute__((ext_vector_type(2)));
typedef __bf16 bf16v2_ __attribute__((ext_vector_type(2)));
__device__ __forceinline__ unsigned f2bf(float f) { return (unsigned)__builtin_bit_cast(unsigned short, (__bf16)f); }
__device__ __forceinline__ unsigned pk2(float lo, float hi) { const f32x2_ v = {lo, hi}; return __builtin_bit_cast(unsigned, __builtin_convertvector(v, bf16v2_)); }
__device__ __forceinline__ float bf2f(unsigned short b) { return __builtin_bit_cast(float, ((unsigned)b) << 16); }
__device__ __forceinline__ float bflo(unsigned u) { return __builtin_bit_cast(float, u << 16); }
__device__ __forceinline__ float bfhi(unsigned u) { return __builtin_bit_cast(float, u & 0xffff0000u); }
__device__ __forceinline__ float sigmoidf_(float x) { return __builtin_amdgcn_rcpf(1.0f + __expf(-x)); }
__device__ __forceinline__ float siluf_(float x) { return x * sigmoidf_(x); }
__device__ __forceinline__ float logsigmoidf_(float x) { return fminf(x, 0.f) - __logf(1.0f + __expf(-fabsf(x))); }
__device__ __forceinline__ float logsigmoid_acc(float x) { return fminf(x, 0.f) - log1pf(expf(-fabsf(x))); }
__device__ __forceinline__ float ex2(float x) { return __builtin_amdgcn_exp2f(x); }
__device__ __forceinline__ float wave_sum(float v) {
#pragma unroll
    for (int o = 1; o < 64; o <<= 1) v += __shfl_xor(v, o);
    return v;
}
__device__ __forceinline__ bf16x8 mk8(bf16x4 lo, bf16x4 hi) { return __builtin_shufflevector(lo, hi, 0, 1, 2, 3, 4, 5, 6, 7); }
__device__ __forceinline__ bf16x8 pack8(f32x4 a, f32x4 b) { u32x4 w; w.x = pk2(a[0], a[1]); w.y = pk2(a[2], a[3]); w.z = pk2(b[0], b[1]); w.w = pk2(b[2], b[3]); return __builtin_bit_cast(bf16x8, w); }
#define MFMA16(a, b, c) __builtin_amdgcn_mfma_f32_16x16x32_bf16((a), (b), (c), 0, 0, 0)
#define LDS_ISSUED() asm volatile("" ::: "memory")

struct Args { const float* in[20]; float* out; unsigned char* ws; int ph_lo, ph_hi; };

struct Ctx {
    LAS unsigned char* lds; int tid, lane, wave, G, bid;
    const float *x_prompt, *x_sample, *st_C, *st_n, *st_m, *st_ret, *st_gla, *cvec, *c_ctx, *norm_g, *w_ada, *b_ada, *w_in, *gate_b, *ret_logit, *gla_w2, *gla_b2, *hn_g, *w_out, *final_g;
    float* out; unsigned* ctl; float* mod; bf16 *WinT, *WoutT, *R1, *PROJ, *Ast, *Bst, *Cst; float *Anm, *AG, *CB, *SW, *ssq; bf16 *R3, *XB;
    int g_id, g_r, g_typ, g_pm0, g_s0, g_rel;
};

#define FRESH_TID(F) do { int t_ = threadIdx.x; asm volatile("" : "+v"(t_)); (F).tid = t_; (F).lane = t_ & 63; (F).wave = __builtin_amdgcn_readfirstlane(t_ >> 6); } while (0)
__device__ __forceinline__ void seq_info(int s, int& row0, int& L) { if (s < 32) { row0 = s * 256; L = 256; } else { row0 = NCTX + (s - 32) * 1024; L = 1024; } }

__device__ __forceinline__ float col_scale_in(int ns) {
    if (ns >= 512 && ns < 1024) return 0.08838834764831845f;
    if (ns >= 2832 && ns < 3088) return 0.125f;
    if (ns >= 3728 && ns < 3856) return 0.17677669529663687f;
    return 1.0f;
}
__device__ __forceinline__ void p0_transpose_item(const float* W, int ldn, int nvalid, bool scale_in, bf16* WT, LAS float* scr, int kb, int nb, int lane) {
    const int k0 = 64 * kb, n0 = 32 * nb;
    const int nd = n0 + (lane & 31); const int n = scale_in ? src_col(nd) : nd; const float sc = scale_in ? col_scale_in(n) : 1.0f;
    { float wv[32];
#pragma unroll
        for (int i = 0; i < 32; ++i) { const int kk = 2 * i + (lane >> 5); wv[i] = (n >= 0 && n < nvalid) ? __builtin_nontemporal_load(W + (size_t)(k0 + kk) * ldn + n) : 0.f; }
#pragma unroll
        for (int i = 0; i < 32; ++i) { const int kk = 2 * i + (lane >> 5); scr[kk * 33 + (lane & 31)] = wv[i] * sc; } }
    asm volatile("s_waitcnt lgkmcnt(0)" ::: "memory");
    const int c = lane & 7;
#pragma unroll
    for (int j = 0; j < 4; ++j) { const int nn = (lane >> 3) + 8 * j; const LAS float* s = scr + (8 * c) * 33 + nn;
        u32x4 o; o.x = pk2(s[0 * 33], s[1 * 33]); o.y = pk2(s[2 * 33], s[3 * 33]); o.z = pk2(s[4 * 33], s[5 * 33]); o.w = pk2(s[6 * 33], s[7 * 33]);
        *(u32x4*)(WT + (size_t)(n0 + nn) * 1024 + k0 + 8 * c) = o; }
    asm volatile("s_waitcnt lgkmcnt(0)" ::: "memory");
}
__device__ __forceinline__ void p0_prologue(Ctx& F) {
    FRESH_TID(F);
    LAS float* scr = (LAS float*)(F.lds + F.wave * 8448);
    const int gw = F.bid * 8 + F.wave, NGW = F.G * 8;
    constexpr int I_IN = 16 * (DINP / 32), I_OUT = 16 * 32, I_L = I_IN + I_OUT;
    for (int it = gw; it < DEPTH * I_L; it += NGW) {
        const int l = it / I_L; int r = it % I_L;
        if (r < I_IN) p0_transpose_item(F.w_in + (size_t)l * 1024 * DIN, DIN, DIN, true, F.WinT + (size_t)l * DINP * 1024, scr, r / (DINP / 32), r % (DINP / 32), F.lane);
        else { r -= I_IN; p0_transpose_item(F.w_out + (size_t)l * 1024 * 1024, 1024, 1024, false, F.WoutT + (size_t)l * 1024 * 1024, scr, r / 32, r % 32, F.lane); }
    }
    __syncthreads();
    LAS float* sl = (LAS float*)(F.lds + 69632);
    LAS float* red = (LAS float*)(F.lds + 106496);
    bool have_sl = false;
    for (int it = F.bid; it < DEPTH * 96; it += F.G) {
        if (!have_sl) {
            for (int i = F.tid; i < 9 * 1024; i += 512) { const int r = i >> 10, k = i & 1023; const float v = r == 0 ? F.c_ctx[k] : F.cvec[(r - 1) * 1024 + k]; sl[i] = siluf_(v); }
            have_sl = true; __syncthreads();
        }
        const int l = it / 96, e0 = (it % 96) * 32, c = F.tid & 31, kg = F.tid >> 5;
        const float* wp = F.w_ada + ((size_t)l * 1024 + kg * 64) * 3072 + e0 + c;
        float acc[9];
#pragma unroll
        for (int r = 0; r < 9; ++r) acc[r] = 0.f;
#pragma unroll 1
        for (int k0 = 0; k0 < 64; k0 += 16) {
            float wv[16];
#pragma unroll
            for (int k = 0; k < 16; ++k) wv[k] = __builtin_nontemporal_load(wp + (size_t)(k0 + k) * 3072);
#pragma unroll
            for (int k = 0; k < 16; ++k)
#pragma unroll
                for (int r = 0; r < 9; ++r) acc[r] += sl[r * 1024 + kg * 64 + k0 + k] * wv[k];
        }
#pragma unroll
        for (int r = 0; r < 9; ++r) red[(kg * 9 + r) * 32 + c] = acc[r];
        __syncthreads();
        for (int o = F.tid; o < 9 * 32; o += 512) { const int r = o >> 5, cc = o & 31; float sacc = F.b_ada[l * 3072 + e0 + cc];
#pragma unroll
            for (int g = 0; g < 16; ++g) sacc += red[(g * 9 + r) * 32 + cc];
            F.mod[((size_t)l * 9 + r) * 3072 + e0 + cc] = sacc; }
        __syncthreads();
    }
}

__device__ __forceinline__ void p0b_phase(Ctx& F) {
    FRESH_TID(F);
    const int gw = F.bid * 8 + F.wave, NGW = F.G * 8, lane = F.lane;
    for (int m0 = gw; m0 < NTOK; m0 += 4 * NGW) {
        f32x4 v[4][4];
#pragma unroll
        for (int rr = 0; rr < 4; ++rr) { const int m = m0 + rr * NGW;
            const float* xrow = m < NCTX ? F.x_prompt + (size_t)m * 1024 : F.x_sample + (size_t)(m - NCTX) * 1024;
            const f32x4* xr = (const f32x4*)xrow + lane;
#pragma unroll
            for (int j = 0; j < 4; ++j) v[rr][j] = (m < NTOK) ? __builtin_nontemporal_load(xr + 64 * j) : (f32x4){0.f, 0.f, 0.f, 0.f}; }
#pragma unroll
        for (int rr = 0; rr < 4; ++rr) { const int m = m0 + rr * NGW; if (m >= NTOK) break;
            const int mr = m < NCTX ? 0 : 1 + ((m - NCTX) >> 10);
            const float* md = F.mod + (size_t)mr * 3072;
            float sacc = 0.f;
#pragma unroll
            for (int j = 0; j < 4; ++j) sacc += (v[rr][j].x * v[rr][j].x + v[rr][j].y * v[rr][j].y) + (v[rr][j].z * v[rr][j].z + v[rr][j].w * v[rr][j].w);
            sacc = wave_sum(sacc);
            if (lane == 0) F.ssq[m] = sacc;
            unsigned long long* o8 = (unsigned long long*)(F.R3 + (size_t)m * 1024) + lane;
#pragma unroll
            for (int j = 0; j < 4; ++j) { const int c = 4 * lane + 256 * j;
                const f32x4 gg = *(const f32x4*)(F.norm_g + c), sc = *(const f32x4*)(md + 1024 + c);
                const f32x4 a = v[rr][j] * gg * (sc + 1.0f);
                o8[64 * j] = (unsigned long long)pk2(a.x, a.y) | ((unsigned long long)pk2(a.z, a.w) << 32); } }
    }
    const int c = lane & 15, q = lane >> 4;
    for (int t = NGW - 1 - gw; t < DEPTH * (DINP / 16); t += NGW) {
        const int l = t / (DINP / 16), n0 = (t % (DINP / 16)) * 16;
        const bf16* wrow = F.WinT + ((size_t)l * DINP + n0 + c) * 1024 + 8 * q;
        const float* sh = F.mod + ((size_t)l * 9 + (c < 9 ? c : 0)) * 3072 + 8 * q;
        f32x4 acc = (f32x4){0.f, 0.f, 0.f, 0.f};
#pragma unroll 16
        for (int k = 0; k < 32; ++k) {
            const bf16x8 b = *(const bf16x8*)(wrow + 32 * k);
            f32x4 a0 = *(const f32x4*)(sh + 32 * k), a1 = *(const f32x4*)(sh + 32 * k + 4);
            if (c >= 9) { a0 = (f32x4){0.f, 0.f, 0.f, 0.f}; a1 = a0; }
            acc = MFMA16(pack8(a0, a1), b, acc);
        }
#pragma unroll
        for (int r = 0; r < 4; ++r) F.SW[((size_t)l * 16 + 4 * q + r) * DINP + n0 + c] = acc[r];
    }
}
__device__ __forceinline__ void final_phase(Ctx& F) {
    const int gw = F.bid * 8 + F.wave, NGW = F.G * 8;
    for (int m = gw; m < NTOK; m += NGW) {
        f32x4* xr = (f32x4*)(F.out + (size_t)m * 1024) + F.lane;
        const float rstd = __builtin_amdgcn_rsqf(F.ssq[4 * NTOK + m] * (1.f / 1024.f) + EPS);
#pragma unroll
        for (int j = 0; j < 4; ++j) { const f32x4 gg = *(const f32x4*)(F.final_g + 4 * F.lane + 256 * j); xr[64 * j] = xr[64 * j] * rstd * gg; }
    }
}

__device__ __forceinline__ bf16x8 tr_frag(const LAS bf16* base, int RS, int row0, int col0, int c) {
    const LAS bf16* p = base + (row0 + (c >> 2)) * RS + col0 + 4 * (c & 3);
    const bf16x4 lo = __builtin_amdgcn_ds_read_tr16_b64_v4i16((LAS bf16x4*)p);
    const bf16x4 hi = __builtin_amdgcn_ds_read_tr16_b64_v4i16((LAS bf16x4*)(p + 4 * RS));
    return mk8(lo, hi);
}
__device__ __forceinline__ u32x4 scale8(u32x4 v, float g) { u32x4 o;
#pragma unroll
    for (int j = 0; j < 4; ++j) o[j] = pk2(bflo(v[j]) * g, bfhi(v[j]) * g);
    return o; }

constexpr int RSA = 136;
constexpr int A1_TAB = 69632;
__device__ __forceinline__ void mlstm_chain(Ctx& F, int l, int s, int h, int dir) {
    FRESH_TID(F);
    const int tid = F.tid, lane = F.lane, w = F.wave, c = lane & 15, q = lane >> 4;
    int row0, L; seq_info(s, row0, L);
    const int nch = L / 64, e0 = 16 * w, gc0 = row0 >> 6;
    const float bi = F.gate_b[l * 16 + dir * 8 + h], bfg = F.gate_b[l * 16 + dir * 8 + 4 + h];
    LAS float* gt = (LAS float*)(F.lds + A1_TAB);
    u32x4 kr0[2], vr0[2], kr1[2], vr1[2];
#define A1_LOAD(nn, KR, VR) do { \
        _Pragma("unroll") for (int i_ = 0; i_ < 2; ++i_) { const int p_ = tid + 512 * i_, r_ = p_ >> 4, cp_ = (p_ & 15) * 8; \
            const int pos_ = dir ? (L - 1 - (64 * (nn) + r_)) : (64 * (nn) + r_); \
            const bf16* src_ = F.PROJ + (size_t)(row0 + pos_) * DINP + h * 128 + cp_; \
            KR[i_] = *(const u32x4*)(src_ + C_AK); VR[i_] = *(const u32x4*)(src_ + C_AV); } } while (0)
    bf16 gi[2], gf[2];
#pragma unroll
    for (int i = 0; i < 2; ++i) { const int n = (w + 8 * i) & (nch - 1);
        const int posl = dir ? (L - 1 - (64 * n + lane)) : (64 * n + lane);
        const bf16* gp = F.PROJ + (size_t)(row0 + posl) * DINP + C_AG + dir * 8 + h; gi[i] = gp[0]; gf[i] = gp[4]; }
    A1_LOAD(0, kr0, vr0); A1_LOAD(1, kr1, vr1);
    f32x4 st[8], nst; float m_prev;
#define A1_SCANS() do { \
    _Pragma("unroll") for (int i = 0; i < 2; ++i) { const int n = w + 8 * i; \
        if (n < nch) { \
            const int posl = dir ? (L - 1 - (64 * n + lane)) : (64 * n + lane); \
            const float ic = bf2f(gi[i]) + bi, fp = bf2f(gf[i]) + bfg; \
            float Fc = logsigmoidf_(fp); \
            _Pragma("unroll") for (int o = 1; o < 64; o <<= 1) { const float t = __shfl_up(Fc, o); if (lane >= o) Fc += t; } \
            const float u = ic - Fc; \
            float pm = u; \
            _Pragma("unroll") for (int o = 1; o < 64; o <<= 1) { const float t = __shfl_up(pm, o); if (lane >= o) pm = fmaxf(pm, t); } \
            const float F_last = __shfl(Fc, 63), pmL = __shfl(pm, 63); \
            gt[n * 64 + lane] = F_last + u; \
            *(f32x4*)(F.AG + (((size_t)(row0 + posl) * 4 + h) * 2 + dir) * 4) = (f32x4){u, pm, Fc, 0.f}; \
            if (lane == 0) { gt[1024 + n] = F_last; gt[1040 + n] = F_last + pmL; } \
        } } } while (0)
    if (s >= 32) {
        const size_t sb = (((size_t)(s - 32) * DEPTH + l) * 2 + dir) * 4 + h;
        const float* C0 = F.st_C + sb * 16384;
#pragma unroll
        for (int t = 0; t < 8; ++t)
#pragma unroll
            for (int r = 0; r < 4; ++r) st[t][r] = C0[(size_t)(16 * t + 4 * q + r) * 128 + e0 + c];
#pragma unroll
        for (int r = 0; r < 4; ++r) nst[r] = F.st_n[sb * 128 + 16 * w + 4 * q + r];
        m_prev = F.st_m[sb];
        A1_SCANS();
    } else {
#pragma unroll
        for (int t = 0; t < 8; ++t) st[t] = (f32x4){0.f, 0.f, 0.f, 0.f};
        nst = (f32x4){0.f, 0.f, 0.f, 0.f}; m_prev = 0.f;
        A1_SCANS();
    }
#undef A1_SCANS
    const u32x4 ones_u = (u32x4){0x3f803f80u, 0x3f803f80u, 0x3f803f80u, 0x3f803f80u};
    const bf16x8 ones = __builtin_bit_cast(bf16x8, ones_u);
    __syncthreads();
#define A1_STEP(nn, KR, VR, BUF) do { \
        LAS bf16* Kg = (LAS bf16*)(F.lds + (BUF) * 34816); LAS bf16* Vs = Kg + 64 * RSA; \
        const float FLn = gt[1024 + (nn)], GMn = gt[1040 + (nn)]; \
        const float m_new = fmaxf(FLn + m_prev, GMn), a_dec = __expf(FLn + m_prev - m_new); \
        { const int m_ = dir ? nch - 1 - (nn) : (nn); const size_t slot = ((size_t)(gc0 + m_) * 4 + h) * 2 + dir; \
          u32x4* sp = (u32x4*)(F.Ast + slot * 16384) + (w * 4) * 64 + lane; \
          _Pragma("unroll") for (int k = 0; k < 4; ++k) sp[k * 64] = __builtin_bit_cast(u32x4, pack8(st[2 * k], st[2 * k + 1])); \
          if (c == 0) *(f32x4*)(F.Anm + slot * 132 + 16 * w + 4 * q) = nst; \
          if (tid == 0) F.Anm[slot * 132 + 128] = m_prev; } \
        _Pragma("unroll") for (int i = 0; i < 2; ++i) { const int p = tid + 512 * i, r = p >> 4, cp = (p & 15) * 8; \
            const float gr = __expf(gt[(nn) * 64 + r] - m_new); \
            *(LAS u32x4*)(Kg + r * RSA + cp) = scale8(KR[i], gr); *(LAS u32x4*)(Vs + r * RSA + cp) = VR[i]; } \
        if ((nn) + 2 < nch) A1_LOAD((nn) + 2, KR, VR); \
        __syncthreads(); \
        bf16x8 vb[2], nf[2]; \
        _Pragma("unroll") for (int k = 0; k < 2; ++k) { vb[k] = tr_frag(Vs, RSA, 32 * k + 8 * q, e0, c); nf[k] = tr_frag(Kg, RSA, 32 * k + 8 * q, 16 * w, c); } \
        _Pragma("unroll") for (int t0 = 0; t0 < 8; t0 += 4) { bf16x8 af[4][2]; \
            _Pragma("unroll") for (int t = 0; t < 4; ++t) _Pragma("unroll") for (int k = 0; k < 2; ++k) af[t][k] = tr_frag(Kg, RSA, 32 * k + 8 * q, 16 * (t0 + t), c); \
            LDS_ISSUED(); \
            _Pragma("unroll") for (int t = 0; t < 4; ++t) { st[t0 + t] = st[t0 + t] * a_dec; \
                _Pragma("unroll") for (int k = 0; k < 2; ++k) st[t0 + t] = MFMA16(af[t][k], vb[k], st[t0 + t]); } } \
        f32x4 nacc = (f32x4){0.f, 0.f, 0.f, 0.f}; \
        _Pragma("unroll") for (int k = 0; k < 2; ++k) nacc = MFMA16(nf[k], ones, nacc); \
        nst = nst * a_dec + nacc; m_prev = m_new; } while (0)
    for (int n = 0; n < nch; n += 2) { A1_STEP(n, kr0, vr0, 0); A1_STEP(n + 1, kr1, vr1, 1); }
#undef A1_STEP
#undef A1_LOAD
    if (s < 32) {
        const size_t sb = (((size_t)s * DEPTH + l) * 2 + dir) * 4 + h;
        float* Co = F.out + O_C + sb * 16384;
#pragma unroll
        for (int t = 0; t < 8; ++t)
#pragma unroll
            for (int r = 0; r < 4; ++r) __builtin_nontemporal_store(st[t][r], Co + (size_t)(16 * t + 4 * q + r) * 128 + e0 + c);
        if (c == 0) *(f32x4*)(F.out + O_N + sb * 128 + 16 * w + 4 * q) = nst;
        if (tid == 0) F.out[O_M + sb] = m_prev;
    }
    __syncthreads();
}

__device__ __forceinline__ void rot8(float (&a)[8], float (&b)[8], int pos, int cp) {
    const float prow = (float)(pos >> 6), pcol = (float)(pos & 63);
#pragma unroll
    for (int x = 0; x < 8; ++x) { const int f = cp + x;
        const float fr = ex2(-(float)(f & 15) * 0.8304820237218406f);
        const float ang = (f < 16 ? prow : pcol) * fr;
        const float cs = __cosf(ang), sn = __sinf(ang);
        const float t1 = a[x], t2 = b[x]; a[x] = t1 * cs - t2 * sn; b[x] = t1 * sn + t2 * cs; }
}
__device__ __forceinline__ void unpack8(u32x4 v, float (&o)[8]) {
#pragma unroll
    for (int j = 0; j < 4; ++j) { o[2 * j] = bflo(v[j]); o[2 * j + 1] = bfhi(v[j]); } }
__device__ __forceinline__ u32x4 packf8(const float (&a)[8], float g) { u32x4 o; o.x = pk2(a[0] * g, a[1] * g); o.y = pk2(a[2] * g, a[3] * g); o.z = pk2(a[4] * g, a[5] * g); o.w = pk2(a[6] * g, a[7] * g); return o; }

__device__ __forceinline__ void ret_chain(Ctx& F, int l, int s, int h) {
    FRESH_TID(F);
    const int tid = F.tid, lane = F.lane, dir = F.wave >> 2, wl = F.wave & 3, tl = tid & 255, c = lane & 15, q = lane >> 4;
    int row0, L; seq_info(s, row0, L);
    const int nch = L / 64, e0 = 16 * wl, gc0 = row0 >> 6;
    const float lg2 = logsigmoid_acc(F.ret_logit[(l * 2 + dir) * 4 + h]) * 1.4426950408889634f;
    const bool rot = s >= 32;
    f32x4 st[4];
    if (s >= 32) {
        const float* S0 = F.st_ret + ((((size_t)(s - 32) * DEPTH + l) * 2 + dir) * 4 + h) * 4096;
#pragma unroll
        for (int t = 0; t < 4; ++t)
#pragma unroll
            for (int r = 0; r < 4; ++r) st[t][r] = S0[(size_t)(16 * t + 4 * q + r) * 64 + e0 + c];
    } else {
#pragma unroll
        for (int t = 0; t < 4; ++t) st[t] = (f32x4){0.f, 0.f, 0.f, 0.f};
    }
    const float g64 = ex2(64.f * lg2);
    const int r = tl >> 2, cp = (tl & 3) * 8;
    const float gr = ex2((float)(63 - r) * lg2);
    u32x4 ka0, kb0, va0, vb0, ka1, kb1, va1, vb1;
#define B1_LOAD(nn, K1, K2, V1, V2) do { const int pos_ = dir ? (L - 1 - (64 * (nn) + r)) : (64 * (nn) + r); \
        const bf16* src_ = F.PROJ + (size_t)(row0 + pos_) * DINP + h * 64 + cp; \
        K1 = *(const u32x4*)(src_ + C_BK); K2 = *(const u32x4*)(src_ + C_BK + 32); V1 = *(const u32x4*)(src_ + C_BV); V2 = *(const u32x4*)(src_ + C_BV + 32); } while (0)
    B1_LOAD(0, ka0, kb0, va0, vb0); B1_LOAD(1, ka1, kb1, va1, vb1);
#define B1_STEP(nn, K1, K2, V1, V2, BUF) do { \
        LAS bf16* Kg = (LAS bf16*)(F.lds + (dir * 2 + (BUF)) * 18432); LAS bf16* Vs = Kg + 64 * 72; \
        { const int m_ = dir ? nch - 1 - (nn) : (nn); const size_t slot = ((size_t)(gc0 + m_) * 4 + h) * 2 + dir; \
          u32x4* sp = (u32x4*)(F.Bst + slot * 4096) + (wl * 2) * 64 + lane; \
          _Pragma("unroll") for (int k = 0; k < 2; ++k) sp[k * 64] = __builtin_bit_cast(u32x4, pack8(st[2 * k], st[2 * k + 1])); } \
        { float ka[8], kb[8]; unpack8(K1, ka); unpack8(K2, kb); \
          if (rot) { const int pos = dir ? (L - 1 - (64 * (nn) + r)) : (64 * (nn) + r); rot8(ka, kb, pos, cp); } \
          *(LAS u32x4*)(Kg + r * 72 + cp) = packf8(ka, gr); *(LAS u32x4*)(Kg + r * 72 + cp + 32) = packf8(kb, gr); \
          *(LAS u32x4*)(Vs + r * 72 + cp) = V1; *(LAS u32x4*)(Vs + r * 72 + cp + 32) = V2; } \
        if ((nn) + 2 < nch) B1_LOAD((nn) + 2, K1, K2, V1, V2); \
        __syncthreads(); \
        bf16x8 vb[2], af[4][2]; \
        _Pragma("unroll") for (int k = 0; k < 2; ++k) vb[k] = tr_frag(Vs, 72, 32 * k + 8 * q, e0, c); \
        _Pragma("unroll") for (int t = 0; t < 4; ++t) _Pragma("unroll") for (int k = 0; k < 2; ++k) af[t][k] = tr_frag(Kg, 72, 32 * k + 8 * q, 16 * t, c); \
        LDS_ISSUED(); \
        _Pragma("unroll") for (int t = 0; t < 4; ++t) { st[t] = st[t] * g64; \
            _Pragma("unroll") for (int k = 0; k < 2; ++k) st[t] = MFMA16(af[t][k], vb[k], st[t]); } } while (0)
    for (int n = 0; n < nch; n += 2) { B1_STEP(n, ka0, kb0, va0, vb0, 0); B1_STEP(n + 1, ka1, kb1, va1, vb1, 1); }
#undef B1_STEP
#undef B1_LOAD
    if (s < 32) {
        float* So = F.out + O_R + ((((size_t)s * DEPTH + l) * 2 + dir) * 4 + h) * 4096;
#pragma unroll
        for (int t = 0; t < 4; ++t)
#pragma unroll
            for (int rr = 0; rr < 4; ++rr) __builtin_nontemporal_store(st[t][rr], So + (size_t)(16 * t + 4 * q + rr) * 64 + e0 + c);
    }
}

__device__ __forceinline__ void gla_chain(Ctx& F, int l, int s, int h, int dir) {
    FRESH_TID(F);
    const int tid = F.tid, lane = F.lane, hw = F.wave >> 2, wl = F.wave & 3, c = lane & 15, q = lane >> 4;
    int row0, L; seq_info(s, row0, L);
    const int nch = L / 32, nss = nch / 4, e0 = 16 * wl, gc0 = row0 >> 5;
    const int dl = lane & 7, jg = lane >> 3, d = 8 * wl + dl;
    LAS bf16* CL = (LAS bf16*)(F.lds); LAS bf16* KR = CL + 2048; LAS bf16* Ku = CL + 7168; LAS bf16* Vs = CL + 12288; LAS float* dec = (LAS float*)(CL + 21504);
    float w2r[16];
#pragma unroll
    for (int r = 0; r < 16; ++r) w2r[r] = F.gla_w2[(((size_t)l * 2 + dir) * 16 + r) * 128 + h * 32 + d];
    const float b2v = F.gla_b2[((size_t)l * 2 + dir) * 128 + h * 32 + d];
    f32x4 st[2];
    if (s >= 32) {
        const float* S0 = F.st_gla + ((((size_t)(s - 32) * DEPTH + l) * 2 + dir) * 4 + h) * 2048;
#pragma unroll
        for (int t = 0; t < 2; ++t)
#pragma unroll
            for (int r = 0; r < 4; ++r) st[t][r] = S0[(size_t)(16 * t + 4 * q + r) * 64 + e0 + c];
    } else { st[0] = (f32x4){0.f, 0.f, 0.f, 0.f}; st[1] = st[0]; }
    u32x4 pc, pk, pv[2];
#define C1_LOAD(ss) do { \
        if (tid < 256) { const int j_ = tid >> 1; const int pos_ = dir ? (L - 1 - (128 * (ss) + j_)) : (128 * (ss) + j_); \
          pc = *(const u32x4*)(F.PROJ + (size_t)(row0 + pos_) * DINP + C_CLR + dir * 16 + (tid & 1) * 8); } \
        { const int j_ = tid >> 2; const int pos_ = dir ? (L - 1 - (128 * (ss) + j_)) : (128 * (ss) + j_); \
          pk = *(const u32x4*)(F.PROJ + (size_t)(row0 + pos_) * DINP + C_CK + h * 32 + (tid & 3) * 8); } \
        _Pragma("unroll") for (int i_ = 0; i_ < 2; ++i_) { const int p_ = tid + 512 * i_, j_ = p_ >> 3; const int pos_ = dir ? (L - 1 - (128 * (ss) + j_)) : (128 * (ss) + j_); \
          pv[i_] = *(const u32x4*)(F.PROJ + (size_t)(row0 + pos_) * DINP + C_CV + h * 64 + (p_ & 7) * 8); } } while (0)
    C1_LOAD(0);
    for (int ss = 0; ss < nss; ++ss) {
        if (tid < 256) *(LAS u32x4*)(CL + (tid >> 1) * 16 + (tid & 1) * 8) = pc;
        *(LAS u32x4*)(KR + (tid >> 2) * 40 + (tid & 3) * 8) = pk;
#pragma unroll
        for (int i = 0; i < 2; ++i) { const int p = tid + 512 * i; *(LAS u32x4*)(Vs + (p >> 3) * 72 + (p & 7) * 8) = pv[i]; }
        if (ss + 1 < nss) C1_LOAD(ss + 1);
        __syncthreads();
#pragma unroll
        for (int c2 = 0; c2 < 2; ++c2) {
            const int cc = 2 * hw + c2;
            float pb[4], kv[4], run = 0.f;
#pragma unroll
            for (int x = 0; x < 4; ++x) { const int j = 32 * cc + 4 * jg + x;
                const u32x4 c0 = *(const LAS u32x4*)(CL + j * 16), c1 = *(const LAS u32x4*)(CL + j * 16 + 8);
                float xx = b2v;
#pragma unroll
                for (int y = 0; y < 4; ++y) { xx += bflo(c0[y]) * w2r[2 * y] + bfhi(c0[y]) * w2r[2 * y + 1]; xx += bflo(c1[y]) * w2r[8 + 2 * y] + bfhi(c1[y]) * w2r[8 + 2 * y + 1]; }
                run += logsigmoidf_(xx) * 0.0625f; pb[x] = run; kv[x] = bf2f(KR[j * 40 + d]); }
            float tot = run;
#pragma unroll
            for (int o = 8; o < 64; o <<= 1) { const float t = __shfl_up(tot, o); if (lane >= o) tot += t; }
            const float off = tot - run, blast = __shfl(tot, 56 + dl);
#pragma unroll
            for (int x = 0; x < 4; ++x) { const int j = 32 * cc + 4 * jg + x; const float b = off + pb[x];
                Ku[j * 40 + d] = (bf16)f2bf(kv[x] * __expf(blast - b));
                const int pos = dir ? (L - 1 - (128 * ss + j)) : (128 * ss + j);
                F.CB[((size_t)(row0 + pos) * 2 + dir) * 128 + h * 32 + d] = b; }
            if (jg == 0) dec[cc * 32 + d] = __expf(blast);
        }
        __syncthreads();
        if (hw == 0) {
            bf16x8 vb[4], kf[4][2]; f32x4 dv[4][2];
#pragma unroll
            for (int cc = 0; cc < 4; ++cc) { vb[cc] = tr_frag(Vs, 72, 32 * cc + 8 * q, e0, c);
#pragma unroll
                for (int t = 0; t < 2; ++t) { kf[cc][t] = tr_frag(Ku, 40, 32 * cc + 8 * q, 16 * t, c); dv[cc][t] = *(const LAS f32x4*)(dec + cc * 32 + 16 * t + 4 * q); } }
            LDS_ISSUED();
#pragma unroll
            for (int cc = 0; cc < 4; ++cc) {
                const int n = 4 * ss + cc;
                { const int m = dir ? nch - 1 - n : n; const size_t slot = ((size_t)(gc0 + m) * 4 + h) * 2 + dir;
                  u32x4* sp = (u32x4*)(F.Cst + slot * 2048) + wl * 64 + lane; sp[0] = __builtin_bit_cast(u32x4, pack8(st[0], st[1])); }
#pragma unroll
                for (int t = 0; t < 2; ++t) st[t] = MFMA16(kf[cc][t], vb[cc], st[t] * dv[cc][t]);
            }
        }
        __syncthreads();
    }
#undef C1_LOAD
    if (s < 32 && hw == 0) {
        float* So = F.out + O_G + ((((size_t)s * DEPTH + l) * 2 + dir) * 4 + h) * 2048;
#pragma unroll
        for (int t = 0; t < 2; ++t)
#pragma unroll
            for (int r = 0; r < 4; ++r) __builtin_nontemporal_store(st[t][r], So + (size_t)(16 * t + 4 * q + r) * 64 + e0 + c);
    }
}

__device__ __forceinline__ void p1_unit(Ctx& F, int l, int uq) {
    int typ, s, h, dir = 0;
    if (F.g_typ) { s = F.g_s0;
        if (uq < 8) { typ = 0; h = uq >> 1; dir = uq & 1; }
        else if (uq < 16) { const int v = uq - 8; typ = 2; h = v >> 1; dir = v & 1; }
        else { typ = 1; h = uq - 16; } }
    else {
        if (uq < 32) { typ = 0; s = F.g_s0 + (uq >> 3); h = (uq >> 1) & 3; dir = uq & 1; }
        else if (uq < 48) { const int v = uq - 32; typ = 1; s = F.g_s0 + (v >> 2); h = v & 3; }
        else { const int v = uq - 48; typ = 2; s = F.g_s0 + (v >> 3); h = (v >> 1) & 3; dir = v & 1; } }
    if (typ == 0) mlstm_chain(F, l, s, h, dir); else if (typ == 1) ret_chain(F, l, s, h); else gla_chain(F, l, s, h, dir);
}
__device__ __forceinline__ int p1_static(int typ, int r, int idx) {
    if (typ) { if (r >= 8) return idx == 0 ? (r - 8) : (idx == 1 ? 8 + (r - 8) : -1);
               if (r < 4) return idx == 0 ? 16 + r : -1;
               return -1; }
    if (r >= 8) { const int j = r - 8; if (idx < 3) return 3 * j + idx; if (idx == 3) return 32 + j; return idx < 6 ? 48 + 2 * j + (idx - 4) : -1; }
    if (idx == 0) return 24 + r; if (idx == 1) return 40 + r; return idx < 4 ? 64 + 2 * r + (idx - 2) : -1;
}
__device__ __forceinline__ void mixer_pass1(Ctx& F, int l) {
    for (int idx = 0; idx < 6; ++idx) { const int uq = p1_static(F.g_typ, F.g_r, idx); if (uq < 0) break; p1_unit(F, l, uq); __syncthreads(); }
}

constexpr int T2_UF = 0, T2_MXF = 64, T2_UB = 128, T2_MXB = 192, T2_WAF = 256, T2_WAB = 320, T2_EMF = 384, T2_EMB = 448, T2_DPF = 512, T2_DPB = 768, T2_QNF = 1024, T2_QNB = 1088,
              T2_NVF = 1152, T2_NVB = 1280, T2_SSP = 1408;
struct A2R { f32x4 agf, agb; float mpf, mpb, nv; u32x2 og[4], zg[4]; };
struct A2F { u32x4 cff[4], cfb[4]; };
struct A2Q { u32x4 qv[2], kv[2], vv[2]; };
__device__ __forceinline__ void a2_decode(int u, int& s, int& h, int& m) { const int gc = u >> 2; h = u & 3; if (gc < 128) { s = gc >> 2; m = gc & 3; } else { s = 32 + ((gc - 128) >> 4); m = (gc - 128) & 15; } }
__device__ __forceinline__ void a2_loadA(Ctx& F, int l, int u, A2R& R) {
    const int tid = F.tid, lane = F.lane;
    int s, h, m; a2_decode(u, s, h, m);
    int row0, L; seq_info(s, row0, L);
    const int gc = (row0 >> 6) + m, rowb = row0 + 64 * m;
    const size_t slot_f = ((size_t)gc * 4 + h) * 2, slot_b = slot_f + 1;
    R.agf = *(const f32x4*)(F.AG + (((size_t)(rowb + lane) * 4 + h) * 2) * 4); R.agb = *(const f32x4*)(F.AG + (((size_t)(rowb + lane) * 4 + h) * 2 + 1) * 4);
    R.mpf = F.Anm[slot_f * 132 + 128]; R.mpb = F.Anm[slot_b * 132 + 128];
    R.nv = F.Anm[(tid < 128 ? slot_f : slot_b) * 132 + (tid & 127)];
    { const int c = lane & 15, q = lane >> 4, e0 = 16 * F.wave;
#pragma unroll
      for (int it = 0; it < 4; ++it) { const bf16* pp_ = F.PROJ + (size_t)(rowb + 16 * it + c) * DINP + h * 128 + e0 + 4 * q; R.og[it] = *(const u32x2*)(pp_ + C_AO); R.zg[it] = *(const u32x2*)(pp_ + C_AZ); } }
}
__device__ __forceinline__ void a2_loadF(Ctx& F, int u, A2F& R) {
    const int lane = F.lane, w = F.wave;
    int s, h, m; a2_decode(u, s, h, m);
    int row0, L; seq_info(s, row0, L);
    const int gc = (row0 >> 6) + m;
    const size_t slot_f = ((size_t)gc * 4 + h) * 2, slot_b = slot_f + 1;
    const u32x4* pf_ = (const u32x4*)(F.Ast + slot_f * 16384) + (w * 4) * 64 + lane; const u32x4* pb_ = (const u32x4*)(F.Ast + slot_b * 16384) + (w * 4) * 64 + lane;
#pragma unroll
    for (int k = 0; k < 4; ++k) { R.cff[k] = __builtin_nontemporal_load(pf_ + k * 64); R.cfb[k] = __builtin_nontemporal_load(pb_ + k * 64); }
}
__device__ __forceinline__ void a2_loadQ(Ctx& F, int u, A2Q& Q) {
    const int tid = F.tid;
    int s, h, m; a2_decode(u, s, h, m);
    int row0, L; seq_info(s, row0, L);
    const int rowb = row0 + 64 * m;
#pragma unroll
    for (int i = 0; i < 2; ++i) { const int p = tid + 512 * i, r = p >> 4, cp = (p & 15) * 8;
        const bf16* src = F.PROJ + (size_t)(rowb + r) * DINP + h * 128 + cp;
        Q.qv[i] = __builtin_nontemporal_load((const u32x4*)(src + C_AQ)); Q.kv[i] = __builtin_nontemporal_load((const u32x4*)(src + C_AK)); Q.vv[i] = __builtin_nontemporal_load((const u32x4*)(src + C_AV)); }
}
__device__ __forceinline__ void a2_compute(Ctx& F, int l, int u, A2R& R, A2Q& Q, A2F& FR, int u_next, A2R& Rn) {
    const int tid = F.tid, lane = F.lane, w = F.wave, c = lane & 15, q = lane >> 4;
    LAS bf16* Qs = (LAS bf16*)(F.lds); LAS bf16* Ks = (LAS bf16*)(F.lds + 17408); LAS bf16* Vs = (LAS bf16*)(F.lds + 34816);
    LAS bf16* Pf = (LAS bf16*)(F.lds + 52224); LAS bf16* Pb = (LAS bf16*)(F.lds + 61440); LAS float* tab = (LAS float*)(F.lds + 70656);
    int s, h, m; a2_decode(u, s, h, m);
    int row0, L; seq_info(s, row0, L);
    const int e0 = 16 * w, rowb = row0 + 64 * m;
    asm volatile("" :: "v"(R.agf), "v"(R.agb));
#pragma unroll
    for (int i = 0; i < 2; ++i) { const int p = tid + 512 * i, r = p >> 4, cp = (p & 15) * 8;
        *(LAS u32x4*)(Qs + r * RSA + cp) = Q.qv[i]; *(LAS u32x4*)(Ks + r * RSA + cp) = Q.kv[i]; *(LAS u32x4*)(Vs + r * RSA + cp) = Q.vv[i]; }
    if (u_next < 1024) { a2_loadQ(F, u_next, Q); a2_loadA(F, l, u_next, Rn); }
    u32x2 ogv[4], zgv[4];
#pragma unroll
    for (int it = 0; it < 4; ++it) { ogv[it] = R.og[it]; zgv[it] = R.zg[it]; }
    const f32x4 hg = *(const f32x4*)(F.hn_g + l * 1024 + h * 128 + e0 + 4 * q);
    if (tid < 256) tab[T2_NVF + tid] = R.nv;
    const float mpf = R.mpf, mpb = R.mpb;
    const float uf = R.agf[0], pmf = R.agf[1], Ff = R.agf[2], ub = R.agb[0], pmb = R.agb[1], Fb = R.agb[2];
    const float mxf = fmaxf(mpf, pmf), mxb = fmaxf(mpb, pmb);
    if (w == 0) { tab[T2_UF + lane] = uf; tab[T2_MXF + lane] = mxf; tab[T2_UB + lane] = ub; tab[T2_MXB + lane] = mxb;
        tab[T2_WAF + lane] = __expf(mpf - mxf); tab[T2_WAB + lane] = __expf(mpb - mxb); tab[T2_EMF + lane] = __expf(-(Ff + mxf)); tab[T2_EMB + lane] = __expf(-(Fb + mxb)); }
    __syncthreads();
#pragma unroll
    for (int x = 0; x < 2; ++x) {
        const int tix = w + 8 * x, jt = tix & 3, it = tix >> 2;
        f32x4 acc = (f32x4){0.f, 0.f, 0.f, 0.f};
#pragma unroll
        for (int k = 0; k < 4; ++k) acc = MFMA16(*(const LAS bf16x8*)(Ks + (16 * jt + c) * RSA + 32 * k + 8 * q), *(const LAS bf16x8*)(Qs + (16 * it + c) * RSA + 32 * k + 8 * q), acc);
        const int i = 16 * it + c, j0 = 16 * jt + 4 * q;
        const float mxfi = tab[T2_MXF + i], mxbi = tab[T2_MXB + i];
        const f32x4 ufj = *(const LAS f32x4*)(tab + T2_UF + j0), ubj = *(const LAS f32x4*)(tab + T2_UB + j0);
        float pf[4], pb[4], dsf = 0.f, dsb = 0.f;
#pragma unroll
        for (int r = 0; r < 4; ++r) { pf[r] = (j0 + r <= i) ? acc[r] * __expf(ufj[r] - mxfi) : 0.f; pb[r] = (j0 + r >= i) ? acc[r] * __expf(ubj[r] - mxbi) : 0.f; dsf += pf[r]; dsb += pb[r]; }
        dsf = qsum4(dsf); dsb = qsum4(dsb);
        if (q == 0) { tab[T2_DPF + jt * 64 + i] = dsf; tab[T2_DPB + jt * 64 + i] = dsb; }
        u32x2 pw; pw.x = pk2(pf[0], pf[1]); pw.y = pk2(pf[2], pf[3]); *(LAS u32x2*)(Pf + i * 72 + j0) = pw;
        pw.x = pk2(pb[0], pb[1]); pw.y = pk2(pb[2], pb[3]); *(LAS u32x2*)(Pb + i * 72 + j0) = pw;
    }
    {
        const int i = tid >> 3, d0 = (tid & 7) * 16;
        const u32x4 qa = *(const LAS u32x4*)(Qs + i * RSA + d0), qb = *(const LAS u32x4*)(Qs + i * RSA + d0 + 8);
        float sf = 0.f, sb = 0.f;
#pragma unroll
        for (int j = 0; j < 4; ++j) { const float a0 = bflo(qa[j]), a1 = bfhi(qa[j]), b0 = bflo(qb[j]), b1 = bfhi(qb[j]);
            sf += a0 * tab[T2_NVF + d0 + 2 * j] + a1 * tab[T2_NVF + d0 + 2 * j + 1] + b0 * tab[T2_NVF + d0 + 8 + 2 * j] + b1 * tab[T2_NVF + d0 + 8 + 2 * j + 1];
            sb += a0 * tab[T2_NVB + d0 + 2 * j] + a1 * tab[T2_NVB + d0 + 2 * j + 1] + b0 * tab[T2_NVB + d0 + 8 + 2 * j] + b1 * tab[T2_NVB + d0 + 8 + 2 * j + 1]; }
        sf += __shfl_xor(sf, 1); sf += __shfl_xor(sf, 2); sf += __shfl_xor(sf, 4); sb += __shfl_xor(sb, 1); sb += __shfl_xor(sb, 2); sb += __shfl_xor(sb, 4);
        if ((tid & 7) == 0) { tab[T2_QNF + i] = sf; tab[T2_QNB + i] = sb; }
    }
    __syncthreads();
    bf16x8 vf[2];
#pragma unroll
    for (int k = 0; k < 2; ++k) vf[k] = tr_frag(Vs, RSA, 32 * k + 8 * q, e0, c);
    f32x4 ya[4];
#pragma unroll
    for (int it = 0; it < 4; ++it) {
        const int i = 16 * it + c;
        f32x4 aof = (f32x4){0.f, 0.f, 0.f, 0.f}, aob = aof, aif = aof, aib = aof;
        aof = MFMA16(vf[0], *(const LAS bf16x8*)(Pf + i * 72 + 8 * q), aof);
        if (it >= 2) aof = MFMA16(vf[1], *(const LAS bf16x8*)(Pf + i * 72 + 32 + 8 * q), aof);
        aob = MFMA16(vf[1], *(const LAS bf16x8*)(Pb + i * 72 + 32 + 8 * q), aob);
        if (it < 2) aob = MFMA16(vf[0], *(const LAS bf16x8*)(Pb + i * 72 + 8 * q), aob);
#pragma unroll
        for (int k = 0; k < 4; ++k) {
            const bf16x8 qp = mk8(*(const LAS bf16x4*)(Qs + i * RSA + 32 * k + 4 * q), *(const LAS bf16x4*)(Qs + i * RSA + 32 * k + 16 + 4 * q));
            aif = MFMA16(__builtin_bit_cast(bf16x8, FR.cff[k]), qp, aif); aib = MFMA16(__builtin_bit_cast(bf16x8, FR.cfb[k]), qp, aib); }
        const float waf = tab[T2_WAF + i], wab = tab[T2_WAB + i];
        const float denf = tab[T2_DPF + i] + tab[T2_DPF + 64 + i] + tab[T2_DPF + 128 + i] + tab[T2_DPF + 192 + i] + waf * tab[T2_QNF + i];
        const float denb = tab[T2_DPB + i] + tab[T2_DPB + 64 + i] + tab[T2_DPB + 128 + i] + tab[T2_DPB + 192 + i] + wab * tab[T2_QNB + i];
        const float rdf = __builtin_amdgcn_rcpf(fmaxf(fabsf(denf), tab[T2_EMF + i])), rdb = __builtin_amdgcn_rcpf(fmaxf(fabsf(denb), tab[T2_EMB + i]));
        const f32x4 hv = (aof + aif * waf) * rdf + (aob + aib * wab) * rdb;
        const u32x2 og = ogv[it];
        f32x4 y; y[0] = hv[0] * sigmoidf_(bflo(og.x)); y[1] = hv[1] * sigmoidf_(bfhi(og.x)); y[2] = hv[2] * sigmoidf_(bflo(og.y)); y[3] = hv[3] * sigmoidf_(bfhi(og.y));
        ya[it] = y;
        float ss = (y[0] * y[0] + y[1] * y[1]) + (y[2] * y[2] + y[3] * y[3]);
        ss = qsum4(ss);
        if (q == 0) tab[T2_SSP + w * 64 + i] = ss;
    }
    if (u_next < 1024) a2_loadF(F, u_next, FR);
    __syncthreads();
#pragma unroll
    for (int it = 0; it < 4; ++it) {
        const int i = 16 * it + c;
        float ss = 0.f;
#pragma unroll
        for (int ww = 0; ww < 8; ++ww) ss += tab[T2_SSP + ww * 64 + i];
        const float rs = __builtin_amdgcn_rsqf(ss * (1.f / 128.f) + EPS);
        const u32x2 zg = zgv[it];
        const f32x4 y = ya[it] * rs * hg;
        u32x2 o; o.x = pk2(y[0] * siluf_(bflo(zg.x)), y[1] * siluf_(bfhi(zg.x))); o.y = pk2(y[2] * siluf_(bflo(zg.y)), y[3] * siluf_(bfhi(zg.y)));
        *(u32x2*)(F.R1 + (size_t)(rowb + i) * 1024 + h * 128 + e0 + 4 * q) = o;
    }
}

constexpr int RSB = 264;
__device__ __forceinline__ void ret_out(Ctx& F, int l, int s, int m) {
    FRESH_TID(F);
    const int tid = F.tid, lane = F.lane, w = F.wave, hh = w >> 1, ih = w & 1, c = lane & 15, q = lane >> 4;
    LAS bf16* Qs = (LAS bf16*)(F.lds); LAS bf16* Ks = (LAS bf16*)(F.lds + 33792); LAS bf16* Vs = (LAS bf16*)(F.lds + 67584); LAS bf16* Pw = (LAS bf16*)(F.lds + 101376 + w * 4608);
    int row0, L; seq_info(s, row0, L);
    const int gc = (row0 >> 6) + m, rowb = row0 + 64 * m;
    const bool rot = s >= 32;
    const float lgf = logsigmoid_acc(F.ret_logit[(l * 2 + 0) * 4 + hh]) * 1.4426950408889634f, lgb = logsigmoid_acc(F.ret_logit[(l * 2 + 1) * 4 + hh]) * 1.4426950408889634f;
    const float ginvf = ex2(-lgf), gmulb = ex2(lgb);
    u32x4 cff[4][2], cfb[4][2];
    { const size_t slot_f = ((size_t)gc * 4 + hh) * 2;
      const u32x4* pf_ = (const u32x4*)(F.Bst + slot_f * 4096) + lane; const u32x4* pb_ = (const u32x4*)(F.Bst + (slot_f + 1) * 4096) + lane;
#pragma unroll
      for (int es = 0; es < 4; ++es)
#pragma unroll
          for (int k = 0; k < 2; ++k) { cff[es][k] = __builtin_nontemporal_load(pf_ + (es * 2 + k) * 64); cfb[es][k] = __builtin_nontemporal_load(pb_ + (es * 2 + k) * 64); } }
    u32x2 zgv[2][4]; f32x4 hgv[4];
#pragma unroll
    for (int es = 0; es < 4; ++es) { hgv[es] = *(const f32x4*)(F.hn_g + l * 1024 + 512 + hh * 64 + 16 * es + 4 * q);
#pragma unroll
        for (int itl = 0; itl < 2; ++itl) zgv[itl][es] = *(const u32x2*)(F.PROJ + (size_t)(rowb + 16 * (2 * ih + itl) + c) * DINP + C_BZ + hh * 64 + 16 * es + 4 * q); }
#pragma unroll
    for (int i = 0; i < 2; ++i) {
        const int item = tid + 512 * i, r = item >> 4, hd = (item >> 2) & 3, cp = (item & 3) * 8;
        const bf16* src = F.PROJ + (size_t)(rowb + r) * DINP + hd * 64 + cp;
        float qa[8], qb[8], ka[8], kb[8];
        unpack8(*(const u32x4*)(src + C_BQ), qa); unpack8(*(const u32x4*)(src + C_BQ + 32), qb); unpack8(*(const u32x4*)(src + C_BK), ka); unpack8(*(const u32x4*)(src + C_BK + 32), kb);
        if (rot) { rot8(qa, qb, 64 * m + r, cp); rot8(ka, kb, 64 * m + r, cp); }
        *(LAS u32x4*)(Qs + r * RSB + hd * 64 + cp) = packf8(qa, 1.f); *(LAS u32x4*)(Qs + r * RSB + hd * 64 + cp + 32) = packf8(qb, 1.f);
        *(LAS u32x4*)(Ks + r * RSB + hd * 64 + cp) = packf8(ka, 1.f); *(LAS u32x4*)(Ks + r * RSB + hd * 64 + cp + 32) = packf8(kb, 1.f);
    }
#pragma unroll
    for (int i = 0; i < 4; ++i) { const int p = tid + 512 * i, r = p >> 5, cp = (p & 31) * 8;
        *(LAS u32x4*)(Vs + r * RSB + cp) = __builtin_nontemporal_load((const u32x4*)(F.PROJ + (size_t)(rowb + r) * DINP + C_BV + cp)); }
    __syncthreads();
#pragma unroll
    for (int itl = 0; itl < 2; ++itl)
#pragma unroll
        for (int jt = 0; jt < 4; ++jt) {
            const int it = 2 * ih + itl;
            f32x4 acc = (f32x4){0.f, 0.f, 0.f, 0.f};
#pragma unroll
            for (int k = 0; k < 2; ++k) acc = MFMA16(*(const LAS bf16x8*)(Ks + (16 * jt + c) * RSB + hh * 64 + 32 * k + 8 * q), *(const LAS bf16x8*)(Qs + (16 * it + c) * RSB + hh * 64 + 32 * k + 8 * q), acc);
            const int i = 16 * it + c, j0 = 16 * jt + 4 * q;
            float p[4];
            { float wf = ex2((float)(i - j0) * lgf), wb = ex2((float)(j0 - i) * lgb);
#pragma unroll
              for (int r = 0; r < 4; ++r) { const int j = j0 + r; p[r] = acc[r] * (((j <= i) ? wf : 0.f) + ((j >= i) ? wb : 0.f)); wf *= ginvf; wb *= gmulb; } }
            u32x2 pw; pw.x = pk2(p[0], p[1]); pw.y = pk2(p[2], p[3]);
            *(LAS u32x2*)(Pw + (16 * itl + c) * 72 + j0) = pw;
        }
    __syncthreads();
    bf16x8 vf[4][2];
#pragma unroll
    for (int es = 0; es < 4; ++es)
#pragma unroll
        for (int k = 0; k < 2; ++k) vf[es][k] = tr_frag(Vs, RSB, 32 * k + 8 * q, hh * 64 + 16 * es, c);
#pragma unroll
    for (int itl = 0; itl < 2; ++itl) {
        const int i = 16 * (2 * ih + itl) + c;
        const float wqf = ex2((float)(i + 1) * lgf), wqb = ex2((float)(64 - i) * lgb);
        bf16x8 qp[2], pp[2];
#pragma unroll
        for (int k = 0; k < 2; ++k) { qp[k] = mk8(*(const LAS bf16x4*)(Qs + i * RSB + hh * 64 + 32 * k + 4 * q), *(const LAS bf16x4*)(Qs + i * RSB + hh * 64 + 32 * k + 16 + 4 * q));
            pp[k] = *(const LAS bf16x8*)(Pw + (16 * itl + c) * 72 + 32 * k + 8 * q); }
        f32x4 yb[4]; float ss = 0.f;
#pragma unroll
        for (int es = 0; es < 4; ++es) {
            f32x4 ao = (f32x4){0.f, 0.f, 0.f, 0.f}, af = ao, ab = ao;
#pragma unroll
            for (int k = 0; k < 2; ++k) { ao = MFMA16(vf[es][k], pp[k], ao); af = MFMA16(__builtin_bit_cast(bf16x8, cff[es][k]), qp[k], af); ab = MFMA16(__builtin_bit_cast(bf16x8, cfb[es][k]), qp[k], ab); }
            const f32x4 y = ao + af * wqf + ab * wqb; yb[es] = y;
            ss += (y[0] * y[0] + y[1] * y[1]) + (y[2] * y[2] + y[3] * y[3]);
        }
        ss = qsum4(ss);
        const float rs = __builtin_amdgcn_rsqf(ss * (1.f / 64.f) + EPS);
#pragma unroll
        for (int es = 0; es < 4; ++es) {
            const int col = hh * 64 + 16 * es + 4 * q;
            const u32x2 zg = zgv[itl][es];
            const f32x4 hg = hgv[es];
            const f32x4 y = yb[es] * rs * hg;
            u32x2 o; o.x = pk2(y[0] * siluf_(bflo(zg.x)), y[1] * siluf_(bfhi(zg.x))); o.y = pk2(y[2] * siluf_(bflo(zg.y)), y[3] * siluf_(bfhi(zg.y)));
            *(u32x2*)(F.R1 + (size_t)(rowb + i) * 1024 + 512 + col) = o;
        }
    }
}

__device__ __forceinline__ void gla_out(Ctx& F, int l, int s, int m) {
    FRESH_TID(F);
    const int lane = F.lane, w = F.wave, hh = w >> 1, c32 = w & 1, c = lane & 15, q = lane >> 4;
    LAS bf16* base = (LAS bf16*)(F.lds + w * 17408);
    LAS bf16* Qf = base; LAS bf16* Kf = base + 1280; LAS bf16* Qb = base + 2560; LAS bf16* Kb = base + 3840; LAS bf16* Vs = base + 5120; LAS bf16* Pw = base + 7424;
    int row0, L; seq_info(s, row0, L);
    const int rowc = row0 + 64 * m + 32 * c32, gc32 = (row0 >> 5) + 2 * m + c32;
    u32x4 cff[4], cfb[4];
    { const size_t slot_f = ((size_t)gc32 * 4 + hh) * 2;
      const u32x4* pf_ = (const u32x4*)(F.Cst + slot_f * 2048) + lane; const u32x4* pb_ = (const u32x4*)(F.Cst + (slot_f + 1) * 2048) + lane;
#pragma unroll
      for (int es = 0; es < 4; ++es) { cff[es] = __builtin_nontemporal_load(pf_ + es * 64); cfb[es] = __builtin_nontemporal_load(pb_ + es * 64); } }
    u32x2 zgv[2][4]; f32x4 hgv[4];
#pragma unroll
    for (int es = 0; es < 4; ++es) { hgv[es] = *(const f32x4*)(F.hn_g + l * 1024 + 768 + hh * 64 + 16 * es + 4 * q);
#pragma unroll
        for (int it = 0; it < 2; ++it) zgv[it][es] = *(const u32x2*)(F.PROJ + (size_t)(rowc + 16 * it + c) * DINP + C_CZ + hh * 64 + 16 * es + 4 * q); }
#pragma unroll
    for (int i = 0; i < 4; ++i) { const int p = lane + 64 * i, r = p >> 3, cp = (p & 7) * 8;
        *(LAS u32x4*)(Vs + r * 72 + cp) = __builtin_nontemporal_load((const u32x4*)(F.PROJ + (size_t)(rowc + r) * DINP + C_CV + hh * 64 + cp)); }
    {
        const int p = lane >> 1, d0 = (lane & 1) * 16;
        const size_t row = (size_t)(rowc + p);
        const f32x4* cbf = (const f32x4*)(F.CB + (row * 2 + 0) * 128 + hh * 32 + d0); const f32x4* cbb = (const f32x4*)(F.CB + (row * 2 + 1) * 128 + hh * 32 + d0);
        const bf16* src = F.PROJ + row * DINP + hh * 32 + d0;
        float qv[16], kv[16], bf_[16], bb_[16];
        { float t8[8]; unpack8(*(const u32x4*)(src + C_CQ), t8);
#pragma unroll
          for (int j = 0; j < 8; ++j) qv[j] = t8[j];
          unpack8(*(const u32x4*)(src + C_CQ + 8), t8);
#pragma unroll
          for (int j = 0; j < 8; ++j) qv[8 + j] = t8[j];
          unpack8(*(const u32x4*)(src + C_CK), t8);
#pragma unroll
          for (int j = 0; j < 8; ++j) kv[j] = t8[j];
          unpack8(*(const u32x4*)(src + C_CK + 8), t8);
#pragma unroll
          for (int j = 0; j < 8; ++j) kv[8 + j] = t8[j]; }
#pragma unroll
        for (int j = 0; j < 4; ++j) { const f32x4 a = cbf[j], b = cbb[j];
#pragma unroll
            for (int r = 0; r < 4; ++r) { bf_[4 * j + r] = a[r]; bb_[4 * j + r] = b[r]; } }
#pragma unroll
        for (int hp = 0; hp < 2; ++hp) {
            u32x4 o;
#pragma unroll
            for (int j = 0; j < 4; ++j) o[j] = pk2(qv[8 * hp + 2 * j] * __expf(bf_[8 * hp + 2 * j]), qv[8 * hp + 2 * j + 1] * __expf(bf_[8 * hp + 2 * j + 1]));
            *(LAS u32x4*)(Qf + p * 40 + d0 + 8 * hp) = o;
#pragma unroll
            for (int j = 0; j < 4; ++j) o[j] = pk2(kv[8 * hp + 2 * j] * __expf(-bf_[8 * hp + 2 * j]), kv[8 * hp + 2 * j + 1] * __expf(-bf_[8 * hp + 2 * j + 1]));
            *(LAS u32x4*)(Kf + p * 40 + d0 + 8 * hp) = o;
#pragma unroll
            for (int j = 0; j < 4; ++j) o[j] = pk2(qv[8 * hp + 2 * j] * __expf(bb_[8 * hp + 2 * j]), qv[8 * hp + 2 * j + 1] * __expf(bb_[8 * hp + 2 * j + 1]));
            *(LAS u32x4*)(Qb + p * 40 + d0 + 8 * hp) = o;
#pragma unroll
            for (int j = 0; j < 4; ++j) o[j] = pk2(kv[8 * hp + 2 * j] * __expf(-bb_[8 * hp + 2 * j]), kv[8 * hp + 2 * j + 1] * __expf(-bb_[8 * hp + 2 * j + 1]));
            *(LAS u32x4*)(Kb + p * 40 + d0 + 8 * hp) = o;
        }
    }
    __syncthreads();
#pragma unroll
    for (int it = 0; it < 2; ++it)
#pragma unroll
        for (int jt = 0; jt < 2; ++jt) {
            const f32x4 z = (f32x4){0.f, 0.f, 0.f, 0.f};
            const f32x4 af = MFMA16(*(const LAS bf16x8*)(Kf + (16 * jt + c) * 40 + 8 * q), *(const LAS bf16x8*)(Qf + (16 * it + c) * 40 + 8 * q), z);
            const f32x4 ab = MFMA16(*(const LAS bf16x8*)(Kb + (16 * jt + c) * 40 + 8 * q), *(const LAS bf16x8*)(Qb + (16 * it + c) * 40 + 8 * q), z);
            const int i = 16 * it + c, j0 = 16 * jt + 4 * q;
            float p[4];
#pragma unroll
            for (int r = 0; r < 4; ++r) p[r] = ((j0 + r <= i) ? af[r] : 0.f) + ((j0 + r >= i) ? ab[r] : 0.f);
            u32x2 pw; pw.x = pk2(p[0], p[1]); pw.y = pk2(p[2], p[3]);
            *(LAS u32x2*)(Pw + i * 40 + j0) = pw;
        }
    __syncthreads();
    bf16x8 vf[4];
#pragma unroll
    for (int es = 0; es < 4; ++es) vf[es] = tr_frag(Vs, 72, 8 * q, 16 * es, c);
#pragma unroll
    for (int it = 0; it < 2; ++it) {
        const int i = 16 * it + c;
        const bf16x8 pp = *(const LAS bf16x8*)(Pw + i * 40 + 8 * q);
        const bf16x8 qpf = mk8(*(const LAS bf16x4*)(Qf + i * 40 + 4 * q), *(const LAS bf16x4*)(Qf + i * 40 + 16 + 4 * q));
        const bf16x8 qpb = mk8(*(const LAS bf16x4*)(Qb + i * 40 + 4 * q), *(const LAS bf16x4*)(Qb + i * 40 + 16 + 4 * q));
        f32x4 yc[4]; float ss = 0.f;
#pragma unroll
        for (int es = 0; es < 4; ++es) {
            f32x4 ao = (f32x4){0.f, 0.f, 0.f, 0.f};
            ao = MFMA16(vf[es], pp, ao); ao = MFMA16(__builtin_bit_cast(bf16x8, cff[es]), qpf, ao); ao = MFMA16(__builtin_bit_cast(bf16x8, cfb[es]), qpb, ao);
            yc[es] = ao; ss += (ao[0] * ao[0] + ao[1] * ao[1]) + (ao[2] * ao[2] + ao[3] * ao[3]);
        }
        ss = qsum4(ss);
        const float rs = __builtin_amdgcn_rsqf(ss * (1.f / 64.f) + EPS);
#pragma unroll
        for (int es = 0; es < 4; ++es) {
            const int col = hh * 64 + 16 * es + 4 * q;
            const u32x2 zg = zgv[it][es];
            const f32x4 hg = hgv[es];
            const f32x4 y = yc[es] * rs * hg;
            u32x2 o; o.x = pk2(y[0] * siluf_(bflo(zg.x)), y[1] * siluf_(bfhi(zg.x))); o.y = pk2(y[2] * siluf_(bflo(zg.y)), y[3] * siluf_(bfhi(zg.y)));
            *(u32x2*)(F.R1 + (size_t)(rowc + i) * 1024 + 768 + col) = o;
        }
    }
}

__device__ __forceinline__ void mixer_pass2(Ctx& F, int l) {
    FRESH_TID(F);
    const int gc0 = F.g_pm0 * 4, ub = gc0 * 4;
    {
        A2R R, Rn; A2Q Q; A2F FR;
        const int u0 = ub + F.g_r;
        a2_loadA(F, l, u0, R); a2_loadQ(F, u0, Q); a2_loadF(F, u0, FR);
#pragma unroll 1
        for (int k = 0; k < 4; ++k) {
            a2_compute(F, l, u0 + 16 * k, R, Q, FR, k < 3 ? u0 + 16 * (k + 1) : 2000, Rn);
            R = Rn;
        }
    }
    __syncthreads();
    { const int gc = gc0 + F.g_r;
      int s, m; if (gc < 128) { s = gc >> 2; m = gc & 3; } else { s = 32 + ((gc - 128) >> 4); m = (gc - 128) & 15; }
      ret_out(F, l, s, m);
      __syncthreads();
      gla_out(F, l, s, m);
      __syncthreads(); }
}

__device__ __forceinline__ void group_barrier(Ctx& F, unsigned& epoch) {
    asm volatile("s_waitcnt vmcnt(0)" ::: "memory");
    __syncthreads();
    ++epoch;
    if (threadIdx.x == 0) {
        unsigned* cnt = F.ctl + CW_GB + 64 * F.g_id; unsigned* tmo = F.ctl + CW_GTMO;
        if (F.g_rel) {
            __builtin_amdgcn_fence(__ATOMIC_RELEASE, "agent");
            asm volatile("s_waitcnt vmcnt(0)" ::: "memory"); }
        (void)__hip_atomic_fetch_add(cnt, 1u, __ATOMIC_RELAXED, __HIP_MEMORY_SCOPE_AGENT);
        const unsigned target = epoch * 16u; unsigned sp = 0;
        while (__hip_atomic_load(cnt, __ATOMIC_RELAXED, __HIP_MEMORY_SCOPE_AGENT) < target) {
            __builtin_amdgcn_s_sleep(1);
            if ((++sp & 255u) == 0u) { if (__hip_atomic_load(tmo, __ATOMIC_RELAXED, __HIP_MEMORY_SCOPE_AGENT)) break; if (sp > (1u << 20)) { atomicAdd(tmo, 1u); break; } }
        }
        __builtin_amdgcn_fence(__ATOMIC_ACQUIRE, "agent");
        asm volatile("s_waitcnt vmcnt(0)" ::: "memory");
    }
    __syncthreads();
}
__device__ __forceinline__ void final_group(Ctx& F) {
    FRESH_TID(F);
    const int gw = F.g_r * 8 + F.wave;
    for (int mm = gw; mm < 1024; mm += 128) {
        const int m = F.g_pm0 * 256 + mm;
        const float rstd = __builtin_amdgcn_rsqf(F.ssq[4 * NTOK + m] * (1.f / 1024.f) + EPS);
        const u32x4* xr = (const u32x4*)(F.XB + (size_t)m * 1024) + F.lane;
        f32x4* orow = (f32x4*)(F.out + (size_t)m * 1024);
#pragma unroll
        for (int j = 0; j < 2; ++j) { const u32x4 xb = __builtin_nontemporal_load(xr + 64 * j); const int c0 = 8 * F.lane + 512 * j;
            const f32x4 g0 = *(const f32x4*)(F.final_g + c0), g1 = *(const f32x4*)(F.final_g + c0 + 4);
            const f32x4 x0 = (f32x4){bflo(xb.x), bfhi(xb.x), bflo(xb.y), bfhi(xb.y)}, x1 = (f32x4){bflo(xb.z), bfhi(xb.z), bflo(xb.w), bfhi(xb.w)};
            __builtin_nontemporal_store(x0 * rstd * g0, orow + (c0 >> 2)); __builtin_nontemporal_store(x1 * rstd * g1, orow + (c0 >> 2) + 1); }
    }
}

__global__ void __launch_bounds__(512, 2) fwd_kernel(Args args) {
    extern __shared__ __attribute__((aligned(16))) unsigned char lds_raw[];
    Ctx F;
    F.lds = (LAS unsigned char*)lds_raw;
    F.tid = threadIdx.x; F.lane = F.tid & 63; F.wave = __builtin_amdgcn_readfirstlane(F.tid >> 6); F.G = gridDim.x; F.bid = blockIdx.x;
    F.x_prompt = args.in[0]; F.x_sample = args.in[1]; F.st_C = args.in[2]; F.st_n = args.in[3]; F.st_m = args.in[4]; F.st_ret = args.in[5]; F.st_gla = args.in[6];
    F.cvec = args.in[7]; F.c_ctx = args.in[8]; F.norm_g = args.in[9]; F.w_ada = args.in[10]; F.b_ada = args.in[11]; F.w_in = args.in[12]; F.gate_b = args.in[13];
    F.ret_logit = args.in[14]; F.gla_w2 = args.in[15]; F.gla_b2 = args.in[16]; F.hn_g = args.in[17]; F.w_out = args.in[18]; F.final_g = args.in[19];
    F.out = args.out; unsigned char* ws = args.ws;
    F.ctl = (unsigned*)(ws + WS_CTL); F.mod = (float*)(ws + WS_MOD); F.WinT = (bf16*)(ws + WS_WIN); F.WoutT = (bf16*)(ws + WS_WOUT);
    F.R1 = (bf16*)(ws + WS_R1); F.PROJ = (bf16*)(ws + WS_PROJ); F.Ast = (bf16*)(ws + WS_AST); F.Bst = (bf16*)(ws + WS_BST); F.Cst = (bf16*)(ws + WS_CST); F.Anm = (float*)(ws + WS_ANM); F.AG = (float*)(ws + WS_AG); F.CB = (float*)(ws + WS_CB); F.SW = (float*)(ws + WS_SW); F.R3 = (bf16*)(ws + WS_R3); F.XB = (bf16*)(ws + WS_XB); F.ssq = (float*)(F.ctl + CW_SUMSQ);
    if (F.tid < 8) ((LAS unsigned*)(F.lds + LDS_BYTES - 32))[F.tid] = 0u;
    __syncthreads();
    const XcdBarrier xbar = xcd_barrier_post(F.ctl + CW_BAR, (volatile LAS unsigned*)(F.lds + LDS_BYTES - 32));
    p0_prologue(F);
    xcd_barrier(xbar);
    {
        bool uniform = true;
#pragma unroll
        for (unsigned j = 0; j < 16; ++j) { const unsigned cj = xb_ld(&xbar.bar[XB_XCNT(j)]); uniform = uniform && (cj == (j < 8 ? 32u : 0u)); }
        const unsigned myrank = (unsigned)__builtin_amdgcn_readfirstlane((int)((volatile LAS unsigned*)(F.lds + LDS_BYTES - 32))[2]);
        uniform = uniform && (xbar.x < 8u) && (myrank < 32u);
        const int x = uniform ? (int)xbar.x : (F.bid & 7), i = uniform ? (int)myrank : (F.bid >> 3);
        F.g_rel = uniform ? 0 : 1;
        const int xi = __builtin_amdgcn_readfirstlane(x), ii = __builtin_amdgcn_readfirstlane(i);
        F.g_typ = ii >> 4; F.g_r = ii & 15; F.g_id = F.g_typ * 8 + xi; F.g_pm0 = F.g_typ ? 32 + 4 * xi : 4 * xi; F.g_s0 = F.g_typ ? 32 + xi : 4 * xi;
    }
    p0b_phase(F);
    xcd_barrier(xbar);
    unsigned gbe = 0;
    for (int l = 0; l < DEPTH; ++l) {
        {
            pg8::Gemm g{F.R3, F.WinT + (size_t)l * DINP * 1024, NTOK, DIN_EARLY, 1024}; pg8::StaticOrder S; S.init(NTOK, DIN_EARLY, F.G, F.bid);
            S.grp_w = 16; S.grp_r = F.g_r; S.grp_pm0 = F.g_pm0; S.grp_units = 64;
            if (F.g_r < 8) S.late_pn = (DIN_EARLY / 256) + (F.g_r >> 2);
            S.arrive = F.ctl + CW_GA + 64 * F.g_id; S.arrive_pn = 12 + (F.g_r >> 2); S.arrive_rel = F.g_rel;
            pg8::EpiBf16 E{F.PROJ, DINP, F.ssq + (size_t)l * NTOK, F.SW + (size_t)l * 16 * DINP};
            pg8::gemm_phase<pg8::EpiBf16, pg8::StaticOrder, true, true>(F.lds, g, S, E);
        }
        {
            __syncthreads();
            if (threadIdx.x == 0) {
                unsigned* cnt = F.ctl + CW_GA + 64 * F.g_id; unsigned* tmo = F.ctl + CW_GTMO;
                const unsigned target = 128u * (unsigned)(l + 1); unsigned sp = 0;
                while (__hip_atomic_load(cnt, __ATOMIC_RELAXED, __HIP_MEMORY_SCOPE_AGENT) < target) {
                    __builtin_amdgcn_s_sleep(1);
                    if ((++sp & 255u) == 0u) { if (__hip_atomic_load(tmo, __ATOMIC_RELAXED, __HIP_MEMORY_SCOPE_AGENT)) break; if (sp > (1u << 20)) { atomicAdd(tmo, 1u); break; } }
                }
                __builtin_amdgcn_fence(__ATOMIC_ACQUIRE, "agent");
                asm volatile("s_waitcnt vmcnt(0)" ::: "memory");
            }
            __syncthreads();
        }
        mixer_pass1(F, l);
        group_barrier(F, gbe);
        mixer_pass2(F, l);
        group_barrier(F, gbe);
        {
            pg8::Gemm g{F.R1, F.WoutT + (size_t)l * 1024 * 1024, NTOK, 1024, 1024}; pg8::StaticOrder S; S.init(NTOK, 1024, F.G, F.bid);
            S.grp_w = 16; S.grp_r = F.g_r; S.grp_pm0 = F.g_pm0; S.grp_units = 16;
            const bool lastl = (l == DEPTH - 1);
            pg8::EpiResid E{F.x_prompt, F.x_sample, l == 0 ? nullptr : F.XB, F.out, F.XB, F.mod + (size_t)l * 9 * 3072 + 2048,
                            lastl ? nullptr : F.norm_g + (l + 1) * 1024, lastl ? nullptr : F.mod + (size_t)(l + 1) * 9 * 3072 + 1024, F.R3, F.ssq + (size_t)(l + 1) * NTOK};
            pg8::gemm_phase<pg8::EpiResid, pg8::StaticOrder, true, true>(F.lds, g, S, E);
        }
        group_barrier(F, gbe);
    }
    final_group(F);
}

extern "C" void kernel_launch(void* const* d_in, const int* in_sizes, int n_in, void* d_out, int out_size, void* d_ws, size_t ws_size, hipStream_t stream) {
    static int grid = 0;
    if (grid == 0) {
        if (n_in != 20 || out_size != (int)O_END || ws_size < WS_END) { fprintf(stderr, "kernel_launch: unexpected shapes: n_in %d out %d ws %zu\n", n_in, out_size, ws_size); grid = -1; return; }
        int dev = 0, cus = 0, per_cu = 0;
        if (hipGetDevice(&dev) != hipSuccess || hipDeviceGetAttribute(&cus, hipDeviceAttributeMultiprocessorCount, dev) != hipSuccess) { grid = -1; return; }
        if (hipFuncSetAttribute((const void*)fwd_kernel, hipFuncAttributeMaxDynamicSharedMemorySize, LDS_BYTES) != hipSuccess) { fprintf(stderr, "kernel_launch: hipFuncSetAttribute failed\n"); grid = -1; return; }
        if (hipOccupancyMaxActiveBlocksPerMultiprocessor(&per_cu, (const void*)fwd_kernel, 512, LDS_BYTES) != hipSuccess || per_cu < 1) { fprintf(stderr, "kernel_launch: occupancy query says %d blocks per CU\n", per_cu); per_cu = 1; }
        (void)hipGetLastError();
        grid = cus;
        if (grid != 256) { fprintf(stderr, "kernel_launch: this kernel is built for a 256-CU device (16 groups of 16 workgroups); found %d CUs\n", cus); grid = -1; return; }
    }
    if (grid < 0) return;
    (void)hipMemsetAsync((char*)d_ws + WS_CTL, 0, CTL_ZERO_BYTES, stream);
    Args a{};
    for (int i = 0; i < 20; ++i) a.in[i] = (const float*)d_in[i];
    a.out = (float*)d_out; a.ws = (unsigned char*)d_ws;
    a.ph_lo = 0; a.ph_hi = NPHASE;
    void* kargs[] = {&a};
    hipError_t e = hipLaunchCooperativeKernel((const void*)fwd_kernel, dim3(grid), dim3(512), kargs, LDS_BYTES, stream);
    if (e != hipSuccess) fprintf(stderr, "kernel_launch: cooperative launch failed: %s (grid %d)\n", hipGetErrorString(e), grid);
}
```

```cpp
#include <hip/hip_runtime.h>
#include <hip/hip_cooperative_groups.h>
#include <cstdio>
#include <cstdint>
namespace cg = cooperative_groups;

#define TM_XA 0
#define TM_XB 1
#define TM_YA 0
#define TM_YB 1
#define TM_UNIT1 0
#define TM_UNIT2 0
#ifndef USE_CG_SYNC
#define USE_CG_SYNC 0
#endif
#ifndef N_LAUNCH_MODE
#define N_LAUNCH_MODE 1
#endif

#define LAS __attribute__((address_space(3)))
typedef unsigned short bf16;
typedef short bf16x8 __attribute__((ext_vector_type(8)));
typedef short bf16x4 __attribute__((ext_vector_type(4)));
typedef float f32x4 __attribute__((ext_vector_type(4)));
typedef unsigned u32x4 __attribute__((ext_vector_type(4)));
typedef unsigned u32x2 __attribute__((ext_vector_type(2)));

__device__ __forceinline__ float qsum4(float v) {
    unsigned u = __builtin_bit_cast(unsigned, v);
    auto r = __builtin_amdgcn_permlane16_swap(u, u, false, false);
    v = __builtin_bit_cast(float, (unsigned)r[0]) + __builtin_bit_cast(float, (unsigned)r[1]);
    u = __builtin_bit_cast(unsigned, v);
    auto r2 = __builtin_amdgcn_permlane32_swap(u, u, false, false);
    return __builtin_bit_cast(float, (unsigned)r2[0]) + __builtin_bit_cast(float, (unsigned)r2[1]);
}
namespace pg8 {
#define PG8_LAS __attribute__((address_space(3)))
typedef unsigned short bf16_t;
constexpr int BM = 256, BK = 64, HALF = 128, HTB = HALF * BK * 2, STAGE_BYTES = 8 * HTB, NXCD = 8, WGM = 8;

__host__ __device__ __forceinline__ int lds_byte(int r, int c) { const int st = (r >> 4) * 2 + (c >> 5), rr = r & 15, cc = c & 31, ob = rr * 64 + cc * 2; return st * 1024 + (ob ^ (((ob >> 9) & 1) << 5)); }
__host__ __device__ __forceinline__ void stage_rc(int b, int& R, int& C) { const int st = b / 1024, sb = b % 1024, swz = sb ^ (((sb >> 9) & 1) << 5); R = (st >> 1) * 16 + swz / 64; C = (st & 1) * 32 + (swz % 64) / 2; }
__host__ __device__ __forceinline__ int perm32(int rho) { const int n = rho >> 4, i = rho & 15; return 8 * (i >> 2) + 4 * n + (i & 3); }

struct Unit { int pm, pn; };
struct Gemm { const bf16_t* A; const bf16_t* Bt; int M, N, K; };

struct StaticOrder {
    int nM, nN, nwg, G, c, one_pm, one_pn;
    int grp_w, grp_r, grp_pm0, grp_units;
    int late_pn;
    unsigned* arrive; int arrive_pn, arrive_rel;
    __host__ __device__ void init(int M, int N, int G_, int c_) { nM = M / BM; nN = N / BM; nwg = nM * nN; G = G_; c = c_; one_pm = -1; one_pn = 0; grp_w = 0; grp_r = 0; grp_pm0 = 0; grp_units = 0;
        late_pn = -1; arrive = nullptr; arrive_pn = -1; arrive_rel = 0; }
    __host__ __device__ bool next(int i, Unit& u) const {
        if (one_pm >= 0) { if (i != 0) return false; u.pm = one_pm; u.pn = one_pn; return true; }
        if (grp_w > 0) { const int j = i * grp_w + grp_r;
            if (j >= grp_units) { if (late_pn >= 0 && j < grp_units + grp_w) { u.pm = grp_pm0 + (grp_r & 3); u.pn = late_pn; return true; } return false; }
            u.pm = grp_pm0 + (j & 3); u.pn = j >> 2; return true; }
        const long L = (long)i * G + c; if (L >= nwg) return false;
        int wgid = (int)L; { const int q = nwg / NXCD, r = nwg % NXCD, xcd = wgid % NXCD, off = wgid / NXCD; wgid = (xcd < r ? xcd * (q + 1) : r * (q + 1) + (xcd - r) * q) + off; }
        const int nig = WGM * nN, gid = wgid / nig, fm = gid * WGM, gsz = (nM - fm) < WGM ? (nM - fm) : WGM;
        u.pm = fm + ((wgid % nig) % gsz); u.pn = (wgid % nig) / gsz; return true;
    }
    __device__ __forceinline__ void a_ready(const Unit&) const {}
    __device__ __forceinline__ void done(const Unit& u) const {
        if (arrive != nullptr && u.pn == arrive_pn) {
            asm volatile("s_waitcnt vmcnt(0)" ::: "memory");
            if (arrive_rel) { __builtin_amdgcn_fence(__ATOMIC_RELEASE, "agent"); asm volatile("s_waitcnt vmcnt(0)" ::: "memory"); }
            if ((threadIdx.x & 63) == 0) (void)__hip_atomic_fetch_add(arrive, 1u, __ATOMIC_RELAXED, __HIP_MEMORY_SCOPE_AGENT);
        }
    }
};

__device__ __forceinline__ unsigned cvt_pk_bf16(float lo, float hi) { unsigned r; asm volatile("v_cvt_pk_bf16_f32 %0, %1, %2" : "=v"(r) : "v"(lo), "v"(hi)); return r; }

struct EpiBf16 {
    static constexpr bool PERM = true, AFTER_DRAIN = false;
    bf16_t* O; int ldc; const float* sumsq; const float* sw;
    __device__ __forceinline__ void operator()(const f32x4 (&acc)[2][2][4][2], const Unit& u, int wr, int wc, int fr, int fq) const {
        const int row0 = u.pm * BM + wr * 64 + fr; const int col0 = u.pn * BM + wc * 32 + 8 * fq;
        const int mr = (u.pm < 32) ? 0 : 1 + ((u.pm - 32) >> 2);
        const float* swr = sw + (size_t)mr * ldc + col0;
        f32x4 s0[2], s1[2];
#pragma unroll
        for (int bj = 0; bj < 2; ++bj) { s0[bj] = *(const f32x4*)(swr + bj * HALF); s1[bj] = *(const f32x4*)(swr + bj * HALF + 4); }
        float rsv[2][4];
#pragma unroll
        for (int ai = 0; ai < 2; ++ai)
#pragma unroll
            for (int m = 0; m < 4; ++m) rsv[ai][m] = sumsq[row0 + ai * HALF + m * 16];
#pragma unroll
        for (int ai = 0; ai < 2; ++ai)
#pragma unroll
            for (int m = 0; m < 4; ++m) { const int row = row0 + ai * HALF + m * 16; bf16_t* rowp = O + (size_t)row * ldc + col0;
                const float rs = __builtin_amdgcn_rsqf(rsv[ai][m] * (1.f / 1024.f) + 1e-6f);
#pragma unroll
                for (int bj = 0; bj < 2; ++bj) { const f32x4 v0 = acc[ai][bj][m][0] * rs + s0[bj], v1 = acc[ai][bj][m][1] * rs + s1[bj];
                    u32x4 w; w.x = cvt_pk_bf16(v0[0], v0[1]); w.y = cvt_pk_bf16(v0[2], v0[3]); w.z = cvt_pk_bf16(v1[0], v1[1]); w.w = cvt_pk_bf16(v1[2], v1[3]);
                    *(u32x4*)(rowp + bj * HALF) = w; } }
    }
};
struct EpiResid {
    static constexpr bool PERM = true, AFTER_DRAIN = false;
    const float* xin0; const float* xin1;
    const bf16_t* xinb;
    float* xout; bf16_t* xoutb;
    const float* gate;
    const float* gn; const float* scn; bf16_t* An; float* ssn;
    template <bool XB_IN, bool NEXT>
    __device__ __forceinline__ void run(const f32x4 (&acc)[2][2][4][2], const Unit& u, int wr, int wc, int fr, int fq) const {
        const int row0 = u.pm * BM + wr * 64 + fr, col0 = u.pn * BM + wc * 32 + 8 * fq;
        const int mr = (u.pm < 32) ? 0 : 1 + ((u.pm - 32) >> 2);
        const float* gr = gate + (size_t)mr * 3072 + col0;
        constexpr int D = XB_IN ? 4 : 2;
        u32x4 xb[D][2]; f32x4 xf[D][2][2];
#define ER_LOAD(r_, slot_) do { const int row_ = row0 + ((r_) >> 2) * HALF + ((r_) & 3) * 16; \
            _Pragma("unroll") for (int bj = 0; bj < 2; ++bj) { \
                if constexpr (XB_IN) xb[slot_][bj] = *(const u32x4*)(xinb + (size_t)row_ * 1024 + col0 + bj * HALF); \
                else { const float* xr = (row_ < 8192 ? xin0 + (size_t)row_ * 1024 : xin1 + (size_t)(row_ - 8192) * 1024) + col0 + bj * HALF; \
                       xf[slot_][bj][0] = __builtin_nontemporal_load((const f32x4*)xr); xf[slot_][bj][1] = __builtin_nontemporal_load((const f32x4*)(xr + 4)); } } } while (0)
#pragma unroll
        for (int r = 0; r < D; ++r) ER_LOAD(r, r);
        f32x4 gv[2][2], gs[2][2];
#pragma unroll
        for (int bj = 0; bj < 2; ++bj)
#pragma unroll
            for (int n = 0; n < 2; ++n) { gv[bj][n] = *(const f32x4*)(gr + bj * HALF + n * 4);
                if constexpr (NEXT) { const f32x4 g4 = *(const f32x4*)(gn + col0 + bj * HALF + n * 4), s4 = *(const f32x4*)(scn + (size_t)mr * 3072 + col0 + bj * HALF + n * 4); gs[bj][n] = g4 * (s4 + 1.0f); } }
#pragma unroll
        for (int r = 0; r < 8; ++r) { const int ai = r >> 2, m = r & 3, row = row0 + ai * HALF + m * 16, slot = r % D;
            float ss = 0.f;
#pragma unroll
            for (int bj = 0; bj < 2; ++bj) {
                f32x4 x0, x1;
                if constexpr (XB_IN) { const u32x4 v = xb[slot][bj];
                    x0 = (f32x4){__builtin_bit_cast(float, v.x << 16), __builtin_bit_cast(float, v.x & 0xffff0000u), __builtin_bit_cast(float, v.y << 16), __builtin_bit_cast(float, v.y & 0xffff0000u)};
                    x1 = (f32x4){__builtin_bit_cast(float, v.z << 16), __builtin_bit_cast(float, v.z & 0xffff0000u), __builtin_bit_cast(float, v.w << 16), __builtin_bit_cast(float, v.w & 0xffff0000u)}; }
                else { x0 = xf[slot][bj][0]; x1 = xf[slot][bj][1]; }
                const f32x4 n0 = x0 + gv[bj][0] * acc[ai][bj][m][0], n1 = x1 + gv[bj][1] * acc[ai][bj][m][1];
                { u32x4 w; w.x = cvt_pk_bf16(n0[0], n0[1]); w.y = cvt_pk_bf16(n0[2], n0[3]); w.z = cvt_pk_bf16(n1[0], n1[1]); w.w = cvt_pk_bf16(n1[2], n1[3]);
                  *(u32x4*)(xoutb + (size_t)row * 1024 + col0 + bj * HALF) = w; }
                ss += ((n0[0] * n0[0] + n0[1] * n0[1]) + (n0[2] * n0[2] + n0[3] * n0[3])) + ((n1[0] * n1[0] + n1[1] * n1[1]) + (n1[2] * n1[2] + n1[3] * n1[3]));
                if constexpr (NEXT) { const f32x4 a0 = n0 * gs[bj][0], a1 = n1 * gs[bj][1];
                    u32x4 w; w.x = cvt_pk_bf16(a0[0], a0[1]); w.y = cvt_pk_bf16(a0[2], a0[3]); w.z = cvt_pk_bf16(a1[0], a1[1]); w.w = cvt_pk_bf16(a1[2], a1[3]);
                    *(u32x4*)(An + (size_t)row * 1024 + col0 + bj * HALF) = w; } }
            ss = qsum4(ss);
            if (fq == 0) atomicAdd(ssn + row, ss);
            if (r + D < 8) ER_LOAD(r + D, slot);
        }
#undef ER_LOAD
    }
    __device__ __forceinline__ void operator()(const f32x4 (&acc)[2][2][4][2], const Unit& u, int wr, int wc, int fr, int fq) const {
        if (xinb) { if (gn) run<true, true>(acc, u, wr, wc, fr, fq); else run<true, false>(acc, u, wr, wc, fr, fq); }
        else run<false, true>(acc, u, wr, wc, fr, fq);
    }
};

template <class Epi, class Sched, bool ALIGN_EPI = false, bool SP2 = false>
__device__ __forceinline__ void gemm_phase(PG8_LAS unsigned char* lds, const Gemm g, const Sched& S, const Epi& E) {
    int tid_ = threadIdx.x; asm volatile("" : "+v"(tid_));
    const int tid = tid_, wid = __builtin_amdgcn_readfirstlane(tid >> 6), lane = tid & 63, wr = wid >> 2, wc = wid & 3, fr = lane & 15, fq = lane >> 4;
    const int K = g.K, nt = K / BK;
    unsigned voffA[2], voffB[2];
#pragma unroll
    for (int i = 0; i < 2; ++i) { int R, C; stage_rc(tid * 16 + i * 8192, R, C); const int Rb = Epi::PERM ? ((R & ~31) + perm32(R & 31)) : R;
        voffA[i] = (unsigned)(R * K + C) * 2u; voffB[i] = (unsigned)(Rb * K + C) * 2u; }
    const size_t kstep = (size_t)(BK * 2);
    const size_t hstep = (size_t)HALF * K * 2;
    const size_t tstep = 2 * hstep;
    const unsigned ldsw = (unsigned)wid * 1024u;
    const int aoff = lds_byte(wr * 64 + fr, fq * 8), boff = lds_byte(wc * 32 + fr, fq * 8);
#define PG8_SA(b, h) (((b) * 2 + (h)) * HTB)
#define PG8_SB(b, h) ((4 + (b) * 2 + (h)) * HTB)
#define PG8_STAGE(bufoff, gbase, voff) do { _Pragma("unroll") for (int _i = 0; _i < 2; ++_i) \
        __builtin_amdgcn_global_load_lds((const unsigned*)((const char*)(gbase) + (voff)[_i]), (PG8_LAS unsigned*)(lds + (bufoff) + ldsw + _i * 8192), 16, 0, 0); } while (0)
#define PG8_LDA(dst, b, h) do { _Pragma("unroll") for (int m = 0; m < 4; ++m) _Pragma("unroll") for (int k = 0; k < 2; ++k) dst[m][k] = *(const PG8_LAS bf16x8*)(lds + PG8_SA(b, h) + aoff + m * 2048 + k * 1024); } while (0)
#define PG8_LDB(dst, b, h) do { _Pragma("unroll") for (int n = 0; n < 2; ++n) _Pragma("unroll") for (int k = 0; k < 2; ++k) dst[n][k] = *(const PG8_LAS bf16x8*)(lds + PG8_SB(b, h) + boff + n * 2048 + k * 1024); } while (0)
#define PG8_MMA(ai, bj, At, Bt) do { __builtin_amdgcn_s_setprio(1); _Pragma("unroll") for (int m = 0; m < 4; ++m) _Pragma("unroll") for (int n = 0; n < 2; ++n) _Pragma("unroll") for (int k = 0; k < 2; ++k) \
        acc[ai][bj][m][n] = __builtin_amdgcn_mfma_f32_16x16x32_bf16(Bt[n][k], At[m][k], acc[ai][bj][m][n], 0, 0, 0); __builtin_amdgcn_s_setprio(0); } while (0)
#define PG8_WAIT_V(n) asm volatile("s_waitcnt vmcnt(" #n ")" ::: "memory")
#define PG8_WAIT_L(n) asm volatile("s_waitcnt lgkmcnt(" #n ")" ::: "memory")
#define PG8_BAR __builtin_amdgcn_s_barrier()
#define PG8_SCHED __builtin_amdgcn_sched_barrier(0)
    Unit cur, nxt; int ui = 0;
    if (!S.next(0, cur)) return;
    f32x4 acc[2][2][4][2];
#pragma unroll
    for (int a = 0; a < 2; ++a)
#pragma unroll
        for (int b = 0; b < 2; ++b)
#pragma unroll
            for (int m = 0; m < 4; ++m)
#pragma unroll
                for (int n = 0; n < 2; ++n) acc[a][b][m][n] = (f32x4){0.f, 0.f, 0.f, 0.f};
    bf16x8 At[4][2], B0[2][2], B1[2][2];
    const char* cA = (const char*)g.A + (size_t)cur.pm * tstep; const char* cB = (const char*)g.Bt + (size_t)cur.pn * tstep;
    S.a_ready(cur);
    if constexpr (SP2) {
        PG8_STAGE(PG8_SB(0, 0), cB, voffB); PG8_STAGE(PG8_SB(0, 1), cB + hstep, voffB); PG8_STAGE(PG8_SA(0, 0), cA, voffA); PG8_STAGE(PG8_SA(0, 1), cA + hstep, voffA);
        if (wr == 1) PG8_BAR;
        PG8_WAIT_V(2); PG8_BAR;
        PG8_STAGE(PG8_SB(1, 0), cB + kstep, voffB); PG8_STAGE(PG8_SA(1, 0), cA + kstep, voffA); PG8_STAGE(PG8_SB(1, 1), cB + hstep + kstep, voffB);
        PG8_WAIT_V(6); PG8_BAR;
    } else {
        PG8_STAGE(PG8_SB(0, 0), cB, voffB); PG8_STAGE(PG8_SA(0, 0), cA, voffA); PG8_STAGE(PG8_SB(0, 1), cB + hstep, voffB); PG8_STAGE(PG8_SA(0, 1), cA + hstep, voffA);
        if (wr == 1) PG8_BAR;
        PG8_WAIT_V(4); PG8_BAR;
        PG8_STAGE(PG8_SB(1, 0), cB + kstep, voffB); PG8_STAGE(PG8_SA(1, 0), cA + kstep, voffA); PG8_STAGE(PG8_SB(1, 1), cB + hstep + kstep, voffB);
        PG8_WAIT_V(6); PG8_BAR;
    }
    for (;;) {
        const bool has_next = S.next(ui + 1, nxt);
        const char* nA = has_next ? (const char*)g.A + (size_t)nxt.pm * tstep : cA; const char* nB = has_next ? (const char*)g.Bt + (size_t)nxt.pn * tstep : cB;
        for (int t = 0; t < nt; t += 2) {
            const bool last = (t == nt - 2);
            const char* a1 = cA + (size_t)(t + 1) * kstep;
            const char* a2 = last ? nA : cA + (size_t)(t + 2) * kstep; const char* b2 = last ? nB : cB + (size_t)(t + 2) * kstep;
            const char* a3 = a2 + kstep; const char* b3 = b2 + kstep;
            if (last && has_next) S.a_ready(nxt);
            if constexpr (SP2) {
            PG8_LDB(B0, 0, 0); PG8_LDB(B1, 0, 1); PG8_SCHED; PG8_LDA(At, 0, 0); PG8_STAGE(PG8_SA(1, 1), a1 + hstep, voffA);
            PG8_WAIT_V(8); PG8_WAIT_L(0); PG8_BAR; PG8_MMA(0, 0, At, B0); PG8_MMA(0, 1, At, B1); PG8_BAR; PG8_SCHED;
            PG8_LDA(At, 0, 1); PG8_STAGE(PG8_SB(0, 0), b2, voffB); PG8_STAGE(PG8_SB(0, 1), b2 + hstep, voffB); PG8_STAGE(PG8_SA(0, 0), a2, voffA);
            PG8_WAIT_V(8); PG8_WAIT_L(0); PG8_BAR; PG8_MMA(1, 0, At, B0); PG8_MMA(1, 1, At, B1); PG8_BAR; PG8_SCHED;
            PG8_LDB(B0, 1, 0); PG8_LDB(B1, 1, 1); PG8_SCHED; PG8_LDA(At, 1, 0); PG8_STAGE(PG8_SA(0, 1), a2 + hstep, voffA);
            PG8_WAIT_V(8); PG8_WAIT_L(0); PG8_BAR; PG8_MMA(0, 0, At, B0); PG8_MMA(0, 1, At, B1); PG8_BAR; PG8_SCHED;
            PG8_LDA(At, 1, 1); PG8_STAGE(PG8_SB(1, 0), b3, voffB); PG8_STAGE(PG8_SB(1, 1), b3 + hstep, voffB); PG8_STAGE(PG8_SA(1, 0), a3, voffA);
            PG8_WAIT_V(8); PG8_WAIT_L(0); PG8_BAR; PG8_MMA(1, 0, At, B0); PG8_MMA(1, 1, At, B1); PG8_BAR; PG8_SCHED;
            } else {
            PG8_LDB(B0, 0, 0); PG8_SCHED; PG8_LDA(At, 0, 0); PG8_STAGE(PG8_SA(1, 1), a1 + hstep, voffA);
            PG8_WAIT_L(8); PG8_BAR; PG8_WAIT_L(0); PG8_MMA(0, 0, At, B0); PG8_BAR; PG8_SCHED;
            PG8_LDB(B1, 0, 1); PG8_STAGE(PG8_SB(0, 0), b2, voffB);
            PG8_BAR; PG8_WAIT_L(0); PG8_MMA(0, 1, At, B1); PG8_BAR;
            PG8_LDA(At, 0, 1); PG8_STAGE(PG8_SA(0, 0), a2, voffA);
            PG8_BAR; PG8_WAIT_L(0); PG8_MMA(1, 0, At, B0); PG8_BAR; PG8_SCHED;
            PG8_STAGE(PG8_SB(0, 1), b2 + hstep, voffB);
            PG8_WAIT_V(6); PG8_BAR; PG8_MMA(1, 1, At, B1); PG8_BAR;
            PG8_LDB(B0, 1, 0); PG8_SCHED; PG8_LDA(At, 1, 0); PG8_STAGE(PG8_SA(0, 1), a2 + hstep, voffA);
            PG8_WAIT_L(8); PG8_BAR; PG8_WAIT_L(0); PG8_MMA(0, 0, At, B0); PG8_BAR; PG8_SCHED;
            PG8_LDB(B1, 1, 1); PG8_STAGE(PG8_SB(1, 0), b3, voffB);
            PG8_BAR; PG8_WAIT_L(0); PG8_MMA(0, 1, At, B1); PG8_BAR;
            PG8_LDA(At, 1, 1); PG8_STAGE(PG8_SA(1, 0), a3, voffA);
            PG8_BAR; PG8_WAIT_L(0); PG8_MMA(1, 0, At, B0); PG8_BAR; PG8_SCHED;
            PG8_STAGE(PG8_SB(1, 1), b3 + hstep, voffB);
            PG8_WAIT_V(6); PG8_BAR; PG8_MMA(1, 1, At, B1); PG8_BAR;
            }
        }
        if constexpr (ALIGN_EPI) { if (wr == 0) PG8_BAR; }
        if constexpr (!Epi::AFTER_DRAIN) { E(acc, cur, wr, wc, fr, fq); S.done(cur); }
        if (!has_next) break;
#pragma unroll
        for (int a = 0; a < 2; ++a)
#pragma unroll
            for (int b = 0; b < 2; ++b)
#pragma unroll
                for (int m = 0; m < 4; ++m)
#pragma unroll
                    for (int n = 0; n < 2; ++n) acc[a][b][m][n] = (f32x4){0.f, 0.f, 0.f, 0.f};
        cur = nxt; cA = nA; cB = nB; ++ui;
        if constexpr (ALIGN_EPI) { if (wr == 1) PG8_BAR; }
    }
    PG8_WAIT_V(0);
    if constexpr (!ALIGN_EPI) { if (wr == 0) PG8_BAR; }
    PG8_BAR;
#undef PG8_SA
#undef PG8_SB
#undef PG8_STAGE
#undef PG8_LDA
#undef PG8_LDB
#undef PG8_MMA
#undef PG8_WAIT_V
#undef PG8_WAIT_L
#undef PG8_BAR
#undef PG8_SCHED
}
}


#define XB_TMO      128
#define XB_XCNT(j)  (256  + 64 * (j))
#define XB_XSUB(j)  (1280 + 64 * (j))
#define XB_XGEN(j)  (2304 + 64 * (j))
#define XB_TOP      3328
#define XB_TOPGEN   3392
#define XCD_BAR_WORDS 3456
#define XB_SPIN_CAP (1u << 18)
__device__ __forceinline__ unsigned xb_ld(unsigned* p)              { return __hip_atomic_load(p, __ATOMIC_RELAXED, __HIP_MEMORY_SCOPE_AGENT); }
__device__ __forceinline__ unsigned xb_add(unsigned* p, unsigned v) { return __hip_atomic_fetch_add(p, v, __ATOMIC_RELAXED, __HIP_MEMORY_SCOPE_AGENT); }
__device__ __forceinline__ unsigned xb_xcc_id() { return (unsigned)__builtin_amdgcn_s_getreg((3 << 11) | 20) & 0xFu; }
#define XB_SPIN(cond, bar) do { unsigned _sp = 0; while (cond) { __builtin_amdgcn_s_sleep(1); \
    if ((++_sp & 255u) == 0u) { if (xb_ld(&(bar)[XB_TMO])) break; if (_sp > XB_SPIN_CAP) { atomicAdd(&(bar)[XB_TMO], 1u); break; } } } } while (0)
struct XcdBarrier { unsigned* bar; unsigned x; volatile LAS unsigned* st; };
__device__ __forceinline__ XcdBarrier xcd_barrier_post(unsigned* bar, volatile LAS unsigned* st) {
    XcdBarrier b; b.bar = bar; b.x = xb_xcc_id(); b.st = st;
    if (threadIdx.x == 0) st[2] = xb_add(&bar[XB_XCNT(b.x)], 1u);
    return b;
}
__device__ __forceinline__ void xcd_barrier_complete(unsigned* bar, unsigned x, unsigned& nloc, unsigned& nx) {
    const unsigned G = gridDim.x * gridDim.y * gridDim.z;
    unsigned sum, cnt, mine, sp = 0u;
    for (;;) {
        sum = 0u; cnt = 0u; mine = 0u;
#pragma unroll
        for (unsigned j = 0; j < 16; ++j) { const unsigned c = xb_ld(&bar[XB_XCNT(j)]); sum += c; cnt += (c > 0u) ? 1u : 0u; mine = (j == x) ? c : mine; }
        if (sum == G) break;
        __builtin_amdgcn_s_sleep(1);
        if ((++sp & 255u) == 0u) { if (xb_ld(&bar[XB_TMO])) break; if (sp > XB_SPIN_CAP) { atomicAdd(&bar[XB_TMO], 1u); break; } }
    }
    nloc = mine > 0u ? mine : 1u; nx = cnt > 0u ? cnt : 1u;
}
__device__ __forceinline__ void xcd_barrier(const XcdBarrier& b) {
    asm volatile("s_waitcnt vmcnt(0)" ::: "memory");
    __syncthreads();
    if (threadIdx.x == 0) {
        unsigned* bar = b.bar;
        __builtin_amdgcn_s_waitcnt(0);
        unsigned nloc = b.st[0], nx = b.st[1];
        if (nloc == 0u) { xcd_barrier_complete(bar, b.x, nloc, nx); b.st[0] = nloc; b.st[1] = nx; }
        const unsigned old = xb_add(&bar[XB_XSUB(b.x)], 1u);
        const unsigned gen = old / nloc;
        if (old + 1u == (gen + 1u) * nloc) {
            __builtin_amdgcn_fence(__ATOMIC_RELEASE, "agent");
            asm volatile("s_waitcnt vmcnt(0)" ::: "memory");
            const unsigned og = xb_add(&bar[XB_TOP], 1u);
            const unsigned tg = og / nx;
            if (og + 1u == (tg + 1u) * nx) xb_add(&bar[XB_TOPGEN], 1u);
            else XB_SPIN(xb_ld(&bar[XB_TOPGEN]) == tg, bar);
            __builtin_amdgcn_fence(__ATOMIC_ACQUIRE, "agent");
            xb_add(&bar[XB_XGEN(b.x)], 1u);
            asm volatile("s_waitcnt vmcnt(0)" ::: "memory");
        } else {
            XB_SPIN(xb_ld(&bar[XB_XGEN(b.x)]) == gen, bar);
            __builtin_amdgcn_fence(__ATOMIC_ACQUIRE, "agent");
            asm volatile("s_waitcnt vmcnt(0)" ::: "memory");
        }
    }
    __syncthreads();
}

constexpr int DM = 1024, DEPTH = 4, NTOK = 16384, NCTX = 8192;
constexpr int DIN = 4400, DINP = 4608;
constexpr int NSEQ = 40;
constexpr int C_AQ = 0, C_AK = 512, C_AV = 1024, C_AO = 1536, C_BQ = 2048, C_BK = 2304, C_BV = 2560, C_BZ = 2816,
              C_CQ = 3072, C_CK = 3200, C_CV = 3328, C_CZ = 3584, C_CLR = 3840, C_AG = 3872, C_PAD = 3888, C_AZ = 4096;
constexpr int DIN_EARLY = 4096;
__host__ __device__ __forceinline__ int src_col(int n) { return n < 2048 ? n : (n < C_AG ? n + 528 : (n < C_PAD ? n - 1312 : (n < C_AZ ? -1 : n - 2048))); }
constexpr float EPS = 1e-6f;
constexpr size_t O_Y = 0, O_C = 16777216, O_N = O_C + 16777216, O_M = O_N + 131072, O_R = O_M + 1024, O_G = O_R + 4194304, O_END = O_G + 2097152;
constexpr size_t MiB = 1u << 20;
constexpr size_t WS_CTL = 0, CTL_ZERO_BYTES = 512 * 1024;
constexpr size_t WS_MOD = 1 * MiB;
constexpr size_t WS_WIN = 2 * MiB;
constexpr size_t WS_WOUT = 38 * MiB;
constexpr size_t WS_R1 = 46 * MiB;
constexpr size_t WS_PROJ = 78 * MiB;
constexpr size_t WS_AST = 222 * MiB;
constexpr size_t WS_ANM = 286 * MiB;
constexpr size_t WS_BST = 288 * MiB;
constexpr size_t WS_CST = 304 * MiB;
constexpr size_t WS_AG = 320 * MiB;
constexpr size_t WS_CB = 322 * MiB;
constexpr size_t WS_R3 = 338 * MiB;
constexpr size_t WS_SW = 370 * MiB;
constexpr size_t WS_XB = 372 * MiB;
constexpr size_t WS_END = 404 * MiB;
constexpr int CW_QUEUE = 64;
constexpr int CW_BAR = 4096;
constexpr int CW_GQ = 9216;
constexpr int CW_GB = 10240;
constexpr int CW_GA = 12288;
constexpr int CW_GTMO = 11264;

constexpr int LDS_BYTES = 147456;
constexpr int NPHASE = 2 + DEPTH * 4 + 1;
constexpr int CW_SUMSQ = 16384;

typedef float f32x2_ __attribute__((ext_vector_type(2)));
typedef __bf16 bf16v2_ __attribute__((ext_vector_type(2)));
__device__ __forceinline__ unsigned f2bf(float f) { return (unsigned)__builtin_bit_cast(unsigned short, (__bf16)f); }
__device__ __forceinline__ unsigned pk2(float lo, float hi) { const f32x2_ v = {lo, hi}; return __builtin_bit_cast(unsigned, __builtin_convertvector(v, bf16v2_)); }
__device__ __forceinline__ float bf2f(unsigned short b) { return __builtin_bit_cast(float, ((unsigned)b) << 16); }
__device__ __forceinline__ float bflo(unsigned u) { return __builtin_bit_cast(float, u << 16); }
__device__ __forceinline__ float bfhi(unsigned u) { return __builtin_bit_cast(float, u & 0xffff0000u); }
__device__ __forceinline__ float sigmoidf_(float x) { return __builtin_amdgcn_rcpf(1.0f + __expf(-x)); }
__device__ __forceinline__ float siluf_(float x) { return x * sigmoidf_(x); }
__device__ __forceinline__ float logsigmoidf_(float x) { return fminf(x, 0.f) - __logf(1.0f + __expf(-fabsf(x))); }
__device__ __forceinline__ float logsigmoid_acc(float x) { return fminf(x, 0.f) - log1pf(expf(-fabsf(x))); }
__device__ __forceinline__ float ex2(float x) { return __builtin_amdgcn_exp2f(x); }
__device__ __forceinline__ float wave_sum(float v) {
#pragma unroll
    for (int o = 1; o < 64; o <<= 1) v += __shfl_xor(v, o);
    return v;
}
__device__ __forceinline__ bf16x8 mk8(bf16x4 lo, bf16x4 hi) { return __builtin_shufflevector(lo, hi, 0, 1, 2, 3, 4, 5, 6, 7); }
__device__ __forceinline__ bf16x8 pack8(f32x4 a, f32x4 b) { u32x4 w; w.x = pk2(a[0], a[1]); w.y = pk2(a[2], a[3]); w.z = pk2(b[0], b[1]); w.w = pk2(b[2], b[3]); return __builtin_bit_cast(bf16x8, w); }
#define MFMA16(a, b, c) __builtin_amdgcn_mfma_f32_16x16x32_bf16((a), (b), (c), 0, 0, 0)
#define LDS_ISSUED() asm volatile("" ::: "memory")

struct Args { const float* in[20]; float* out; unsigned char* ws; int ph_lo, ph_hi; };

struct Ctx {
    LAS unsigned char* lds; int tid, lane, wave, G, bid;
    const float *x_prompt, *x_sample, *st_C, *st_n, *st_m, *st_ret, *st_gla, *cvec, *c_ctx, *norm_g, *w_ada, *b_ada, *w_in, *gate_b, *ret_logit, *gla_w2, *gla_b2, *hn_g, *w_out, *final_g;
    float* out; unsigned* ctl; float* mod; bf16 *WinT, *WoutT, *R1, *PROJ, *Ast, *Bst, *Cst; float *Anm, *AG, *CB, *SW, *ssq; bf16 *R3, *XB;
    int g_id, g_r, g_typ, g_pm0, g_s0, g_rel;
};

#define FRESH_TID(F) do { int t_ = threadIdx.x; asm volatile("" : "+v"(t_)); (F).tid = t_; (F).lane = t_ & 63; (F).wave = __builtin_amdgcn_readfirstlane(t_ >> 6); } while (0)
__device__ __forceinline__ void seq_info(int s, int& row0, int& L) { if (s < 32) { row0 = s * 256; L = 256; } else { row0 = NCTX + (s - 32) * 1024; L = 1024; } }

__device__ __forceinline__ float col_scale_in(int ns) {
    if (ns >= 512 && ns < 1024) return 0.08838834764831845f;
    if (ns >= 2832 && ns < 3088) return 0.125f;
    if (ns >= 3728 && ns < 3856) return 0.17677669529663687f;
    return 1.0f;
}
__device__ __forceinline__ void p0_transpose_item(const float* W, int ldn, int nvalid, bool scale_in, bf16* WT, LAS float* scr, int kb, int nb, int lane) {
    const int k0 = 64 * kb, n0 = 32 * nb;
    const int nd = n0 + (lane & 31); const int n = scale_in ? src_col(nd) : nd; const float sc = scale_in ? col_scale_in(n) : 1.0f;
    { float wv[32];
#pragma unroll
        for (int i = 0; i < 32; ++i) { const int kk = 2 * i + (lane >> 5); wv[i] = (n >= 0 && n < nvalid) ? __builtin_nontemporal_load(W + (size_t)(k0 + kk) * ldn + n) : 0.f; }
#pragma unroll
        for (int i = 0; i < 32; ++i) { const int kk = 2 * i + (lane >> 5); scr[kk * 33 + (lane & 31)] = wv[i] * sc; } }
    asm volatile("s_waitcnt lgkmcnt(0)" ::: "memory");
    const int c = lane & 7;
#pragma unroll
    for (int j = 0; j < 4; ++j) { const int nn = (lane >> 3) + 8 * j; const LAS float* s = scr + (8 * c) * 33 + nn;
        u32x4 o; o.x = pk2(s[0 * 33], s[1 * 33]); o.y = pk2(s[2 * 33], s[3 * 33]); o.z = pk2(s[4 * 33], s[5 * 33]); o.w = pk2(s[6 * 33], s[7 * 33]);
        *(u32x4*)(WT + (size_t)(n0 + nn) * 1024 + k0 + 8 * c) = o; }
    asm volatile("s_waitcnt lgkmcnt(0)" ::: "memory");
}
__device__ __forceinline__ void p0_prologue(Ctx& F) {
    FRESH_TID(F);
    LAS float* scr = (LAS float*)(F.lds + F.wave * 8448);
    const int gw = F.bid * 8 + F.wave, NGW = F.G * 8;
    constexpr int I_IN = 16 * (DINP / 32), I_OUT = 16 * 32, I_L = I_IN + I_OUT;
    for (int it = gw; it < DEPTH * I_L; it += NGW) {
        const int l = it / I_L; int r = it % I_L;
        if (r < I_IN) p0_transpose_item(F.w_in + (size_t)l * 1024 * DIN, DIN, DIN, true, F.WinT + (size_t)l * DINP * 1024, scr, r / (DINP / 32), r % (DINP / 32), F.lane);
        else { r -= I_IN; p0_transpose_item(F.w_out + (size_t)l * 1024 * 1024, 1024, 1024, false, F.WoutT + (size_t)l * 1024 * 1024, scr, r / 32, r % 32, F.lane); }
    }
    __syncthreads();
    LAS float* sl = (LAS float*)(F.lds + 69632);
    LAS float* red = (LAS float*)(F.lds + 106496);
    bool have_sl = false;
    for (int it = F.bid; it < DEPTH * 96; it += F.G) {
        if (!have_sl) {
            for (int i = F.tid; i < 9 * 1024; i += 512) { const int r = i >> 10, k = i & 1023; const float v = r == 0 ? F.c_ctx[k] : F.cvec[(r - 1) * 1024 + k]; sl[i] = siluf_(v); }
            have_sl = true; __syncthreads();
        }
        const int l = it / 96, e0 = (it % 96) * 32, c = F.tid & 31, kg = F.tid >> 5;
        const float* wp = F.w_ada + ((size_t)l * 1024 + kg * 64) * 3072 + e0 + c;
        float acc[9];
#pragma unroll
        for (int r = 0; r < 9; ++r) acc[r] = 0.f;
#pragma unroll 1
        for (int k0 = 0; k0 < 64; k0 += 16) {
            float wv[16];
#pragma unroll
            for (int k = 0; k < 16; ++k) wv[k] = __builtin_nontemporal_load(wp + (size_t)(k0 + k) * 3072);
#pragma unroll
            for (int k = 0; k < 16; ++k)
#pragma unroll
                for (int r = 0; r < 9; ++r) acc[r] += sl[r * 1024 + kg * 64 + k0 + k] * wv[k];
        }
#pragma unroll
        for (int r = 0; r < 9; ++r) red[(kg * 9 + r) * 32 + c] = acc[r];
        __syncthreads();
        for (int o = F.tid; o < 9 * 32; o += 512) { const int r = o >> 5, cc = o & 31; float sacc = F.b_ada[l * 3072 + e0 + cc];
#pragma unroll
            for (int g = 0; g < 16; ++g) sacc += red[(g * 9 + r) * 32 + cc];
            F.mod[((size_t)l * 9 + r) * 3072 + e0 + cc] = sacc; }
        __syncthreads();
    }
}

__device__ __forceinline__ void p0b_phase(Ctx& F) {
    FRESH_TID(F);
    const int gw = F.bid * 8 + F.wave, NGW = F.G * 8, lane = F.lane;
    for (int m0 = gw; m0 < NTOK; m0 += 4 * NGW) {
        f32x4 v[4][4];
#pragma unroll
        for (int rr = 0; rr < 4; ++rr) { const int m = m0 + rr * NGW;
            const float* xrow = m < NCTX ? F.x_prompt + (size_t)m * 1024 : F.x_sample + (size_t)(m - NCTX) * 1024;
            const f32x4* xr = (const f32x4*)xrow + lane;
#pragma unroll
            for (int j = 0; j < 4; ++j) v[rr][j] = (m < NTOK) ? __builtin_nontemporal_load(xr + 64 * j) : (f32x4){0.f, 0.f, 0.f, 0.f}; }
#pragma unroll
        for (int rr = 0; rr < 4; ++rr) { const int m = m0 + rr * NGW; if (m >= NTOK) break;
            const int mr = m < NCTX ? 0 : 1 + ((m - NCTX) >> 10);
            const float* md = F.mod + (size_t)mr * 3072;
            float sacc = 0.f;
#pragma unroll
            for (int j = 0; j < 4; ++j) sacc += (v[rr][j].x * v[rr][j].x + v[rr][j].y * v[rr][j].y) + (v[rr][j].z * v[rr][j].z + v[rr][j].w * v[rr][j].w);
            sacc = wave_sum(sacc);
            if (lane == 0) F.ssq[m] = sacc;
            unsigned long long* o8 = (unsigned long long*)(F.R3 + (size_t)m * 1024) + lane;
#pragma unroll
            for (int j = 0; j < 4; ++j) { const int c = 4 * lane + 256 * j;
                const f32x4 gg = *(const f32x4*)(F.norm_g + c), sc = *(const f32x4*)(md + 1024 + c);
                const f32x4 a = v[rr][j] * gg * (sc + 1.0f);
                o8[64 * j] = (unsigned long long)pk2(a.x, a.y) | ((unsigned long long)pk2(a.z, a.w) << 32); } }
    }
    const int c = lane & 15, q = lane >> 4;
    for (int t = NGW - 1 - gw; t < DEPTH * (DINP / 16); t += NGW) {
        const int l = t / (DINP / 16), n0 = (t % (DINP / 16)) * 16;
        const bf16* wrow = F.WinT + ((size_t)l * DINP + n0 + c) * 1024 + 8 * q;
        const float* sh = F.mod + ((size_t)l * 9 + (c < 9 ? c : 0)) * 3072 + 8 * q;
        f32x4 acc = (f32x4){0.f, 0.f, 0.f, 0.f};
#pragma unroll 16
        for (int k = 0; k < 32; ++k) {
            const bf16x8 b = *(const bf16x8*)(wrow + 32 * k);
            f32x4 a0 = *(const f32x4*)(sh + 32 * k), a1 = *(const f32x4*)(sh + 32 * k + 4);
            if (c >= 9) { a0 = (f32x4){0.f, 0.f, 0.f, 0.f}; a1 = a0; }
            acc = MFMA16(pack8(a0, a1), b, acc);
        }
#pragma unroll
        for (int r = 0; r < 4; ++r) F.SW[((size_t)l * 16 + 4 * q + r) * DINP + n0 + c] = acc[r];
    }
}
__device__ __forceinline__ void final_phase(Ctx& F) {
    const int gw = F.bid * 8 + F.wave, NGW = F.G * 8;
    for (int m = gw; m < NTOK; m += NGW) {
        f32x4* xr = (f32x4*)(F.out + (size_t)m * 1024) + F.lane;
        const float rstd = __builtin_amdgcn_rsqf(F.ssq[4 * NTOK + m] * (1.f / 1024.f) + EPS);
#pragma unroll
        for (int j = 0; j < 4; ++j) { const f32x4 gg = *(const f32x4*)(F.final_g + 4 * F.lane + 256 * j); xr[64 * j] = xr[64 * j] * rstd * gg; }
    }
}

__device__ __forceinline__ bf16x8 tr_frag(const LAS bf16* base, int RS, int row0, int col0, int c) {
    const LAS bf16* p = base + (row0 + (c >> 2)) * RS + col0 + 4 * (c & 3);
    const bf16x4 lo = __builtin_amdgcn_ds_read_tr16_b64_v4i16((LAS bf16x4*)p);
    const bf16x4 hi = __builtin_amdgcn_ds_read_tr16_b64_v4i16((LAS bf16x4*)(p + 4 * RS));
    return mk8(lo, hi);
}
__device__ __forceinline__ u32x4 scale8(u32x4 v, float g) { u32x4 o;
#pragma unroll
    for (int j = 0; j < 4; ++j) o[j] = pk2(bflo(v[j]) * g, bfhi(v[j]) * g);
    return o; }

constexpr int RSA = 136;
constexpr int A1_TAB = 69632;
__device__ __forceinline__ void mlstm_chain(Ctx& F, int l, int s, int h, int dir) {
    FRESH_TID(F);
    const int tid = F.tid, lane = F.lane, w = F.wave, c = lane & 15, q = lane >> 4;
    int row0, L; seq_info(s, row0, L);
    const int nch = L / 64, e0 = 16 * w, gc0 = row0 >> 6;
    const float bi = F.gate_b[l * 16 + dir * 8 + h], bfg = F.gate_b[l * 16 + dir * 8 + 4 + h];
    LAS float* gt = (LAS float*)(F.lds + A1_TAB);
    u32x4 kr0[2], vr0[2], kr1[2], vr1[2];
#define A1_LOAD(nn, KR, VR) do { \
        _Pragma("unroll") for (int i_ = 0; i_ < 2; ++i_) { const int p_ = tid + 512 * i_, r_ = p_ >> 4, cp_ = (p_ & 15) * 8; \
            const int pos_ = dir ? (L - 1 - (64 * (nn) + r_)) : (64 * (nn) + r_); \
            const bf16* src_ = F.PROJ + (size_t)(row0 + pos_) * DINP + h * 128 + cp_; \
            KR[i_] = *(const u32x4*)(src_ + C_AK); VR[i_] = *(const u32x4*)(src_ + C_AV); } } while (0)
    bf16 gi[2], gf[2];
#pragma unroll
    for (int i = 0; i < 2; ++i) { const int n = (w + 8 * i) & (nch - 1);
        const int posl = dir ? (L - 1 - (64 * n + lane)) : (64 * n + lane);
        const bf16* gp = F.PROJ + (size_t)(row0 + posl) * DINP + C_AG + dir * 8 + h; gi[i] = gp[0]; gf[i] = gp[4]; }
    A1_LOAD(0, kr0, vr0); A1_LOAD(1, kr1, vr1);
    f32x4 st[8], nst; float m_prev;
#define A1_SCANS() do { \
    _Pragma("unroll") for (int i = 0; i < 2; ++i) { const int n = w + 8 * i; \
        if (n < nch) { \
            const int posl = dir ? (L - 1 - (64 * n + lane)) : (64 * n + lane); \
            const float ic = bf2f(gi[i]) + bi, fp = bf2f(gf[i]) + bfg; \
            float Fc = logsigmoidf_(fp); \
            _Pragma("unroll") for (int o = 1; o < 64; o <<= 1) { const float t = __shfl_up(Fc, o); if (lane >= o) Fc += t; } \
            const float u = ic - Fc; \
            float pm = u; \
            _Pragma("unroll") for (int o = 1; o < 64; o <<= 1) { const float t = __shfl_up(pm, o); if (lane >= o) pm = fmaxf(pm, t); } \
            const float F_last = __shfl(Fc, 63), pmL = __shfl(pm, 63); \
            gt[n * 64 + lane] = F_last + u; \
            *(f32x4*)(F.AG + (((size_t)(row0 + posl) * 4 + h) * 2 + dir) * 4) = (f32x4){u, pm, Fc, 0.f}; \
            if (lane == 0) { gt[1024 + n] = F_last; gt[1040 + n] = F_last + pmL; } \
        } } } while (0)
    if (s >= 32) {
        const size_t sb = (((size_t)(s - 32) * DEPTH + l) * 2 + dir) * 4 + h;
        const float* C0 = F.st_C + sb * 16384;
#pragma unroll
        for (int t = 0; t < 8; ++t)
#pragma unroll
            for (int r = 0; r < 4; ++r) st[t][r] = C0[(size_t)(16 * t + 4 * q + r) * 128 + e0 + c];
#pragma unroll
        for (int r = 0; r < 4; ++r) nst[r] = F.st_n[sb * 128 + 16 * w + 4 * q + r];
        m_prev = F.st_m[sb];
        A1_SCANS();
    } else {
#pragma unroll
        for (int t = 0; t < 8; ++t) st[t] = (f32x4){0.f, 0.f, 0.f, 0.f};
        nst = (f32x4){0.f, 0.f, 0.f, 0.f}; m_prev = 0.f;
        A1_SCANS();
    }
#undef A1_SCANS
    const u32x4 ones_u = (u32x4){0x3f803f80u, 0x3f803f80u, 0x3f803f80u, 0x3f803f80u};
    const bf16x8 ones = __builtin_bit_cast(bf16x8, ones_u);
    __syncthreads();
#define A1_STEP(nn, KR, VR, BUF) do { \
        LAS bf16* Kg = (LAS bf16*)(F.lds + (BUF) * 34816); LAS bf16* Vs = Kg + 64 * RSA; \
        const float FLn = gt[1024 + (nn)], GMn = gt[1040 + (nn)]; \
        const float m_new = fmaxf(FLn + m_prev, GMn), a_dec = __expf(FLn + m_prev - m_new); \
        { const int m_ = dir ? nch - 1 - (nn) : (nn); const size_t slot = ((size_t)(gc0 + m_) * 4 + h) * 2 + dir; \
          u32x4* sp = (u32x4*)(F.Ast + slot * 16384) + (w * 4) * 64 + lane; \
          _Pragma("unroll") for (int k = 0; k < 4; ++k) sp[k * 64] = __builtin_bit_cast(u32x4, pack8(st[2 * k], st[2 * k + 1])); \
          if (c == 0) *(f32x4*)(F.Anm + slot * 132 + 16 * w + 4 * q) = nst; \
          if (tid == 0) F.Anm[slot * 132 + 128] = m_prev; } \
        _Pragma("unroll") for (int i = 0; i < 2; ++i) { const int p = tid + 512 * i, r = p >> 4, cp = (p & 15) * 8; \
            const float gr = __expf(gt[(nn) * 64 + r] - m_new); \
            *(LAS u32x4*)(Kg + r * RSA + cp) = scale8(KR[i], gr); *(LAS u32x4*)(Vs + r * RSA + cp) = VR[i]; } \
        if ((nn) + 2 < nch) A1_LOAD((nn) + 2, KR, VR); \
        __syncthreads(); \
        bf16x8 vb[2], nf[2]; \
        _Pragma("unroll") for (int k = 0; k < 2; ++k) { vb[k] = tr_frag(Vs, RSA, 32 * k + 8 * q, e0, c); nf[k] = tr_frag(Kg, RSA, 32 * k + 8 * q, 16 * w, c); } \
        _Pragma("unroll") for (int t0 = 0; t0 < 8; t0 += 4) { bf16x8 af[4][2]; \
            _Pragma("unroll") for (int t = 0; t < 4; ++t) _Pragma("unroll") for (int k = 0; k < 2; ++k) af[t][k] = tr_frag(Kg, RSA, 32 * k + 8 * q, 16 * (t0 + t), c); \
            LDS_ISSUED(); \
            _Pragma("unroll") for (int t = 0; t < 4; ++t) { st[t0 + t] = st[t0 + t] * a_dec; \
                _Pragma("unroll") for (int k = 0; k < 2; ++k) st[t0 + t] = MFMA16(af[t][k], vb[k], st[t0 + t]); } } \
        f32x4 nacc = (f32x4){0.f, 0.f, 0.f, 0.f}; \
        _Pragma("unroll") for (int k = 0; k < 2; ++k) nacc = MFMA16(nf[k], ones, nacc); \
        nst = nst * a_dec + nacc; m_prev = m_new; } while (0)
    for (int n = 0; n < nch; n += 2) { A1_STEP(n, kr0, vr0, 0); A1_STEP(n + 1, kr1, vr1, 1); }
#undef A1_STEP
#undef A1_LOAD
    if (s < 32) {
        const size_t sb = (((size_t)s * DEPTH + l) * 2 + dir) * 4 + h;
        float* Co = F.out + O_C + sb * 16384;
#pragma unroll
        for (int t = 0; t < 8; ++t)
#pragma unroll
            for (int r = 0; r < 4; ++r) __builtin_nontemporal_store(st[t][r], Co + (size_t)(16 * t + 4 * q + r) * 128 + e0 + c);
        if (c == 0) *(f32x4*)(F.out + O_N + sb * 128 + 16 * w + 4 * q) = nst;
        if (tid == 0) F.out[O_M + sb] = m_prev;
    }
    __syncthreads();
}

__device__ __forceinline__ void rot8(float (&a)[8], float (&b)[8], int pos, int cp) {
    const float prow = (float)(pos >> 6), pcol = (float)(pos & 63);
#pragma unroll
    for (int x = 0; x < 8; ++x) { const int f = cp + x;
        const float fr = ex2(-(float)(f & 15) * 0.8304820237218406f);
        const float ang = (f < 16 ? prow : pcol) * fr;
        const float cs = __cosf(ang), sn = __sinf(ang);
        const float t1 = a[x], t2 = b[x]; a[x] = t1 * cs - t2 * sn; b[x] = t1 * sn + t2 * cs; }
}
__device__ __forceinline__ void unpack8(u32x4 v, float (&o)[8]) {
#pragma unroll
    for (int j = 0; j < 4; ++j) { o[2 * j] = bflo(v[j]); o[2 * j + 1] = bfhi(v[j]); } }
__device__ __forceinline__ u32x4 packf8(const float (&a)[8], float g) { u32x4 o; o.x = pk2(a[0] * g, a[1] * g); o.y = pk2(a[2] * g, a[3] * g); o.z = pk2(a[4] * g, a[5] * g); o.w = pk2(a[6] * g, a[7] * g); return o; }

__device__ __forceinline__ void ret_chain(Ctx& F, int l, int s, int h) {
    FRESH_TID(F);
    const int tid = F.tid, lane = F.lane, dir = F.wave >> 2, wl = F.wave & 3, tl = tid & 255, c = lane & 15, q = lane >> 4;
    int row0, L; seq_info(s, row0, L);
    const int nch = L / 64, e0 = 16 * wl, gc0 = row0 >> 6;
    const float lg2 = logsigmoid_acc(F.ret_logit[(l * 2 + dir) * 4 + h]) * 1.4426950408889634f;
    const bool rot = s >= 32;
    f32x4 st[4];
    if (s >= 32) {
        const float* S0 = F.st_ret + ((((size_t)(s - 32) * DEPTH + l) * 2 + dir) * 4 + h) * 4096;
#pragma unroll
        for (int t = 0; t < 4; ++t)
#pragma unroll
            for (int r = 0; r < 4; ++r) st[t][r] = S0[(size_t)(16 * t + 4 * q + r) * 64 + e0 + c];
    } else {
#pragma unroll
        for (int t = 0; t < 4; ++t) st[t] = (f32x4){0.f, 0.f, 0.f, 0.f};
    }
    const float g64 = ex2(64.f * lg2);
    const int r = tl >> 2, cp = (tl & 3) * 8;
    const float gr = ex2((float)(63 - r) * lg2);
    u32x4 ka0, kb0, va0, vb0, ka1, kb1, va1, vb1;
#define B1_LOAD(nn, K1, K2, V1, V2) do { const int pos_ = dir ? (L - 1 - (64 * (nn) + r)) : (64 * (nn) + r); \
        const bf16* src_ = F.PROJ + (size_t)(row0 + pos_) * DINP + h * 64 + cp; \
        K1 = *(const u32x4*)(src_ + C_BK); K2 = *(const u32x4*)(src_ + C_BK + 32); V1 = *(const u32x4*)(src_ + C_BV); V2 = *(const u32x4*)(src_ + C_BV + 32); } while (0)
    B1_LOAD(0, ka0, kb0, va0, vb0); B1_LOAD(1, ka1, kb1, va1, vb1);
#define B1_STEP(nn, K1, K2, V1, V2, BUF) do { \
        LAS bf16* Kg = (LAS bf16*)(F.lds + (dir * 2 + (BUF)) * 18432); LAS bf16* Vs = Kg + 64 * 72; \
        { const int m_ = dir ? nch - 1 - (nn) : (nn); const size_t slot = ((size_t)(gc0 + m_) * 4 + h) * 2 + dir; \
          u32x4* sp = (u32x4*)(F.Bst + slot * 4096) + (wl * 2) * 64 + lane; \
          _Pragma("unroll") for (int k = 0; k < 2; ++k) sp[k * 64] = __builtin_bit_cast(u32x4, pack8(st[2 * k], st[2 * k + 1])); } \
        { float ka[8], kb[8]; unpack8(K1, ka); unpack8(K2, kb); \
          if (rot) { const int pos = dir ? (L - 1 - (64 * (nn) + r)) : (64 * (nn) + r); rot8(ka, kb, pos, cp); } \
          *(LAS u32x4*)(Kg + r * 72 + cp) = packf8(ka, gr); *(LAS u32x4*)(Kg + r * 72 + cp + 32) = packf8(kb, gr); \
          *(LAS u32x4*)(Vs + r * 72 + cp) = V1; *(LAS u32x4*)(Vs + r * 72 + cp + 32) = V2; } \
        if ((nn) + 2 < nch) B1_LOAD((nn) + 2, K1, K2, V1, V2); \
        __syncthreads(); \
        bf16x8 vb[2], af[4][2]; \
        _Pragma("unroll") for (int k = 0; k < 2; ++k) vb[k] = tr_frag(Vs, 72, 32 * k + 8 * q, e0, c); \
        _Pragma("unroll") for (int t = 0; t < 4; ++t) _Pragma("unroll") for (int k = 0; k < 2; ++k) af[t][k] = tr_frag(Kg, 72, 32 * k + 8 * q, 16 * t, c); \
        LDS_ISSUED(); \
        _Pragma("unroll") for (int t = 0; t < 4; ++t) { st[t] = st[t] * g64; \
            _Pragma("unroll") for (int k = 0; k < 2; ++k) st[t] = MFMA16(af[t][k], vb[k], st[t]); } } while (0)
    for (int n = 0; n < nch; n += 2) { B1_STEP(n, ka0, kb0, va0, vb0, 0); B1_STEP(n + 1, ka1, kb1, va1, vb1, 1); }
#undef B1_STEP
#undef B1_LOAD
    if (s < 32) {
        float* So = F.out + O_R + ((((size_t)s * DEPTH + l) * 2 + dir) * 4 + h) * 4096;
#pragma unroll
        for (int t = 0; t < 4; ++t)
#pragma unroll
            for (int rr = 0; rr < 4; ++rr) __builtin_nontemporal_store(st[t][rr], So + (size_t)(16 * t + 4 * q + rr) * 64 + e0 + c);
    }
}

__device__ __forceinline__ void gla_chain(Ctx& F, int l, int s, int h, int dir) {
    FRESH_TID(F);
    const int tid = F.tid, lane = F.lane, hw = F.wave >> 2, wl = F.wave & 3, c = lane & 15, q = lane >> 4;
    int row0, L; seq_info(s, row0, L);
    const int nch = L / 32, nss = nch / 4, e0 = 16 * wl, gc0 = row0 >> 5;
    const int dl = lane & 7, jg = lane >> 3, d = 8 * wl + dl;
    LAS bf16* CL = (LAS bf16*)(F.lds); LAS bf16* KR = CL + 2048; LAS bf16* Ku = CL + 7168; LAS bf16* Vs = CL + 12288; LAS float* dec = (LAS float*)(CL + 21504);
    float w2r[16];
#pragma unroll
    for (int r = 0; r < 16; ++r) w2r[r] = F.gla_w2[(((size_t)l * 2 + dir) * 16 + r) * 128 + h * 32 + d];
    const float b2v = F.gla_b2[((size_t)l * 2 + dir) * 128 + h * 32 + d];
    f32x4 st[2];
    if (s >= 32) {
        const float* S0 = F.st_gla + ((((size_t)(s - 32) * DEPTH + l) * 2 + dir) * 4 + h) * 2048;
#pragma unroll
        for (int t = 0; t < 2; ++t)
#pragma unroll
            for (int r = 0; r < 4; ++r) st[t][r] = S0[(size_t)(16 * t + 4 * q + r) * 64 + e0 + c];
    } else { st[0] = (f32x4){0.f, 0.f, 0.f, 0.f}; st[1] = st[0]; }
    u32x4 pc, pk, pv[2];
#define C1_LOAD(ss) do { \
        if (tid < 256) { const int j_ = tid >> 1; const int pos_ = dir ? (L - 1 - (128 * (ss) + j_)) : (128 * (ss) + j_); \
          pc = *(const u32x4*)(F.PROJ + (size_t)(row0 + pos_) * DINP + C_CLR + dir * 16 + (tid & 1) * 8); } \
        { const int j_ = tid >> 2; const int pos_ = dir ? (L - 1 - (128 * (ss) + j_)) : (128 * (ss) + j_); \
          pk = *(const u32x4*)(F.PROJ + (size_t)(row0 + pos_) * DINP + C_CK + h * 32 + (tid & 3) * 8); } \
        _Pragma("unroll") for (int i_ = 0; i_ < 2; ++i_) { const int p_ = tid + 512 * i_, j_ = p_ >> 3; const int pos_ = dir ? (L - 1 - (128 * (ss) + j_)) : (128 * (ss) + j_); \
          pv[i_] = *(const u32x4*)(F.PROJ + (size_t)(row0 + pos_) * DINP + C_CV + h * 64 + (p_ & 7) * 8); } } while (0)
    C1_LOAD(0);
    for (int ss = 0; ss < nss; ++ss) {
        if (tid < 256) *(LAS u32x4*)(CL + (tid >> 1) * 16 + (tid & 1) * 8) = pc;
        *(LAS u32x4*)(KR + (tid >> 2) * 40 + (tid & 3) * 8) = pk;
#pragma unroll
        for (int i = 0; i < 2; ++i) { const int p = tid + 512 * i; *(LAS u32x4*)(Vs + (p >> 3) * 72 + (p & 7) * 8) = pv[i]; }
        if (ss + 1 < nss) C1_LOAD(ss + 1);
        __syncthreads();
#pragma unroll
        for (int c2 = 0; c2 < 2; ++c2) {
            const int cc = 2 * hw + c2;
            float pb[4], kv[4], run = 0.f;
#pragma unroll
            for (int x = 0; x < 4; ++x) { const int j = 32 * cc + 4 * jg + x;
                const u32x4 c0 = *(const LAS u32x4*)(CL + j * 16), c1 = *(const LAS u32x4*)(CL + j * 16 + 8);
                float xx = b2v;
#pragma unroll
                for (int y = 0; y < 4; ++y) { xx += bflo(c0[y]) * w2r[2 * y] + bfhi(c0[y]) * w2r[2 * y + 1]; xx += bflo(c1[y]) * w2r[8 + 2 * y] + bfhi(c1[y]) * w2r[8 + 2 * y + 1]; }
                run += logsigmoidf_(xx) * 0.0625f; pb[x] = run; kv[x] = bf2f(KR[j * 40 + d]); }
            float tot = run;
#pragma unroll
            for (int o = 8; o < 64; o <<= 1) { const float t = __shfl_up(tot, o); if (lane >= o) tot += t; }
            const float off = tot - run, blast = __shfl(tot, 56 + dl);
#pragma unroll
            for (int x = 0; x < 4; ++x) { const int j = 32 * cc + 4 * jg + x; const float b = off + pb[x];
                Ku[j * 40 + d] = (bf16)f2bf(kv[x] * __expf(blast - b));
                const int pos = dir ? (L - 1 - (128 * ss + j)) : (128 * ss + j);
                F.CB[((size_t)(row0 + pos) * 2 + dir) * 128 + h * 32 + d] = b; }
            if (jg == 0) dec[cc * 32 + d] = __expf(blast);
        }
        __syncthreads();
        if (hw == 0) {
            bf16x8 vb[4], kf[4][2]; f32x4 dv[4][2];
#pragma unroll
            for (int cc = 0; cc < 4; ++cc) { vb[cc] = tr_frag(Vs, 72, 32 * cc + 8 * q, e0, c);
#pragma unroll
                for (int t = 0; t < 2; ++t) { kf[cc][t] = tr_frag(Ku, 40, 32 * cc + 8 * q, 16 * t, c); dv[cc][t] = *(const LAS f32x4*)(dec + cc * 32 + 16 * t + 4 * q); } }
            LDS_ISSUED();
#pragma unroll
            for (int cc = 0; cc < 4; ++cc) {
                const int n = 4 * ss + cc;
                { const int m = dir ? nch - 1 - n : n; const size_t slot = ((size_t)(gc0 + m) * 4 + h) * 2 + dir;
                  u32x4* sp = (u32x4*)(F.Cst + slot * 2048) + wl * 64 + lane; sp[0] = __builtin_bit_cast(u32x4, pack8(st[0], st[1])); }
#pragma unroll
                for (int t = 0; t < 2; ++t) st[t] = MFMA16(kf[cc][t], vb[cc], st[t] * dv[cc][t]);
            }
        }
        __syncthreads();
    }
#undef C1_LOAD
    if (s < 32 && hw == 0) {
        float* So = F.out + O_G + ((((size_t)s * DEPTH + l) * 2 + dir) * 4 + h) * 2048;
#pragma unroll
        for (int t = 0; t < 2; ++t)
#pragma unroll
            for (int r = 0; r < 4; ++r) __builtin_nontemporal_store(st[t][r], So + (size_t)(16 * t + 4 * q + r) * 64 + e0 + c);
    }
}

__device__ __forceinline__ void p1_unit(Ctx& F, int l, int uq) {
    int typ, s, h, dir = 0;
    if (F.g_typ) { s = F.g_s0;
        if (uq < 8) { typ = 0; h = uq >> 1; dir = uq & 1; }
        else if (uq < 16) { const int v = uq - 8; typ = 2; h = v >> 1; dir = v & 1; }
        else { typ = 1; h = uq - 16; } }
    else {
        if (uq < 32) { typ = 0; s = F.g_s0 + (uq >> 3); h = (uq >> 1) & 3; dir = uq & 1; }
        else if (uq < 48) { const int v = uq - 32; typ = 1; s = F.g_s0 + (v >> 2); h = v & 3; }
        else { const int v = uq - 48; typ = 2; s = F.g_s0 + (v >> 3); h = (v >> 1) & 3; dir = v & 1; } }
    if (typ == 0) mlstm_chain(F, l, s, h, dir); else if (typ == 1) ret_chain(F, l, s, h); else gla_chain(F, l, s, h, dir);
}
__device__ __forceinline__ int p1_static(int typ, int r, int idx) {
    if (typ) { if (r >= 8) return idx == 0 ? (r - 8) : (idx == 1 ? 8 + (r - 8) : -1);
               if (r < 4) return idx == 0 ? 16 + r : -1;
               return -1; }
    if (r >= 8) { const int j = r - 8; if (idx < 3) return 3 * j + idx; if (idx == 3) return 32 + j; return idx < 6 ? 48 + 2 * j + (idx - 4) : -1; }
    if (idx == 0) return 24 + r; if (idx == 1) return 40 + r; return idx < 4 ? 64 + 2 * r + (idx - 2) : -1;
}
__device__ __forceinline__ void mixer_pass1(Ctx& F, int l) {
    for (int idx = 0; idx < 6; ++idx) { const int uq = p1_static(F.g_typ, F.g_r, idx); if (uq < 0) break; p1_unit(F, l, uq); __syncthreads(); }
}

constexpr int T2_UF = 0, T2_MXF = 64, T2_UB = 128, T2_MXB = 192, T2_WAF = 256, T2_WAB = 320, T2_EMF = 384, T2_EMB = 448, T2_DPF = 512, T2_DPB = 768, T2_QNF = 1024, T2_QNB = 1088,
              T2_NVF = 1152, T2_NVB = 1280, T2_SSP = 1408;
struct A2R { f32x4 agf, agb; float mpf, mpb, nv; };
struct A2F { u32x4 cff[4], cfb[4]; };
struct A2Q { u32x4 qv[2], kv[2], vv[2]; };
__device__ __forceinline__ void a2_decode(int u, int& s, int& h, int& m) { const int gc = u >> 2; h = u & 3; if (gc < 128) { s = gc >> 2; m = gc & 3; } else { s = 32 + ((gc - 128) >> 4); m = (gc - 128) & 15; } }
__device__ __forceinline__ void a2_loadA(Ctx& F, int l, int u, A2R& R) {
    const int tid = F.tid, lane = F.lane;
    int s, h, m; a2_decode(u, s, h, m);
    int row0, L; seq_info(s, row0, L);
    const int gc = (row0 >> 6) + m, rowb = row0 + 64 * m;
    const size_t slot_f = ((size_t)gc * 4 + h) * 2, slot_b = slot_f + 1;
    R.agf = *(const f32x4*)(F.AG + (((size_t)(rowb + lane) * 4 + h) * 2) * 4); R.agb = *(const f32x4*)(F.AG + (((size_t)(rowb + lane) * 4 + h) * 2 + 1) * 4);
    R.mpf = F.Anm[slot_f * 132 + 128]; R.mpb = F.Anm[slot_b * 132 + 128];
    R.nv = F.Anm[(tid < 128 ? slot_f : slot_b) * 132 + (tid & 127)];
}
__device__ __forceinline__ void a2_loadF(Ctx& F, int u, A2F& R) {
    const int lane = F.lane, w = F.wave;
    int s, h, m; a2_decode(u, s, h, m);
    int row0, L; seq_info(s, row0, L);
    const int gc = (row0 >> 6) + m;
    const size_t slot_f = ((size_t)gc * 4 + h) * 2, slot_b = slot_f + 1;
    const u32x4* pf_ = (const u32x4*)(F.Ast + slot_f * 16384) + (w * 4) * 64 + lane; const u32x4* pb_ = (const u32x4*)(F.Ast + slot_b * 16384) + (w * 4) * 64 + lane;
#pragma unroll
    for (int k = 0; k < 4; ++k) { R.cff[k] = __builtin_nontemporal_load(pf_ + k * 64); R.cfb[k] = __builtin_nontemporal_load(pb_ + k * 64); }
}
__device__ __forceinline__ void a2_loadQ(Ctx& F, int u, A2Q& Q) {
    const int tid = F.tid;
    int s, h, m; a2_decode(u, s, h, m);
    int row0, L; seq_info(s, row0, L);
    const int rowb = row0 + 64 * m;
#pragma unroll
    for (int i = 0; i < 2; ++i) { const int p = tid + 512 * i, r = p >> 4, cp = (p & 15) * 8;
        const bf16* src = F.PROJ + (size_t)(rowb + r) * DINP + h * 128 + cp;
        Q.qv[i] = __builtin_nontemporal_load((const u32x4*)(src + C_AQ)); Q.kv[i] = __builtin_nontemporal_load((const u32x4*)(src + C_AK)); Q.vv[i] = __builtin_nontemporal_load((const u32x4*)(src + C_AV)); }
}
__device__ __forceinline__ void a2_compute(Ctx& F, int l, int u, A2R& R, A2Q& Q, A2F& FR, int u_next, A2R& Rn) {
    const int tid = F.tid, lane = F.lane, w = F.wave, c = lane & 15, q = lane >> 4;
    LAS bf16* Qs = (LAS bf16*)(F.lds); LAS bf16* Ks = (LAS bf16*)(F.lds + 17408); LAS bf16* Vs = (LAS bf16*)(F.lds + 34816);
    LAS bf16* Pf = (LAS bf16*)(F.lds + 52224); LAS bf16* Pb = (LAS bf16*)(F.lds + 61440); LAS float* tab = (LAS float*)(F.lds + 70656);
    int s, h, m; a2_decode(u, s, h, m);
    int row0, L; seq_info(s, row0, L);
    const int e0 = 16 * w, rowb = row0 + 64 * m;
    asm volatile("" :: "v"(R.agf), "v"(R.agb));
#pragma unroll
    for (int i = 0; i < 2; ++i) { const int p = tid + 512 * i, r = p >> 4, cp = (p & 15) * 8;
        *(LAS u32x4*)(Qs + r * RSA + cp) = Q.qv[i]; *(LAS u32x4*)(Ks + r * RSA + cp) = Q.kv[i]; *(LAS u32x4*)(Vs + r * RSA + cp) = Q.vv[i]; }
    if (u_next < 1024) { a2_loadQ(F, u_next, Q); a2_loadA(F, l, u_next, Rn); }
    u32x2 ogv[4], zgv[4];
#pragma unroll
    for (int it = 0; it < 4; ++it) { const bf16* pp_ = F.PROJ + (size_t)(rowb + 16 * it + c) * DINP + h * 128 + e0 + 4 * q; ogv[it] = *(const u32x2*)(pp_ + C_AO); zgv[it] = *(const u32x2*)(pp_ + C_AZ); }
    const f32x4 hg = *(const f32x4*)(F.hn_g + l * 1024 + h * 128 + e0 + 4 * q);
    if (tid < 256) tab[T2_NVF + tid] = R.nv;
    const float mpf = R.mpf, mpb = R.mpb;
    const float uf = R.agf[0], pmf = R.agf[1], Ff = R.agf[2], ub = R.agb[0], pmb = R.agb[1], Fb = R.agb[2];
    const float mxf = fmaxf(mpf, pmf), mxb = fmaxf(mpb, pmb);
    if (w == 0) { tab[T2_UF + lane] = uf; tab[T2_MXF + lane] = mxf; tab[T2_UB + lane] = ub; tab[T2_MXB + lane] = mxb;
        tab[T2_WAF + lane] = __expf(mpf - mxf); tab[T2_WAB + lane] = __expf(mpb - mxb); tab[T2_EMF + lane] = __expf(-(Ff + mxf)); tab[T2_EMB + lane] = __expf(-(Fb + mxb)); }
    __syncthreads();
#pragma unroll
    for (int x = 0; x < 2; ++x) {
        const int tix = w + 8 * x, jt = tix & 3, it = tix >> 2;
        f32x4 acc = (f32x4){0.f, 0.f, 0.f, 0.f};
#pragma unroll
        for (int k = 0; k < 4; ++k) acc = MFMA16(*(const LAS bf16x8*)(Ks + (16 * jt + c) * RSA + 32 * k + 8 * q), *(const LAS bf16x8*)(Qs + (16 * it + c) * RSA + 32 * k + 8 * q), acc);
        const int i = 16 * it + c, j0 = 16 * jt + 4 * q;
        const float mxfi = tab[T2_MXF + i], mxbi = tab[T2_MXB + i];
        const f32x4 ufj = *(const LAS f32x4*)(tab + T2_UF + j0), ubj = *(const LAS f32x4*)(tab + T2_UB + j0);
        float pf[4], pb[4], dsf = 0.f, dsb = 0.f;
#pragma unroll
        for (int r = 0; r < 4; ++r) { pf[r] = (j0 + r <= i) ? acc[r] * __expf(ufj[r] - mxfi) : 0.f; pb[r] = (j0 + r >= i) ? acc[r] * __expf(ubj[r] - mxbi) : 0.f; dsf += pf[r]; dsb += pb[r]; }
        dsf = qsum4(dsf); dsb = qsum4(dsb);
        if (q == 0) { tab[T2_DPF + jt * 64 + i] = dsf; tab[T2_DPB + jt * 64 + i] = dsb; }
        u32x2 pw; pw.x = pk2(pf[0], pf[1]); pw.y = pk2(pf[2], pf[3]); *(LAS u32x2*)(Pf + i * 72 + j0) = pw;
        pw.x = pk2(pb[0], pb[1]); pw.y = pk2(pb[2], pb[3]); *(LAS u32x2*)(Pb + i * 72 + j0) = pw;
    }
    {
        const int i = tid >> 3, d0 = (tid & 7) * 16;
        const u32x4 qa = *(const LAS u32x4*)(Qs + i * RSA + d0), qb = *(const LAS u32x4*)(Qs + i * RSA + d0 + 8);
        float sf = 0.f, sb = 0.f;
#pragma unroll
        for (int j = 0; j < 4; ++j) { const float a0 = bflo(qa[j]), a1 = bfhi(qa[j]), b0 = bflo(qb[j]), b1 = bfhi(qb[j]);
            sf += a0 * tab[T2_NVF + d0 + 2 * j] + a1 * tab[T2_NVF + d0 + 2 * j + 1] + b0 * tab[T2_NVF + d0 + 8 + 2 * j] + b1 * tab[T2_NVF + d0 + 8 + 2 * j + 1];
            sb += a0 * tab[T2_NVB + d0 + 2 * j] + a1 * tab[T2_NVB + d0 + 2 * j + 1] + b0 * tab[T2_NVB + d0 + 8 + 2 * j] + b1 * tab[T2_NVB + d0 + 8 + 2 * j + 1]; }
        sf += __shfl_xor(sf, 1); sf += __shfl_xor(sf, 2); sf += __shfl_xor(sf, 4); sb += __shfl_xor(sb, 1); sb += __shfl_xor(sb, 2); sb += __shfl_xor(sb, 4);
        if ((tid & 7) == 0) { tab[T2_QNF + i] = sf; tab[T2_QNB + i] = sb; }
    }
    __syncthreads();
    bf16x8 vf[2];
#pragma unroll
    for (int k = 0; k < 2; ++k) vf[k] = tr_frag(Vs, RSA, 32 * k + 8 * q, e0, c);
    f32x4 ya[4];
#pragma unroll
    for (int it = 0; it < 4; ++it) {
        const int i = 16 * it + c;
        f32x4 aof = (f32x4){0.f, 0.f, 0.f, 0.f}, aob = aof, aif = aof, aib = aof;
        aof = MFMA16(vf[0], *(const LAS bf16x8*)(Pf + i * 72 + 8 * q), aof);
        if (it >= 2) aof = MFMA16(vf[1], *(const LAS bf16x8*)(Pf + i * 72 + 32 + 8 * q), aof);
        aob = MFMA16(vf[1], *(const LAS bf16x8*)(Pb + i * 72 + 32 + 8 * q), aob);
        if (it < 2) aob = MFMA16(vf[0], *(const LAS bf16x8*)(Pb + i * 72 + 8 * q), aob);
#pragma unroll
        for (int k = 0; k < 4; ++k) {
            const bf16x8 qp = mk8(*(const LAS bf16x4*)(Qs + i * RSA + 32 * k + 4 * q), *(const LAS bf16x4*)(Qs + i * RSA + 32 * k + 16 + 4 * q));
            aif = MFMA16(__builtin_bit_cast(bf16x8, FR.cff[k]), qp, aif); aib = MFMA16(__builtin_bit_cast(bf16x8, FR.cfb[k]), qp, aib); }
        const float waf = tab[T2_WAF + i], wab = tab[T2_WAB + i];
        const float denf = tab[T2_DPF + i] + tab[T2_DPF + 64 + i] + tab[T2_DPF + 128 + i] + tab[T2_DPF + 192 + i] + waf * tab[T2_QNF + i];
        const float denb = tab[T2_DPB + i] + tab[T2_DPB + 64 + i] + tab[T2_DPB + 128 + i] + tab[T2_DPB + 192 + i] + wab * tab[T2_QNB + i];
        const float rdf = __builtin_amdgcn_rcpf(fmaxf(fabsf(denf), tab[T2_EMF + i])), rdb = __builtin_amdgcn_rcpf(fmaxf(fabsf(denb), tab[T2_EMB + i]));
        const f32x4 hv = (aof + aif * waf) * rdf + (aob + aib * wab) * rdb;
        const u32x2 og = ogv[it];
        f32x4 y; y[0] = hv[0] * sigmoidf_(bflo(og.x)); y[1] = hv[1] * sigmoidf_(bfhi(og.x)); y[2] = hv[2] * sigmoidf_(bflo(og.y)); y[3] = hv[3] * sigmoidf_(bfhi(og.y));
        ya[it] = y;
        float ss = (y[0] * y[0] + y[1] * y[1]) + (y[2] * y[2] + y[3] * y[3]);
        ss = qsum4(ss);
        if (q == 0) tab[T2_SSP + w * 64 + i] = ss;
    }
    if (u_next < 1024) a2_loadF(F, u_next, FR);
    __syncthreads();
#pragma unroll
    for (int it = 0; it < 4; ++it) {
        const int i = 16 * it + c;
        float ss = 0.f;
#pragma unroll
        for (int ww = 0; ww < 8; ++ww) ss += tab[T2_SSP + ww * 64 + i];
        const float rs = __builtin_amdgcn_rsqf(ss * (1.f / 128.f) + EPS);
        const u32x2 zg = zgv[it];
        const f32x4 y = ya[it] * rs * hg;
        u32x2 o; o.x = pk2(y[0] * siluf_(bflo(zg.x)), y[1] * siluf_(bfhi(zg.x))); o.y = pk2(y[2] * siluf_(bflo(zg.y)), y[3] * siluf_(bfhi(zg.y)));
        *(u32x2*)(F.R1 + (size_t)(rowb + i) * 1024 + h * 128 + e0 + 4 * q) = o;
    }
}

constexpr int RSB = 264;
__device__ __forceinline__ void ret_out(Ctx& F, int l, int s, int m) {
    FRESH_TID(F);
    const int tid = F.tid, lane = F.lane, w = F.wave, hh = w >> 1, ih = w & 1, c = lane & 15, q = lane >> 4;
    LAS bf16* Qs = (LAS bf16*)(F.lds); LAS bf16* Ks = (LAS bf16*)(F.lds + 33792); LAS bf16* Vs = (LAS bf16*)(F.lds + 67584); LAS bf16* Pw = (LAS bf16*)(F.lds + 101376 + w * 4608);
    int row0, L; seq_info(s, row0, L);
    const int gc = (row0 >> 6) + m, rowb = row0 + 64 * m;
    const bool rot = s >= 32;
    const float lgf = logsigmoid_acc(F.ret_logit[(l * 2 + 0) * 4 + hh]) * 1.4426950408889634f, lgb = logsigmoid_acc(F.ret_logit[(l * 2 + 1) * 4 + hh]) * 1.4426950408889634f;
    const float ginvf = ex2(-lgf), gmulb = ex2(lgb);
    u32x4 cff[4][2], cfb[4][2];
    { const size_t slot_f = ((size_t)gc * 4 + hh) * 2;
      const u32x4* pf_ = (const u32x4*)(F.Bst + slot_f * 4096) + lane; const u32x4* pb_ = (const u32x4*)(F.Bst + (slot_f + 1) * 4096) + lane;
#pragma unroll
      for (int es = 0; es < 4; ++es)
#pragma unroll
          for (int k = 0; k < 2; ++k) { cff[es][k] = __builtin_nontemporal_load(pf_ + (es * 2 + k) * 64); cfb[es][k] = __builtin_nontemporal_load(pb_ + (es * 2 + k) * 64); } }
    u32x2 zgv[2][4]; f32x4 hgv[4];
#pragma unroll
    for (int es = 0; es < 4; ++es) { hgv[es] = *(const f32x4*)(F.hn_g + l * 1024 + 512 + hh * 64 + 16 * es + 4 * q);
#pragma unroll
        for (int itl = 0; itl < 2; ++itl) zgv[itl][es] = *(const u32x2*)(F.PROJ + (size_t)(rowb + 16 * (2 * ih + itl) + c) * DINP + C_BZ + hh * 64 + 16 * es + 4 * q); }
#pragma unroll
    for (int i = 0; i < 2; ++i) {
        const int item = tid + 512 * i, r = item >> 4, hd = (item >> 2) & 3, cp = (item & 3) * 8;
        const bf16* src = F.PROJ + (size_t)(rowb + r) * DINP + hd * 64 + cp;
        float qa[8], qb[8], ka[8], kb[8];
        unpack8(*(const u32x4*)(src + C_BQ), qa); unpack8(*(const u32x4*)(src + C_BQ + 32), qb); unpack8(*(const u32x4*)(src + C_BK), ka); unpack8(*(const u32x4*)(src + C_BK + 32), kb);
        if (rot) { rot8(qa, qb, 64 * m + r, cp); rot8(ka, kb, 64 * m + r, cp); }
        *(LAS u32x4*)(Qs + r * RSB + hd * 64 + cp) = packf8(qa, 1.f); *(LAS u32x4*)(Qs + r * RSB + hd * 64 + cp + 32) = packf8(qb, 1.f);
        *(LAS u32x4*)(Ks + r * RSB + hd * 64 + cp) = packf8(ka, 1.f); *(LAS u32x4*)(Ks + r * RSB + hd * 64 + cp + 32) = packf8(kb, 1.f);
    }
#pragma unroll
    for (int i = 0; i < 4; ++i) { const int p = tid + 512 * i, r = p >> 5, cp = (p & 31) * 8;
        *(LAS u32x4*)(Vs + r * RSB + cp) = __builtin_nontemporal_load((const u32x4*)(F.PROJ + (size_t)(rowb + r) * DINP + C_BV + cp)); }
    __syncthreads();
#pragma unroll
    for (int itl = 0; itl < 2; ++itl)
#pragma unroll
        for (int jt = 0; jt < 4; ++jt) {
            const int it = 2 * ih + itl;
            f32x4 acc = (f32x4){0.f, 0.f, 0.f, 0.f};
#pragma unroll
            for (int k = 0; k < 2; ++k) acc = MFMA16(*(const LAS bf16x8*)(Ks + (16 * jt + c) * RSB + hh * 64 + 32 * k + 8 * q), *(const LAS bf16x8*)(Qs + (16 * it + c) * RSB + hh * 64 + 32 * k + 8 * q), acc);
            const int i = 16 * it + c, j0 = 16 * jt + 4 * q;
            float p[4];
            { float wf = ex2((float)(i - j0) * lgf), wb = ex2((float)(j0 - i) * lgb);
#pragma unroll
              for (int r = 0; r < 4; ++r) { const int j = j0 + r; p[r] = acc[r] * (((j <= i) ? wf : 0.f) + ((j >= i) ? wb : 0.f)); wf *= ginvf; wb *= gmulb; } }
            u32x2 pw; pw.x = pk2(p[0], p[1]); pw.y = pk2(p[2], p[3]);
            *(LAS u32x2*)(Pw + (16 * itl + c) * 72 + j0) = pw;
        }
    __syncthreads();
    bf16x8 vf[4][2];
#pragma unroll
    for (int es = 0; es < 4; ++es)
#pragma unroll
        for (int k = 0; k < 2; ++k) vf[es][k] = tr_frag(Vs, RSB, 32 * k + 8 * q, hh * 64 + 16 * es, c);
#pragma unroll
    for (int itl = 0; itl < 2; ++itl) {
        const int i = 16 * (2 * ih + itl) + c;
        const float wqf = ex2((float)(i + 1) * lgf), wqb = ex2((float)(64 - i) * lgb);
        bf16x8 qp[2], pp[2];
#pragma unroll
        for (int k = 0; k < 2; ++k) { qp[k] = mk8(*(const LAS bf16x4*)(Qs + i * RSB + hh * 64 + 32 * k + 4 * q), *(const LAS bf16x4*)(Qs + i * RSB + hh * 64 + 32 * k + 16 + 4 * q));
            pp[k] = *(const LAS bf16x8*)(Pw + (16 * itl + c) * 72 + 32 * k + 8 * q); }
        f32x4 yb[4]; float ss = 0.f;
#pragma unroll
        for (int es = 0; es < 4; ++es) {
            f32x4 ao = (f32x4){0.f, 0.f, 0.f, 0.f}, af = ao, ab = ao;
#pragma unroll
            for (int k = 0; k < 2; ++k) { ao = MFMA16(vf[es][k], pp[k], ao); af = MFMA16(__builtin_bit_cast(bf16x8, cff[es][k]), qp[k], af); ab = MFMA16(__builtin_bit_cast(bf16x8, cfb[es][k]), qp[k], ab); }
            const f32x4 y = ao + af * wqf + ab * wqb; yb[es] = y;
            ss += (y[0] * y[0] + y[1] * y[1]) + (y[2] * y[2] + y[3] * y[3]);
        }
        ss = qsum4(ss);
        const float rs = __builtin_amdgcn_rsqf(ss * (1.f / 64.f) + EPS);
#pragma unroll
        for (int es = 0; es < 4; ++es) {
            const int col = hh * 64 + 16 * es + 4 * q;
            const u32x2 zg = zgv[itl][es];
            const f32x4 hg = hgv[es];
            const f32x4 y = yb[es] * rs * hg;
            u32x2 o; o.x = pk2(y[0] * siluf_(bflo(zg.x)), y[1] * siluf_(bfhi(zg.x))); o.y = pk2(y[2] * siluf_(bflo(zg.y)), y[3] * siluf_(bfhi(zg.y)));
            *(u32x2*)(F.R1 + (size_t)(rowb + i) * 1024 + 512 + col) = o;
        }
    }
}

__device__ __forceinline__ void gla_out(Ctx& F, int l, int s, int m) {
    FRESH_TID(F);
    const int lane = F.lane, w = F.wave, hh = w >> 1, c32 = w & 1, c = lane & 15, q = lane >> 4;
    LAS bf16* base = (LAS bf16*)(F.lds + w * 17408);
    LAS bf16* Qf = base; LAS bf16* Kf = base + 1280; LAS bf16* Qb = base + 2560; LAS bf16* Kb = base + 3840; LAS bf16* Vs = base + 5120; LAS bf16* Pw = base + 7424;
    int row0, L; seq_info(s, row0, L);
    const int rowc = row0 + 64 * m + 32 * c32, gc32 = (row0 >> 5) + 2 * m + c32;
    u32x4 cff[4], cfb[4];
    { const size_t slot_f = ((size_t)gc32 * 4 + hh) * 2;
      const u32x4* pf_ = (const u32x4*)(F.Cst + slot_f * 2048) + lane; const u32x4* pb_ = (const u32x4*)(F.Cst + (slot_f + 1) * 2048) + lane;
#pragma unroll
      for (int es = 0; es < 4; ++es) { cff[es] = __builtin_nontemporal_load(pf_ + es * 64); cfb[es] = __builtin_nontemporal_load(pb_ + es * 64); } }
    u32x2 zgv[2][4]; f32x4 hgv[4];
#pragma unroll
    for (int es = 0; es < 4; ++es) { hgv[es] = *(const f32x4*)(F.hn_g + l * 1024 + 768 + hh * 64 + 16 * es + 4 * q);
#pragma unroll
        for (int it = 0; it < 2; ++it) zgv[it][es] = *(const u32x2*)(F.PROJ + (size_t)(rowc + 16 * it + c) * DINP + C_CZ + hh * 64 + 16 * es + 4 * q); }
#pragma unroll
    for (int i = 0; i < 4; ++i) { const int p = lane + 64 * i, r = p >> 3, cp = (p & 7) * 8;
        *(LAS u32x4*)(Vs + r * 72 + cp) = __builtin_nontemporal_load((const u32x4*)(F.PROJ + (size_t)(rowc + r) * DINP + C_CV + hh * 64 + cp)); }
    {
        const int p = lane >> 1, d0 = (lane & 1) * 16;
        const size_t row = (size_t)(rowc + p);
        const f32x4* cbf = (const f32x4*)(F.CB + (row * 2 + 0) * 128 + hh * 32 + d0); const f32x4* cbb = (const f32x4*)(F.CB + (row * 2 + 1) * 128 + hh * 32 + d0);
        const bf16* src = F.PROJ + row * DINP + hh * 32 + d0;
        float qv[16], kv[16], bf_[16], bb_[16];
        { float t8[8]; unpack8(*(const u32x4*)(src + C_CQ), t8);
#pragma unroll
          for (int j = 0; j < 8; ++j) qv[j] = t8[j];
          unpack8(*(const u32x4*)(src + C_CQ + 8), t8);
#pragma unroll
          for (int j = 0; j < 8; ++j) qv[8 + j] = t8[j];
          unpack8(*(const u32x4*)(src + C_CK), t8);
#pragma unroll
          for (int j = 0; j < 8; ++j) kv[j] = t8[j];
          unpack8(*(const u32x4*)(src + C_CK + 8), t8);
#pragma unroll
          for (int j = 0; j < 8; ++j) kv[8 + j] = t8[j]; }
#pragma unroll
        for (int j = 0; j < 4; ++j) { const f32x4 a = cbf[j], b = cbb[j];
#pragma unroll
            for (int r = 0; r < 4; ++r) { bf_[4 * j + r] = a[r]; bb_[4 * j + r] = b[r]; } }
#pragma unroll
        for (int hp = 0; hp < 2; ++hp) {
            u32x4 o;
#pragma unroll
            for (int j = 0; j < 4; ++j) o[j] = pk2(qv[8 * hp + 2 * j] * __expf(bf_[8 * hp + 2 * j]), qv[8 * hp + 2 * j + 1] * __expf(bf_[8 * hp + 2 * j + 1]));
            *(LAS u32x4*)(Qf + p * 40 + d0 + 8 * hp) = o;
#pragma unroll
            for (int j = 0; j < 4; ++j) o[j] = pk2(kv[8 * hp + 2 * j] * __expf(-bf_[8 * hp + 2 * j]), kv[8 * hp + 2 * j + 1] * __expf(-bf_[8 * hp + 2 * j + 1]));
            *(LAS u32x4*)(Kf + p * 40 + d0 + 8 * hp) = o;
#pragma unroll
            for (int j = 0; j < 4; ++j) o[j] = pk2(qv[8 * hp + 2 * j] * __expf(bb_[8 * hp + 2 * j]), qv[8 * hp + 2 * j + 1] * __expf(bb_[8 * hp + 2 * j + 1]));
            *(LAS u32x4*)(Qb + p * 40 + d0 + 8 * hp) = o;
#pragma unroll
            for (int j = 0; j < 4; ++j) o[j] = pk2(kv[8 * hp + 2 * j] * __expf(-bb_[8 * hp + 2 * j]), kv[8 * hp + 2 * j + 1] * __expf(-bb_[8 * hp + 2 * j + 1]));
            *(LAS u32x4*)(Kb + p * 40 + d0 + 8 * hp) = o;
        }
    }
    __syncthreads();
#pragma unroll
    for (int it = 0; it < 2; ++it)
#pragma unroll
        for (int jt = 0; jt < 2; ++jt) {
            const f32x4 z = (f32x4){0.f, 0.f, 0.f, 0.f};
            const f32x4 af = MFMA16(*(const LAS bf16x8*)(Kf + (16 * jt + c) * 40 + 8 * q), *(const LAS bf16x8*)(Qf + (16 * it + c) * 40 + 8 * q), z);
            const f32x4 ab = MFMA16(*(const LAS bf16x8*)(Kb + (16 * jt + c) * 40 + 8 * q), *(const LAS bf16x8*)(Qb + (16 * it + c) * 40 + 8 * q), z);
            const int i = 16 * it + c, j0 = 16 * jt + 4 * q;
            float p[4];
#pragma unroll
            for (int r = 0; r < 4; ++r) p[r] = ((j0 + r <= i) ? af[r] : 0.f) + ((j0 + r >= i) ? ab[r] : 0.f);
            u32x2 pw; pw.x = pk2(p[0], p[1]); pw.y = pk2(p[2], p[3]);
            *(LAS u32x2*)(Pw + i * 40 + j0) = pw;
        }
    __syncthreads();
    bf16x8 vf[4];
#pragma unroll
    for (int es = 0; es < 4; ++es) vf[es] = tr_frag(Vs, 72, 8 * q, 16 * es, c);
#pragma unroll
    for (int it = 0; it < 2; ++it) {
        const int i = 16 * it + c;
        const bf16x8 pp = *(const LAS bf16x8*)(Pw + i * 40 + 8 * q);
        const bf16x8 qpf = mk8(*(const LAS bf16x4*)(Qf + i * 40 + 4 * q), *(const LAS bf16x4*)(Qf + i * 40 + 16 + 4 * q));
        const bf16x8 qpb = mk8(*(const LAS bf16x4*)(Qb + i * 40 + 4 * q), *(const LAS bf16x4*)(Qb + i * 40 + 16 + 4 * q));
        f32x4 yc[4]; float ss = 0.f;
#pragma unroll
        for (int es = 0; es < 4; ++es) {
            f32x4 ao = (f32x4){0.f, 0.f, 0.f, 0.f};
            ao = MFMA16(vf[es], pp, ao); ao = MFMA16(__builtin_bit_cast(bf16x8, cff[es]), qpf, ao); ao = MFMA16(__builtin_bit_cast(bf16x8, cfb[es]), qpb, ao);
            yc[es] = ao; ss += (ao[0] * ao[0] + ao[1] * ao[1]) + (ao[2] * ao[2] + ao[3] * ao[3]);
        }
        ss = qsum4(ss);
        const float rs = __builtin_amdgcn_rsqf(ss * (1.f / 64.f) + EPS);
#pragma unroll
        for (int es = 0; es < 4; ++es) {
            const int col = hh * 64 + 16 * es + 4 * q;
            const u32x2 zg = zgv[it][es];
            const f32x4 hg = hgv[es];
            const f32x4 y = yc[es] * rs * hg;
            u32x2 o; o.x = pk2(y[0] * siluf_(bflo(zg.x)), y[1] * siluf_(bfhi(zg.x))); o.y = pk2(y[2] * siluf_(bflo(zg.y)), y[3] * siluf_(bfhi(zg.y)));
            *(u32x2*)(F.R1 + (size_t)(rowc + i) * 1024 + 768 + col) = o;
        }
    }
}

__device__ __forceinline__ void mixer_pass2(Ctx& F, int l) {
    FRESH_TID(F);
    const int gc0 = F.g_pm0 * 4, ub = gc0 * 4;
    {
        A2R R, Rn; A2Q Q; A2F FR;
        const int u0 = ub + F.g_r;
        a2_loadA(F, l, u0, R); a2_loadQ(F, u0, Q); a2_loadF(F, u0, FR);
#pragma unroll 1
        for (int k = 0; k < 4; ++k) {
            a2_compute(F, l, u0 + 16 * k, R, Q, FR, k < 3 ? u0 + 16 * (k + 1) : 2000, Rn);
            R = Rn;
        }
    }
    __syncthreads();
    { const int gc = gc0 + F.g_r;
      int s, m; if (gc < 128) { s = gc >> 2; m = gc & 3; } else { s = 32 + ((gc - 128) >> 4); m = (gc - 128) & 15; }
      ret_out(F, l, s, m);
      __syncthreads();
      gla_out(F, l, s, m);
      __syncthreads(); }
}

__device__ __forceinline__ void group_barrier(Ctx& F, unsigned& epoch) {
    asm volatile("s_waitcnt vmcnt(0)" ::: "memory");
    __syncthreads();
    ++epoch;
    if (threadIdx.x == 0) {
        unsigned* cnt = F.ctl + CW_GB + 64 * F.g_id; unsigned* tmo = F.ctl + CW_GTMO;
        if (F.g_rel) {
            __builtin_amdgcn_fence(__ATOMIC_RELEASE, "agent");
            asm volatile("s_waitcnt vmcnt(0)" ::: "memory"); }
        (void)__hip_atomic_fetch_add(cnt, 1u, __ATOMIC_RELAXED, __HIP_MEMORY_SCOPE_AGENT);
        const unsigned target = epoch * 16u; unsigned sp = 0;
        while (__hip_atomic_load(cnt, __ATOMIC_RELAXED, __HIP_MEMORY_SCOPE_AGENT) < target) {
            __builtin_amdgcn_s_sleep(1);
            if ((++sp & 255u) == 0u) { if (__hip_atomic_load(tmo, __ATOMIC_RELAXED, __HIP_MEMORY_SCOPE_AGENT)) break; if (sp > (1u << 20)) { atomicAdd(tmo, 1u); break; } }
        }
        __builtin_amdgcn_fence(__ATOMIC_ACQUIRE, "agent");
        asm volatile("s_waitcnt vmcnt(0)" ::: "memory");
    }
    __syncthreads();
}
__device__ __forceinline__ void final_group(Ctx& F) {
    FRESH_TID(F);
    const int gw = F.g_r * 8 + F.wave;
    for (int mm = gw; mm < 1024; mm += 128) {
        const int m = F.g_pm0 * 256 + mm;
        const float rstd = __builtin_amdgcn_rsqf(F.ssq[4 * NTOK + m] * (1.f / 1024.f) + EPS);
        const u32x4* xr = (const u32x4*)(F.XB + (size_t)m * 1024) + F.lane;
        f32x4* orow = (f32x4*)(F.out + (size_t)m * 1024);
#pragma unroll
        for (int j = 0; j < 2; ++j) { const u32x4 xb = __builtin_nontemporal_load(xr + 64 * j); const int c0 = 8 * F.lane + 512 * j;
            const f32x4 g0 = *(const f32x4*)(F.final_g + c0), g1 = *(const f32x4*)(F.final_g + c0 + 4);
            const f32x4 x0 = (f32x4){bflo(xb.x), bfhi(xb.x), bflo(xb.y), bfhi(xb.y)}, x1 = (f32x4){bflo(xb.z), bfhi(xb.z), bflo(xb.w), bfhi(xb.w)};
            __builtin_nontemporal_store(x0 * rstd * g0, orow + (c0 >> 2)); __builtin_nontemporal_store(x1 * rstd * g1, orow + (c0 >> 2) + 1); }
    }
}

__global__ void __launch_bounds__(512, 2) fwd_kernel(Args args) {
    extern __shared__ __attribute__((aligned(16))) unsigned char lds_raw[];
    Ctx F;
    F.lds = (LAS unsigned char*)lds_raw;
    F.tid = threadIdx.x; F.lane = F.tid & 63; F.wave = __builtin_amdgcn_readfirstlane(F.tid >> 6); F.G = gridDim.x; F.bid = blockIdx.x;
    F.x_prompt = args.in[0]; F.x_sample = args.in[1]; F.st_C = args.in[2]; F.st_n = args.in[3]; F.st_m = args.in[4]; F.st_ret = args.in[5]; F.st_gla = args.in[6];
    F.cvec = args.in[7]; F.c_ctx = args.in[8]; F.norm_g = args.in[9]; F.w_ada = args.in[10]; F.b_ada = args.in[11]; F.w_in = args.in[12]; F.gate_b = args.in[13];
    F.ret_logit = args.in[14]; F.gla_w2 = args.in[15]; F.gla_b2 = args.in[16]; F.hn_g = args.in[17]; F.w_out = args.in[18]; F.final_g = args.in[19];
    F.out = args.out; unsigned char* ws = args.ws;
    F.ctl = (unsigned*)(ws + WS_CTL); F.mod = (float*)(ws + WS_MOD); F.WinT = (bf16*)(ws + WS_WIN); F.WoutT = (bf16*)(ws + WS_WOUT);
    F.R1 = (bf16*)(ws + WS_R1); F.PROJ = (bf16*)(ws + WS_PROJ); F.Ast = (bf16*)(ws + WS_AST); F.Bst = (bf16*)(ws + WS_BST); F.Cst = (bf16*)(ws + WS_CST); F.Anm = (float*)(ws + WS_ANM); F.AG = (float*)(ws + WS_AG); F.CB = (float*)(ws + WS_CB); F.SW = (float*)(ws + WS_SW); F.R3 = (bf16*)(ws + WS_R3); F.XB = (bf16*)(ws + WS_XB); F.ssq = (float*)(F.ctl + CW_SUMSQ);
    if (F.tid < 8) ((LAS unsigned*)(F.lds + LDS_BYTES - 32))[F.tid] = 0u;
    __syncthreads();
    const XcdBarrier xbar = xcd_barrier_post(F.ctl + CW_BAR, (volatile LAS unsigned*)(F.lds + LDS_BYTES - 32));
    p0_prologue(F);
    xcd_barrier(xbar);
    {
        bool uniform = true;
#pragma unroll
        for (unsigned j = 0; j < 16; ++j) { const unsigned cj = xb_ld(&xbar.bar[XB_XCNT(j)]); uniform = uniform && (cj == (j < 8 ? 32u : 0u)); }
        const unsigned myrank = (unsigned)__builtin_amdgcn_readfirstlane((int)((volatile LAS unsigned*)(F.lds + LDS_BYTES - 32))[2]);
        uniform = uniform && (xbar.x < 8u) && (myrank < 32u);
        const int x = uniform ? (int)xbar.x : (F.bid & 7), i = uniform ? (int)myrank : (F.bid >> 3);
        F.g_rel = uniform ? 0 : 1;
        const int xi = __builtin_amdgcn_readfirstlane(x), ii = __builtin_amdgcn_readfirstlane(i);
        F.g_typ = ii >> 4; F.g_r = ii & 15; F.g_id = F.g_typ * 8 + xi; F.g_pm0 = F.g_typ ? 32 + 4 * xi : 4 * xi; F.g_s0 = F.g_typ ? 32 + xi : 4 * xi;
    }
    p0b_phase(F);
    xcd_barrier(xbar);
    unsigned gbe = 0;
    for (int l = 0; l < DEPTH; ++l) {
        {
            pg8::Gemm g{F.R3, F.WinT + (size_t)l * DINP * 1024, NTOK, DIN_EARLY, 1024}; pg8::StaticOrder S; S.init(NTOK, DIN_EARLY, F.G, F.bid);
            S.grp_w = 16; S.grp_r = F.g_r; S.grp_pm0 = F.g_pm0; S.grp_units = 64;
            if (F.g_r < 8) S.late_pn = (DIN_EARLY / 256) + (F.g_r >> 2);
            S.arrive = F.ctl + CW_GA + 64 * F.g_id; S.arrive_pn = 12 + (F.g_r >> 2); S.arrive_rel = F.g_rel;
            pg8::EpiBf16 E{F.PROJ, DINP, F.ssq + (size_t)l * NTOK, F.SW + (size_t)l * 16 * DINP};
            pg8::gemm_phase<pg8::EpiBf16, pg8::StaticOrder, true, true>(F.lds, g, S, E);
        }
        {
            __syncthreads();
            if (threadIdx.x == 0) {
                unsigned* cnt = F.ctl + CW_GA + 64 * F.g_id; unsigned* tmo = F.ctl + CW_GTMO;
                const unsigned target = 128u * (unsigned)(l + 1); unsigned sp = 0;
                while (__hip_atomic_load(cnt, __ATOMIC_RELAXED, __HIP_MEMORY_SCOPE_AGENT) < target) {
                    __builtin_amdgcn_s_sleep(1);
                    if ((++sp & 255u) == 0u) { if (__hip_atomic_load(tmo, __ATOMIC_RELAXED, __HIP_MEMORY_SCOPE_AGENT)) break; if (sp > (1u << 20)) { atomicAdd(tmo, 1u); break; } }
                }
                __builtin_amdgcn_fence(__ATOMIC_ACQUIRE, "agent");
                asm volatile("s_waitcnt vmcnt(0)" ::: "memory");
            }
            __syncthreads();
        }
        mixer_pass1(F, l);
        group_barrier(F, gbe);
        mixer_pass2(F, l);
        group_barrier(F, gbe);
        {
            pg8::Gemm g{F.R1, F.WoutT + (size_t)l * 1024 * 1024, NTOK, 1024, 1024}; pg8::StaticOrder S; S.init(NTOK, 1024, F.G, F.bid);
            S.grp_w = 16; S.grp_r = F.g_r; S.grp_pm0 = F.g_pm0; S.grp_units = 16;
            const bool lastl = (l == DEPTH - 1);
            pg8::EpiResid E{F.x_prompt, F.x_sample, l == 0 ? nullptr : F.XB, F.out, F.XB, F.mod + (size_t)l * 9 * 3072 + 2048,
                            lastl ? nullptr : F.norm_g + (l + 1) * 1024, lastl ? nullptr : F.mod + (size_t)(l + 1) * 9 * 3072 + 1024, F.R3, F.ssq + (size_t)(l + 1) * NTOK};
            pg8::gemm_phase<pg8::EpiResid, pg8::StaticOrder, true, true>(F.lds, g, S, E);
        }
        group_barrier(F, gbe);
    }
    final_group(F);
}

extern "C" void kernel_launch(void* const* d_in, const int* in_sizes, int n_in, void* d_out, int out_size, void* d_ws, size_t ws_size, hipStream_t stream) {
    static int grid = 0;
    if (grid == 0) {
        if (n_in != 20 || out_size != (int)O_END || ws_size < WS_END) { fprintf(stderr, "kernel_launch: unexpected shapes: n_in %d out %d ws %zu\n", n_in, out_size, ws_size); grid = -1; return; }
        int dev = 0, cus = 0, per_cu = 0;
        if (hipGetDevice(&dev) != hipSuccess || hipDeviceGetAttribute(&cus, hipDeviceAttributeMultiprocessorCount, dev) != hipSuccess) { grid = -1; return; }
        if (hipFuncSetAttribute((const void*)fwd_kernel, hipFuncAttributeMaxDynamicSharedMemorySize, LDS_BYTES) != hipSuccess) { fprintf(stderr, "kernel_launch: hipFuncSetAttribute failed\n"); grid = -1; return; }
        if (hipOccupancyMaxActiveBlocksPerMultiprocessor(&per_cu, (const void*)fwd_kernel, 512, LDS_BYTES) != hipSuccess || per_cu < 1) { fprintf(stderr, "kernel_launch: occupancy query says %d blocks per CU\n", per_cu); per_cu = 1; }
        (void)hipGetLastError();
        grid = cus;
        if (grid != 256) { fprintf(stderr, "kernel_launch: this kernel is built for a 256-CU device (16 groups of 16 workgroups); found %d CUs\n", cus); grid = -1; return; }
    }
    if (grid < 0) return;
    (void)hipMemsetAsync((char*)d_ws + WS_CTL, 0, CTL_ZERO_BYTES, stream);
    Args a{};
    for (int i = 0; i < 20; ++i) a.in[i] = (const float*)d_in[i];
    a.out = (float*)d_out; a.ws = (unsigned char*)d_ws;
    a.ph_lo = 0; a.ph_hi = NPHASE;
    void* kargs[] = {&a};
    hipError_t e = hipLaunchCooperativeKernel((const void*)fwd_kernel, dim3(grid), dim3(512), kargs, LDS_BYTES, stream);
    if (e != hipSuccess) fprintf(stderr, "kernel_launch: cooperative launch failed: %s (grid %d)\n", hipGetErrorString(e), grid);
}
```

```cpp
#include <hip/hip_runtime.h>
#include <hip/hip_cooperative_groups.h>
#include <cstdio>
#include <cstdint>
namespace cg = cooperative_groups;

#define TM_XA 0
#define TM_XB 1
#define TM_YA 0
#define TM_YB 1
#define TM_UNIT1 0
#define TM_UNIT2 0
#ifndef USE_CG_SYNC
#define USE_CG_SYNC 0
#endif
#ifndef N_LAUNCH_MODE
#define N_LAUNCH_MODE 1
#endif

#define LAS __attribute__((address_space(3)))
typedef unsigned short bf16;
typedef short bf16x8 __attribute__((ext_vector_type(8)));
typedef short bf16x4 __attribute__((ext_vector_type(4)));
typedef float f32x4 __attribute__((ext_vector_type(4)));
typedef unsigned u32x4 __attribute__((ext_vector_type(4)));
typedef unsigned u32x2 __attribute__((ext_vector_type(2)));

__device__ __forceinline__ float qsum4(float v) {
    unsigned u = __builtin_bit_cast(unsigned, v);
    auto r = __builtin_amdgcn_permlane16_swap(u, u, false, false);
    v = __builtin_bit_cast(float, (unsigned)r[0]) + __builtin_bit_cast(float, (unsigned)r[1]);
    u = __builtin_bit_cast(unsigned, v);
    auto r2 = __builtin_amdgcn_permlane32_swap(u, u, false, false);
    return __builtin_bit_cast(float, (unsigned)r2[0]) + __builtin_bit_cast(float, (unsigned)r2[1]);
}
namespace pg8 {
#define PG8_LAS __attribute__((address_space(3)))
typedef unsigned short bf16_t;
constexpr int BM = 256, BK = 64, HALF = 128, HTB = HALF * BK * 2, STAGE_BYTES = 8 * HTB, NXCD = 8, WGM = 8;

__host__ __device__ __forceinline__ int lds_byte(int r, int c) { const int st = (r >> 4) * 2 + (c >> 5), rr = r & 15, cc = c & 31, ob = rr * 64 + cc * 2; return st * 1024 + (ob ^ (((ob >> 9) & 1) << 5)); }
__host__ __device__ __forceinline__ void stage_rc(int b, int& R, int& C) { const int st = b / 1024, sb = b % 1024, swz = sb ^ (((sb >> 9) & 1) << 5); R = (st >> 1) * 16 + swz / 64; C = (st & 1) * 32 + (swz % 64) / 2; }
__host__ __device__ __forceinline__ int perm32(int rho) { const int n = rho >> 4, i = rho & 15; return 8 * (i >> 2) + 4 * n + (i & 3); }

struct Unit { int pm, pn; };
struct Gemm { const bf16_t* A; const bf16_t* Bt; int M, N, K; };

struct StaticOrder {
    int nM, nN, nwg, G, c, one_pm, one_pn;
    int grp_w, grp_r, grp_pm0, grp_units;
    int late_pn;
    unsigned* arrive; int arrive_pn, arrive_rel;
    __host__ __device__ void init(int M, int N, int G_, int c_) { nM = M / BM; nN = N / BM; nwg = nM * nN; G = G_; c = c_; one_pm = -1; one_pn = 0; grp_w = 0; grp_r = 0; grp_pm0 = 0; grp_units = 0;
        late_pn = -1; arrive = nullptr; arrive_pn = -1; arrive_rel = 0; }
    __host__ __device__ bool next(int i, Unit& u) const {
        if (one_pm >= 0) { if (i != 0) return false; u.pm = one_pm; u.pn = one_pn; return true; }
        if (grp_w > 0) { const int j = i * grp_w + grp_r;
            if (j >= grp_units) { if (late_pn >= 0 && j < grp_units + grp_w) { u.pm = grp_pm0 + (grp_r & 3); u.pn = late_pn; return true; } return false; }
            u.pm = grp_pm0 + (j & 3); u.pn = j >> 2; return true; }
        const long L = (long)i * G + c; if (L >= nwg) return false;
        int wgid = (int)L; { const int q = nwg / NXCD, r = nwg % NXCD, xcd = wgid % NXCD, off = wgid / NXCD; wgid = (xcd < r ? xcd * (q + 1) : r * (q + 1) + (xcd - r) * q) + off; }
        const int nig = WGM * nN, gid = wgid / nig, fm = gid * WGM, gsz = (nM - fm) < WGM ? (nM - fm) : WGM;
        u.pm = fm + ((wgid % nig) % gsz); u.pn = (wgid % nig) / gsz; return true;
    }
    __device__ __forceinline__ void a_ready(const Unit&) const {}
    __device__ __forceinline__ void done(const Unit& u) const {
        if (arrive != nullptr && u.pn == arrive_pn) {
            asm volatile("s_waitcnt vmcnt(0)" ::: "memory");
            if (arrive_rel) { __builtin_amdgcn_fence(__ATOMIC_RELEASE, "agent"); asm volatile("s_waitcnt vmcnt(0)" ::: "memory"); }
            if ((threadIdx.x & 63) == 0) (void)__hip_atomic_fetch_add(arrive, 1u, __ATOMIC_RELAXED, __HIP_MEMORY_SCOPE_AGENT);
        }
    }
};

__device__ __forceinline__ unsigned cvt_pk_bf16(float lo, float hi) { unsigned r; asm volatile("v_cvt_pk_bf16_f32 %0, %1, %2" : "=v"(r) : "v"(lo), "v"(hi)); return r; }

struct EpiBf16 {
    static constexpr bool PERM = true, AFTER_DRAIN = false;
    bf16_t* O; int ldc; const float* sumsq; const float* sw;
    __device__ __forceinline__ void operator()(const f32x4 (&acc)[2][2][4][2], const Unit& u, int wr, int wc, int fr, int fq) const {
        const int row0 = u.pm * BM + wr * 64 + fr; const int col0 = u.pn * BM + wc * 32 + 8 * fq;
        const int mr = (u.pm < 32) ? 0 : 1 + ((u.pm - 32) >> 2);
        const float* swr = sw + (size_t)mr * ldc + col0;
        f32x4 s0[2], s1[2];
#pragma unroll
        for (int bj = 0; bj < 2; ++bj) { s0[bj] = *(const f32x4*)(swr + bj * HALF); s1[bj] = *(const f32x4*)(swr + bj * HALF + 4); }
        float rsv[2][4];
#pragma unroll
        for (int ai = 0; ai < 2; ++ai)
#pragma unroll
            for (int m = 0; m < 4; ++m) rsv[ai][m] = sumsq[row0 + ai * HALF + m * 16];
#pragma unroll
        for (int ai = 0; ai < 2; ++ai)
#pragma unroll
            for (int m = 0; m < 4; ++m) { const int row = row0 + ai * HALF + m * 16; bf16_t* rowp = O + (size_t)row * ldc + col0;
                const float rs = __builtin_amdgcn_rsqf(rsv[ai][m] * (1.f / 1024.f) + 1e-6f);
#pragma unroll
                for (int bj = 0; bj < 2; ++bj) { const f32x4 v0 = acc[ai][bj][m][0] * rs + s0[bj], v1 = acc[ai][bj][m][1] * rs + s1[bj];
                    u32x4 w; w.x = cvt_pk_bf16(v0[0], v0[1]); w.y = cvt_pk_bf16(v0[2], v0[3]); w.z = cvt_pk_bf16(v1[0], v1[1]); w.w = cvt_pk_bf16(v1[2], v1[3]);
                    *(u32x4*)(rowp + bj * HALF) = w; } }
    }
};
struct EpiResid {
    static constexpr bool PERM = true, AFTER_DRAIN = false;
    const float* xin0; const float* xin1;
    const bf16_t* xinb;
    float* xout; bf16_t* xoutb;
    const float* gate;
    const float* gn; const float* scn; bf16_t* An; float* ssn;
    template <bool XB_IN, bool NEXT>
    __device__ __forceinline__ void run(const f32x4 (&acc)[2][2][4][2], const Unit& u, int wr, int wc, int fr, int fq) const {
        const int row0 = u.pm * BM + wr * 64 + fr, col0 = u.pn * BM + wc * 32 + 8 * fq;
        const int mr = (u.pm < 32) ? 0 : 1 + ((u.pm - 32) >> 2);
        const float* gr = gate + (size_t)mr * 3072 + col0;
        constexpr int D = XB_IN ? 4 : 2;
        u32x4 xb[D][2]; f32x4 xf[D][2][2];
#define ER_LOAD(r_, slot_) do { const int row_ = row0 + ((r_) >> 2) * HALF + ((r_) & 3) * 16; \
            _Pragma("unroll") for (int bj = 0; bj < 2; ++bj) { \
                if constexpr (XB_IN) xb[slot_][bj] = __builtin_nontemporal_load((const u32x4*)(xinb + (size_t)row_ * 1024 + col0 + bj * HALF)); \
                else { const float* xr = (row_ < 8192 ? xin0 + (size_t)row_ * 1024 : xin1 + (size_t)(row_ - 8192) * 1024) + col0 + bj * HALF; \
                       xf[slot_][bj][0] = __builtin_nontemporal_load((const f32x4*)xr); xf[slot_][bj][1] = __builtin_nontemporal_load((const f32x4*)(xr + 4)); } } } while (0)
#pragma unroll
        for (int r = 0; r < D; ++r) ER_LOAD(r, r);
        f32x4 gv[2][2], gs[2][2];
#pragma unroll
        for (int bj = 0; bj < 2; ++bj)
#pragma unroll
            for (int n = 0; n < 2; ++n) { gv[bj][n] = *(const f32x4*)(gr + bj * HALF + n * 4);
                if constexpr (NEXT) { const f32x4 g4 = *(const f32x4*)(gn + col0 + bj * HALF + n * 4), s4 = *(const f32x4*)(scn + (size_t)mr * 3072 + col0 + bj * HALF + n * 4); gs[bj][n] = g4 * (s4 + 1.0f); } }
#pragma unroll
        for (int r = 0; r < 8; ++r) { const int ai = r >> 2, m = r & 3, row = row0 + ai * HALF + m * 16, slot = r % D;
            float ss = 0.f;
#pragma unroll
            for (int bj = 0; bj < 2; ++bj) {
                f32x4 x0, x1;
                if constexpr (XB_IN) { const u32x4 v = xb[slot][bj];
                    x0 = (f32x4){__builtin_bit_cast(float, v.x << 16), __builtin_bit_cast(float, v.x & 0xffff0000u), __builtin_bit_cast(float, v.y << 16), __builtin_bit_cast(float, v.y & 0xffff0000u)};
                    x1 = (f32x4){__builtin_bit_cast(float, v.z << 16), __builtin_bit_cast(float, v.z & 0xffff0000u), __builtin_bit_cast(float, v.w << 16), __builtin_bit_cast(float, v.w & 0xffff0000u)}; }
                else { x0 = xf[slot][bj][0]; x1 = xf[slot][bj][1]; }
                const f32x4 n0 = x0 + gv[bj][0] * acc[ai][bj][m][0], n1 = x1 + gv[bj][1] * acc[ai][bj][m][1];
                { u32x4 w; w.x = cvt_pk_bf16(n0[0], n0[1]); w.y = cvt_pk_bf16(n0[2], n0[3]); w.z = cvt_pk_bf16(n1[0], n1[1]); w.w = cvt_pk_bf16(n1[2], n1[3]);
                  if constexpr (NEXT) __builtin_nontemporal_store(w, (u32x4*)(xoutb + (size_t)row * 1024 + col0 + bj * HALF));
                  else *(u32x4*)(xoutb + (size_t)row * 1024 + col0 + bj * HALF) = w; }
                ss += ((n0[0] * n0[0] + n0[1] * n0[1]) + (n0[2] * n0[2] + n0[3] * n0[3])) + ((n1[0] * n1[0] + n1[1] * n1[1]) + (n1[2] * n1[2] + n1[3] * n1[3]));
                if constexpr (NEXT) { const f32x4 a0 = n0 * gs[bj][0], a1 = n1 * gs[bj][1];
                    u32x4 w; w.x = cvt_pk_bf16(a0[0], a0[1]); w.y = cvt_pk_bf16(a0[2], a0[3]); w.z = cvt_pk_bf16(a1[0], a1[1]); w.w = cvt_pk_bf16(a1[2], a1[3]);
                    *(u32x4*)(An + (size_t)row * 1024 + col0 + bj * HALF) = w; } }
            ss = qsum4(ss);
            if (fq == 0) atomicAdd(ssn + row, ss);
            if (r + D < 8) ER_LOAD(r + D, slot);
        }
#undef ER_LOAD
    }
    __device__ __forceinline__ void operator()(const f32x4 (&acc)[2][2][4][2], const Unit& u, int wr, int wc, int fr, int fq) const {
        if (xinb) { if (gn) run<true, true>(acc, u, wr, wc, fr, fq); else run<true, false>(acc, u, wr, wc, fr, fq); }
        else run<false, true>(acc, u, wr, wc, fr, fq);
    }
};

template <class Epi, class Sched, bool ALIGN_EPI = false, bool SP2 = false>
__device__ __forceinline__ void gemm_phase(PG8_LAS unsigned char* lds, const Gemm g, const Sched& S, const Epi& E) {
    int tid_ = threadIdx.x; asm volatile("" : "+v"(tid_));
    const int tid = tid_, wid = __builtin_amdgcn_readfirstlane(tid >> 6), lane = tid & 63, wr = wid >> 2, wc = wid & 3, fr = lane & 15, fq = lane >> 4;
    const int K = g.K, nt = K / BK;
    unsigned voffA[2], voffB[2];
#pragma unroll
    for (int i = 0; i < 2; ++i) { int R, C; stage_rc(tid * 16 + i * 8192, R, C); const int Rb = Epi::PERM ? ((R & ~31) + perm32(R & 31)) : R;
        voffA[i] = (unsigned)(R * K + C) * 2u; voffB[i] = (unsigned)(Rb * K + C) * 2u; }
    const size_t kstep = (size_t)(BK * 2);
    const size_t hstep = (size_t)HALF * K * 2;
    const size_t tstep = 2 * hstep;
    const unsigned ldsw = (unsigned)wid * 1024u;
    const int aoff = lds_byte(wr * 64 + fr, fq * 8), boff = lds_byte(wc * 32 + fr, fq * 8);
#define PG8_SA(b, h) (((b) * 2 + (h)) * HTB)
#define PG8_SB(b, h) ((4 + (b) * 2 + (h)) * HTB)
#define PG8_STAGE(bufoff, gbase, voff) do { _Pragma("unroll") for (int _i = 0; _i < 2; ++_i) \
        __builtin_amdgcn_global_load_lds((const unsigned*)((const char*)(gbase) + (voff)[_i]), (PG8_LAS unsigned*)(lds + (bufoff) + ldsw + _i * 8192), 16, 0, 0); } while (0)
#define PG8_LDA(dst, b, h) do { _Pragma("unroll") for (int m = 0; m < 4; ++m) _Pragma("unroll") for (int k = 0; k < 2; ++k) dst[m][k] = *(const PG8_LAS bf16x8*)(lds + PG8_SA(b, h) + aoff + m * 2048 + k * 1024); } while (0)
#define PG8_LDB(dst, b, h) do { _Pragma("unroll") for (int n = 0; n < 2; ++n) _Pragma("unroll") for (int k = 0; k < 2; ++k) dst[n][k] = *(const PG8_LAS bf16x8*)(lds + PG8_SB(b, h) + boff + n * 2048 + k * 1024); } while (0)
#define PG8_MMA(ai, bj, At, Bt) do { __builtin_amdgcn_s_setprio(1); _Pragma("unroll") for (int m = 0; m < 4; ++m) _Pragma("unroll") for (int n = 0; n < 2; ++n) _Pragma("unroll") for (int k = 0; k < 2; ++k) \
        acc[ai][bj][m][n] = __builtin_amdgcn_mfma_f32_16x16x32_bf16(Bt[n][k], At[m][k], acc[ai][bj][m][n], 0, 0, 0); __builtin_amdgcn_s_setprio(0); } while (0)
#define PG8_WAIT_V(n) asm volatile("s_waitcnt vmcnt(" #n ")" ::: "memory")
#define PG8_WAIT_L(n) asm volatile("s_waitcnt lgkmcnt(" #n ")" ::: "memory")
#define PG8_BAR __builtin_amdgcn_s_barrier()
#define PG8_SCHED __builtin_amdgcn_sched_barrier(0)
    Unit cur, nxt; int ui = 0;
    if (!S.next(0, cur)) return;
    f32x4 acc[2][2][4][2];
#pragma unroll
    for (int a = 0; a < 2; ++a)
#pragma unroll
        for (int b = 0; b < 2; ++b)
#pragma unroll
            for (int m = 0; m < 4; ++m)
#pragma unroll
                for (int n = 0; n < 2; ++n) acc[a][b][m][n] = (f32x4){0.f, 0.f, 0.f, 0.f};
    bf16x8 At[4][2], B0[2][2], B1[2][2];
    const char* cA = (const char*)g.A + (size_t)cur.pm * tstep; const char* cB = (const char*)g.Bt + (size_t)cur.pn * tstep;
    S.a_ready(cur);
    if constexpr (SP2) {
        PG8_STAGE(PG8_SB(0, 0), cB, voffB); PG8_STAGE(PG8_SB(0, 1), cB + hstep, voffB); PG8_STAGE(PG8_SA(0, 0), cA, voffA); PG8_STAGE(PG8_SA(0, 1), cA + hstep, voffA);
        if (wr == 1) PG8_BAR;
        PG8_WAIT_V(2); PG8_BAR;
        PG8_STAGE(PG8_SB(1, 0), cB + kstep, voffB); PG8_STAGE(PG8_SA(1, 0), cA + kstep, voffA); PG8_STAGE(PG8_SB(1, 1), cB + hstep + kstep, voffB);
        PG8_WAIT_V(6); PG8_BAR;
    } else {
        PG8_STAGE(PG8_SB(0, 0), cB, voffB); PG8_STAGE(PG8_SA(0, 0), cA, voffA); PG8_STAGE(PG8_SB(0, 1), cB + hstep, voffB); PG8_STAGE(PG8_SA(0, 1), cA + hstep, voffA);
        if (wr == 1) PG8_BAR;
        PG8_WAIT_V(4); PG8_BAR;
        PG8_STAGE(PG8_SB(1, 0), cB + kstep, voffB); PG8_STAGE(PG8_SA(1, 0), cA + kstep, voffA); PG8_STAGE(PG8_SB(1, 1), cB + hstep + kstep, voffB);
        PG8_WAIT_V(6); PG8_BAR;
    }
    for (;;) {
        const bool has_next = S.next(ui + 1, nxt);
        const char* nA = has_next ? (const char*)g.A + (size_t)nxt.pm * tstep : cA; const char* nB = has_next ? (const char*)g.Bt + (size_t)nxt.pn * tstep : cB;
        for (int t = 0; t < nt; t += 2) {
            const bool last = (t == nt - 2);
            const char* a1 = cA + (size_t)(t + 1) * kstep;
            const char* a2 = last ? nA : cA + (size_t)(t + 2) * kstep; const char* b2 = last ? nB : cB + (size_t)(t + 2) * kstep;
            const char* a3 = a2 + kstep; const char* b3 = b2 + kstep;
            if (last && has_next) S.a_ready(nxt);
            if constexpr (SP2) {
            PG8_LDB(B0, 0, 0); PG8_LDB(B1, 0, 1); PG8_SCHED; PG8_LDA(At, 0, 0); PG8_STAGE(PG8_SA(1, 1), a1 + hstep, voffA);
            PG8_WAIT_V(8); PG8_WAIT_L(0); PG8_BAR; PG8_MMA(0, 0, At, B0); PG8_MMA(0, 1, At, B1); PG8_BAR; PG8_SCHED;
            PG8_LDA(At, 0, 1); PG8_STAGE(PG8_SB(0, 0), b2, voffB); PG8_STAGE(PG8_SB(0, 1), b2 + hstep, voffB); PG8_STAGE(PG8_SA(0, 0), a2, voffA);
            PG8_WAIT_V(8); PG8_WAIT_L(0); PG8_BAR; PG8_MMA(1, 0, At, B0); PG8_MMA(1, 1, At, B1); PG8_BAR; PG8_SCHED;
            PG8_LDB(B0, 1, 0); PG8_LDB(B1, 1, 1); PG8_SCHED; PG8_LDA(At, 1, 0); PG8_STAGE(PG8_SA(0, 1), a2 + hstep, voffA);
            PG8_WAIT_V(8); PG8_WAIT_L(0); PG8_BAR; PG8_MMA(0, 0, At, B0); PG8_MMA(0, 1, At, B1); PG8_BAR; PG8_SCHED;
            PG8_LDA(At, 1, 1); PG8_STAGE(PG8_SB(1, 0), b3, voffB); PG8_STAGE(PG8_SB(1, 1), b3 + hstep, voffB); PG8_STAGE(PG8_SA(1, 0), a3, voffA);
            PG8_WAIT_V(8); PG8_WAIT_L(0); PG8_BAR; PG8_MMA(1, 0, At, B0); PG8_MMA(1, 1, At, B1); PG8_BAR; PG8_SCHED;
            } else {
            PG8_LDB(B0, 0, 0); PG8_SCHED; PG8_LDA(At, 0, 0); PG8_STAGE(PG8_SA(1, 1), a1 + hstep, voffA);
            PG8_WAIT_L(8); PG8_BAR; PG8_WAIT_L(0); PG8_MMA(0, 0, At, B0); PG8_BAR; PG8_SCHED;
            PG8_LDB(B1, 0, 1); PG8_STAGE(PG8_SB(0, 0), b2, voffB);
            PG8_BAR; PG8_WAIT_L(0); PG8_MMA(0, 1, At, B1); PG8_BAR;
            PG8_LDA(At, 0, 1); PG8_STAGE(PG8_SA(0, 0), a2, voffA);
            PG8_BAR; PG8_WAIT_L(0); PG8_MMA(1, 0, At, B0); PG8_BAR; PG8_SCHED;
            PG8_STAGE(PG8_SB(0, 1), b2 + hstep, voffB);
            PG8_WAIT_V(6); PG8_BAR; PG8_MMA(1, 1, At, B1); PG8_BAR;
            PG8_LDB(B0, 1, 0); PG8_SCHED; PG8_LDA(At, 1, 0); PG8_STAGE(PG8_SA(0, 1), a2 + hstep, voffA);
            PG8_WAIT_L(8); PG8_BAR; PG8_WAIT_L(0); PG8_MMA(0, 0, At, B0); PG8_BAR; PG8_SCHED;
            PG8_LDB(B1, 1, 1); PG8_STAGE(PG8_SB(1, 0), b3, voffB);
            PG8_BAR; PG8_WAIT_L(0); PG8_MMA(0, 1, At, B1); PG8_BAR;
            PG8_LDA(At, 1, 1); PG8_STAGE(PG8_SA(1, 0), a3, voffA);
            PG8_BAR; PG8_WAIT_L(0); PG8_MMA(1, 0, At, B0); PG8_BAR; PG8_SCHED;
            PG8_STAGE(PG8_SB(1, 1), b3 + hstep, voffB);
            PG8_WAIT_V(6); PG8_BAR; PG8_MMA(1, 1, At, B1); PG8_BAR;
            }
        }
        if constexpr (ALIGN_EPI) { if (wr == 0) PG8_BAR; }
        if constexpr (!Epi::AFTER_DRAIN) { E(acc, cur, wr, wc, fr, fq); S.done(cur); }
        if (!has_next) break;
#pragma unroll
        for (int a = 0; a < 2; ++a)
#pragma unroll
            for (int b = 0; b < 2; ++b)
#pragma unroll
                for (int m = 0; m < 4; ++m)
#pragma unroll
                    for (int n = 0; n < 2; ++n) acc[a][b][m][n] = (f32x4){0.f, 0.f, 0.f, 0.f};
        cur = nxt; cA = nA; cB = nB; ++ui;
        if constexpr (ALIGN_EPI) { if (wr == 1) PG8_BAR; }
    }
    PG8_WAIT_V(0);
    if constexpr (!ALIGN_EPI) { if (wr == 0) PG8_BAR; }
    PG8_BAR;
#undef PG8_SA
#undef PG8_SB
#undef PG8_STAGE
#undef PG8_LDA
#undef PG8_LDB
#undef PG8_MMA
#undef PG8_WAIT_V
#undef PG8_WAIT_L
#undef PG8_BAR
#undef PG8_SCHED
}
}


#define XB_TMO      128
#define XB_XCNT(j)  (256  + 64 * (j))
#define XB_XSUB(j)  (1280 + 64 * (j))
#define XB_XGEN(j)  (2304 + 64 * (j))
#define XB_TOP      3328
#define XB_TOPGEN   3392
#define XCD_BAR_WORDS 3456
#define XB_SPIN_CAP (1u << 18)
__device__ __forceinline__ unsigned xb_ld(unsigned* p)              { return __hip_atomic_load(p, __ATOMIC_RELAXED, __HIP_MEMORY_SCOPE_AGENT); }
__device__ __forceinline__ unsigned xb_add(unsigned* p, unsigned v) { return __hip_atomic_fetch_add(p, v, __ATOMIC_RELAXED, __HIP_MEMORY_SCOPE_AGENT); }
__device__ __forceinline__ unsigned xb_xcc_id() { return (unsigned)__builtin_amdgcn_s_getreg((3 << 11) | 20) & 0xFu; }
#define XB_SPIN(cond, bar) do { unsigned _sp = 0; while (cond) { __builtin_amdgcn_s_sleep(1); \
    if ((++_sp & 255u) == 0u) { if (xb_ld(&(bar)[XB_TMO])) break; if (_sp > XB_SPIN_CAP) { atomicAdd(&(bar)[XB_TMO], 1u); break; } } } } while (0)
struct XcdBarrier { unsigned* bar; unsigned x; volatile LAS unsigned* st; };
__device__ __forceinline__ XcdBarrier xcd_barrier_post(unsigned* bar, volatile LAS unsigned* st) {
    XcdBarrier b; b.bar = bar; b.x = xb_xcc_id(); b.st = st;
    if (threadIdx.x == 0) st[2] = xb_add(&bar[XB_XCNT(b.x)], 1u);
    return b;
}
__device__ __forceinline__ void xcd_barrier_complete(unsigned* bar, unsigned x, unsigned& nloc, unsigned& nx) {
    const unsigned G = gridDim.x * gridDim.y * gridDim.z;
    unsigned sum, cnt, mine, sp = 0u;
    for (;;) {
        sum = 0u; cnt = 0u; mine = 0u;
#pragma unroll
        for (unsigned j = 0; j < 16; ++j) { const unsigned c = xb_ld(&bar[XB_XCNT(j)]); sum += c; cnt += (c > 0u) ? 1u : 0u; mine = (j == x) ? c : mine; }
        if (sum == G) break;
        __builtin_amdgcn_s_sleep(1);
        if ((++sp & 255u) == 0u) { if (xb_ld(&bar[XB_TMO])) break; if (sp > XB_SPIN_CAP) { atomicAdd(&bar[XB_TMO], 1u); break; } }
    }
    nloc = mine > 0u ? mine : 1u; nx = cnt > 0u ? cnt : 1u;
}
__device__ __forceinline__ void xcd_barrier(const XcdBarrier& b) {
    asm volatile("s_waitcnt vmcnt(0)" ::: "memory");
    __syncthreads();
    if (threadIdx.x == 0) {
        unsigned* bar = b.bar;
        __builtin_amdgcn_s_waitcnt(0);
        unsigned nloc = b.st[0], nx = b.st[1];
        if (nloc == 0u) { xcd_barrier_complete(bar, b.x, nloc, nx); b.st[0] = nloc; b.st[1] = nx; }
        const unsigned old = xb_add(&bar[XB_XSUB(b.x)], 1u);
        const unsigned gen = old / nloc;
        if (old + 1u == (gen + 1u) * nloc) {
            __builtin_amdgcn_fence(__ATOMIC_RELEASE, "agent");
            asm volatile("s_waitcnt vmcnt(0)" ::: "memory");
            const unsigned og = xb_add(&bar[XB_TOP], 1u);
            const unsigned tg = og / nx;
            if (og + 1u == (tg + 1u) * nx) xb_add(&bar[XB_TOPGEN], 1u);
            else XB_SPIN(xb_ld(&bar[XB_TOPGEN]) == tg, bar);
            __builtin_amdgcn_fence(__ATOMIC_ACQUIRE, "agent");
            xb_add(&bar[XB_XGEN(b.x)], 1u);
            asm volatile("s_waitcnt vmcnt(0)" ::: "memory");
        } else {
            __builtin_amdgcn_fence(__ATOMIC_ACQUIRE, "agent");
            XB_SPIN(xb_ld(&bar[XB_XGEN(b.x)]) == gen, bar);
            asm volatile("s_waitcnt vmcnt(0)" ::: "memory");
        }
    }
    __syncthreads();
}

constexpr int DM = 1024, DEPTH = 4, NTOK = 16384, NCTX = 8192;
constexpr int DIN = 4400, DINP = 4608;
constexpr int NSEQ = 40;
constexpr int C_AQ = 0, C_AK = 512, C_AV = 1024, C_AO = 1536, C_BQ = 2048, C_BK = 2304, C_BV = 2560, C_BZ = 2816,
              C_CQ = 3072, C_CK = 3200, C_CV = 3328, C_CZ = 3584, C_CLR = 3840, C_AG = 3872, C_PAD = 3888, C_AZ = 4096;
constexpr int DIN_EARLY = 4096;
__host__ __device__ __forceinline__ int src_col(int n) { return n < 2048 ? n : (n < C_AG ? n + 528 : (n < C_PAD ? n - 1312 : (n < C_AZ ? -1 : n - 2048))); }
constexpr float EPS = 1e-6f;
constexpr size_t O_Y = 0, O_C = 16777216, O_N = O_C + 16777216, O_M = O_N + 131072, O_R = O_M + 1024, O_G = O_R + 4194304, O_END = O_G + 2097152;
constexpr size_t MiB = 1u << 20;
constexpr size_t WS_CTL = 0, CTL_ZERO_BYTES = 1536 * 1024;
constexpr size_t WS_MOD = 1 * MiB;
constexpr size_t WS_WIN = 2 * MiB;
constexpr size_t WS_WOUT = 38 * MiB;
constexpr size_t WS_R1 = 46 * MiB;
constexpr size_t WS_PROJ = 78 * MiB;
constexpr size_t WS_AST = 222 * MiB;
constexpr size_t WS_ANM = 286 * MiB;
constexpr size_t WS_BST = 288 * MiB;
constexpr size_t WS_CST = 304 * MiB;
constexpr size_t WS_AG = 320 * MiB;
constexpr size_t WS_CB = 322 * MiB;
constexpr size_t WS_R3 = 338 * MiB;
constexpr size_t WS_SW = 370 * MiB;
constexpr size_t WS_XB = 372 * MiB;
constexpr size_t WS_END = 404 * MiB;
constexpr int CW_QUEUE = 64;
constexpr int CW_BAR = 4096;
constexpr int CW_GQ = 9216;
constexpr int CW_GB = 10240;
constexpr int CW_GA = 12288;
constexpr int CW_GTMO = 11264;

constexpr int LDS_BYTES = 147456;
constexpr int NPHASE = 2 + DEPTH * 4 + 1;
constexpr int CW_SUMSQ = 16384;

typedef float f32x2_ __attribute__((ext_vector_type(2)));
typedef __bf16 bf16v2_ __attribute__((ext_vector_type(2)));
__device__ __forceinline__ unsigned f2bf(float f) { return (unsigned)__builtin_bit_cast(unsigned short, (__bf16)f); }
__device__ __forceinline__ unsigned pk2(float lo, float hi) { const f32x2_ v = {lo, hi}; return __builtin_bit_cast(unsigned, __builtin_convertvector(v, bf16v2_)); }
__device__ __forceinline__ float bf2f(unsigned short b) { return __builtin_bit_cast(float, ((unsigned)b) << 16); }
__device__ __forceinline__ float bflo(unsigned u) { return __builtin_bit_cast(float, u << 16); }
__device__ __forceinline__ float bfhi(unsigned u) { return __builtin_bit_cast(float, u & 0xffff0000u); }
__device__ __forceinline__ float sigmoidf_(float x) { return __builtin_amdgcn_rcpf(1.0f + __expf(-x)); }
__device__ __forceinline__ float siluf_(float x) { return x * sigmoidf_(x); }
__device__ __forceinline__ float logsigmoidf_(float x) { return fminf(x, 0.f) - __logf(1.0f + __expf(-fabsf(x))); }
__device__ __forceinline__ float logsigmoid_acc(float x) { return fminf(x, 0.f) - log1pf(expf(-fabsf(x))); }
__device__ __forceinline__ float ex2(float x) { return __builtin_amdgcn_exp2f(x); }
__device__ __forceinline__ float wave_sum(float v) {
#pragma unroll
    for (int o = 1; o < 64; o <<= 1) v += __shfl_xor(v, o);
    return v;
}
__device__ __forceinline__ bf16x8 mk8(bf16x4 lo, bf16x4 hi) { return __builtin_shufflevector(lo, hi, 0, 1, 2, 3, 4, 5, 6, 7); }
__device__ __forceinline__ bf16x8 pack8(f32x4 a, f32x4 b) { u32x4 w; w.x = pk2(a[0], a[1]); w.y = pk2(a[2], a[3]); w.z = pk2(b[0], b[1]); w.w = pk2(b[2], b[3]); return __builtin_bit_cast(bf16x8, w); }
#define MFMA16(a, b, c) __builtin_amdgcn_mfma_f32_16x16x32_bf16((a), (b), (c), 0, 0, 0)
#define LDS_ISSUED() asm volatile("" ::: "memory")

struct Args { const float* in[20]; float* out; unsigned char* ws; int ph_lo, ph_hi; };

struct Ctx {
    LAS unsigned char* lds; int tid, lane, wave, G, bid;
    const float *x_prompt, *x_sample, *st_C, *st_n, *st_m, *st_ret, *st_gla, *cvec, *c_ctx, *norm_g, *w_ada, *b_ada, *w_in, *gate_b, *ret_logit, *gla_w2, *gla_b2, *hn_g, *w_out, *final_g;
    float* out; unsigned* ctl; float* mod; bf16 *WinT, *WoutT, *R1, *PROJ, *Ast, *Bst, *Cst; float *Anm, *AG, *CB, *SW, *ssq; bf16 *R3, *XB;
    int g_id, g_r, g_typ, g_pm0, g_s0, g_rel;
};

#define FRESH_TID(F) do { int t_ = threadIdx.x; asm volatile("" : "+v"(t_)); (F).tid = t_; (F).lane = t_ & 63; (F).wave = __builtin_amdgcn_readfirstlane(t_ >> 6); } while (0)
__device__ __forceinline__ void seq_info(int s, int& row0, int& L) { if (s < 32) { row0 = s * 256; L = 256; } else { row0 = NCTX + (s - 32) * 1024; L = 1024; } }

__device__ __forceinline__ float col_scale_in(int ns) {
    if (ns >= 512 && ns < 1024) return 0.08838834764831845f;
    if (ns >= 2832 && ns < 3088) return 0.125f;
    if (ns >= 3728 && ns < 3856) return 0.17677669529663687f;
    return 1.0f;
}
__device__ __forceinline__ void p0_transpose_item(const float* W, int ldn, int nvalid, bool scale_in, bf16* WT, LAS float* scr, int kb, int nb, int lane) {
    const int k0 = 64 * kb, n0 = 32 * nb;
    const int nd = n0 + (lane & 31); const int n = scale_in ? src_col(nd) : nd; const float sc = scale_in ? col_scale_in(n) : 1.0f;
    { float wv[32];
#pragma unroll
        for (int i = 0; i < 32; ++i) { const int kk = 2 * i + (lane >> 5); wv[i] = (n >= 0 && n < nvalid) ? __builtin_nontemporal_load(W + (size_t)(k0 + kk) * ldn + n) : 0.f; }
#pragma unroll
        for (int i = 0; i < 32; ++i) { const int kk = 2 * i + (lane >> 5); scr[kk * 33 + (lane & 31)] = wv[i] * sc; } }
    asm volatile("s_waitcnt lgkmcnt(0)" ::: "memory");
    const int c = lane & 7;
#pragma unroll
    for (int j = 0; j < 4; ++j) { const int nn = (lane >> 3) + 8 * j; const LAS float* s = scr + (8 * c) * 33 + nn;
        u32x4 o; o.x = pk2(s[0 * 33], s[1 * 33]); o.y = pk2(s[2 * 33], s[3 * 33]); o.z = pk2(s[4 * 33], s[5 * 33]); o.w = pk2(s[6 * 33], s[7 * 33]);
        *(u32x4*)(WT + (size_t)(n0 + nn) * 1024 + k0 + 8 * c) = o; }
    asm volatile("s_waitcnt lgkmcnt(0)" ::: "memory");
}
__device__ __forceinline__ void p0_prologue(Ctx& F) {
    FRESH_TID(F);
    LAS float* scr = (LAS float*)(F.lds + F.wave * 8448);
    const int gw = F.bid * 8 + F.wave, NGW = F.G * 8;
    constexpr int I_IN = 16 * (DINP / 32), I_OUT = 16 * 32, I_L = I_IN + I_OUT;
    for (int it = gw; it < DEPTH * I_L; it += NGW) {
        const int l = it / I_L; int r = it % I_L;
        if (r < I_IN) p0_transpose_item(F.w_in + (size_t)l * 1024 * DIN, DIN, DIN, true, F.WinT + (size_t)l * DINP * 1024, scr, r / (DINP / 32), r % (DINP / 32), F.lane);
        else { r -= I_IN; p0_transpose_item(F.w_out + (size_t)l * 1024 * 1024, 1024, 1024, false, F.WoutT + (size_t)l * 1024 * 1024, scr, r / 32, r % 32, F.lane); }
    }
    __syncthreads();
    LAS float* red = (LAS float*)(F.lds);
    LAS float* sl = (LAS float*)(F.lds + 73728);
    constexpr int NSUB = DEPTH * 192;
    const int c4 = F.tid & 7, kg = F.tid >> 3;
    f32x4 wv[8];
#define MOD_LOAD(it_) do { const int l_ = (it_) / 192, rem_ = (it_) % 192; \
        const float* wp_ = F.w_ada + ((size_t)l_ * 1024 + (rem_ & 1) * 512 + kg * 8) * 3072 + (rem_ >> 1) * 32 + 4 * c4; \
        _Pragma("unroll") for (int k = 0; k < 8; ++k) wv[k] = __builtin_nontemporal_load((const f32x4*)(wp_ + (size_t)k * 3072)); } while (0)
    if (F.bid < NSUB) MOD_LOAD(F.bid);
    for (int i = F.tid; i < 9 * 1024; i += 512) { const int r = i >> 10, k = i & 1023; const float v = r == 0 ? F.c_ctx[k] : F.cvec[(r - 1) * 1024 + k]; sl[i] = siluf_(v); }
    __syncthreads();
    for (int it = F.bid; it < NSUB; it += F.G) {
        const int l = it / 192, rem = it % 192, e0 = (rem >> 1) * 32, kh = rem & 1;
        f32x4 acc[9];
#pragma unroll
        for (int r = 0; r < 9; ++r) acc[r] = (f32x4){0.f, 0.f, 0.f, 0.f};
#pragma unroll
        for (int k = 0; k < 8; ++k)
#pragma unroll
            for (int r = 0; r < 9; ++r) acc[r] += wv[k] * sl[r * 1024 + kh * 512 + kg * 8 + k];
        if (it + F.G < NSUB) MOD_LOAD(it + F.G);
#pragma unroll
        for (int r = 0; r < 9; ++r) *(LAS f32x4*)(red + (kg * 9 + r) * 32 + 4 * c4) = acc[r];
        __syncthreads();
        for (int o = F.tid; o < 9 * 32; o += 512) { const int r = o >> 5, cc = o & 31; float sacc = kh == 0 ? F.b_ada[l * 3072 + e0 + cc] : 0.f;
#pragma unroll 8
            for (int g = 0; g < 64; ++g) sacc += red[(g * 9 + r) * 32 + cc];
            atomicAdd(F.mod + ((size_t)l * 9 + r) * 3072 + e0 + cc, sacc); }
        __syncthreads();
    }
#undef MOD_LOAD
}

__device__ __forceinline__ void p0b_phase(Ctx& F) {
    FRESH_TID(F);
    const int gw = F.bid * 8 + F.wave, NGW = F.G * 8, lane = F.lane;
    for (int m0 = gw; m0 < NTOK; m0 += 4 * NGW) {
        f32x4 v[4][4];
#pragma unroll
        for (int rr = 0; rr < 4; ++rr) { const int m = m0 + rr * NGW;
            const float* xrow = m < NCTX ? F.x_prompt + (size_t)m * 1024 : F.x_sample + (size_t)(m - NCTX) * 1024;
            const f32x4* xr = (const f32x4*)xrow + lane;
#pragma unroll
            for (int j = 0; j < 4; ++j) v[rr][j] = (m < NTOK) ? __builtin_nontemporal_load(xr + 64 * j) : (f32x4){0.f, 0.f, 0.f, 0.f}; }
#pragma unroll
        for (int rr = 0; rr < 4; ++rr) { const int m = m0 + rr * NGW; if (m >= NTOK) break;
            const int mr = m < NCTX ? 0 : 1 + ((m - NCTX) >> 10);
            const float* md = F.mod + (size_t)mr * 3072;
            float sacc = 0.f;
#pragma unroll
            for (int j = 0; j < 4; ++j) sacc += (v[rr][j].x * v[rr][j].x + v[rr][j].y * v[rr][j].y) + (v[rr][j].z * v[rr][j].z + v[rr][j].w * v[rr][j].w);
            sacc = wave_sum(sacc);
            if (lane == 0) F.ssq[m] = sacc;
            unsigned long long* o8 = (unsigned long long*)(F.R3 + (size_t)m * 1024) + lane;
#pragma unroll
            for (int j = 0; j < 4; ++j) { const int c = 4 * lane + 256 * j;
                const f32x4 gg = *(const f32x4*)(F.norm_g + c), sc = *(const f32x4*)(md + 1024 + c);
                const f32x4 a = v[rr][j] * gg * (sc + 1.0f);
                o8[64 * j] = (unsigned long long)pk2(a.x, a.y) | ((unsigned long long)pk2(a.z, a.w) << 32); } }
    }
    const int c = lane & 15, q = lane >> 4;
    for (int t = NGW - 1 - gw; t < DEPTH * (DINP / 16); t += NGW) {
        const int l = t / (DINP / 16), n0 = (t % (DINP / 16)) * 16;
        const bf16* wrow = F.WinT + ((size_t)l * DINP + n0 + c) * 1024 + 8 * q;
        const float* sh = F.mod + ((size_t)l * 9 + (c < 9 ? c : 0)) * 3072 + 8 * q;
        f32x4 acc = (f32x4){0.f, 0.f, 0.f, 0.f};
#pragma unroll 16
        for (int k = 0; k < 32; ++k) {
            const bf16x8 b = *(const bf16x8*)(wrow + 32 * k);
            f32x4 a0 = *(const f32x4*)(sh + 32 * k), a1 = *(const f32x4*)(sh + 32 * k + 4);
            if (c >= 9) { a0 = (f32x4){0.f, 0.f, 0.f, 0.f}; a1 = a0; }
            acc = MFMA16(pack8(a0, a1), b, acc);
        }
#pragma unroll
        for (int r = 0; r < 4; ++r) F.SW[((size_t)l * 16 + 4 * q + r) * DINP + n0 + c] = acc[r];
    }
}
__device__ __forceinline__ void final_phase(Ctx& F) {
    const int gw = F.bid * 8 + F.wave, NGW = F.G * 8;
    for (int m = gw; m < NTOK; m += NGW) {
        f32x4* xr = (f32x4*)(F.out + (size_t)m * 1024) + F.lane;
        const float rstd = __builtin_amdgcn_rsqf(F.ssq[4 * NTOK + m] * (1.f / 1024.f) + EPS);
#pragma unroll
        for (int j = 0; j < 4; ++j) { const f32x4 gg = *(const f32x4*)(F.final_g + 4 * F.lane + 256 * j); xr[64 * j] = xr[64 * j] * rstd * gg; }
    }
}

__device__ __forceinline__ bf16x8 tr_frag(const LAS bf16* base, int RS, int row0, int col0, int c) {
    const LAS bf16* p = base + (row0 + (c >> 2)) * RS + col0 + 4 * (c & 3);
    const bf16x4 lo = __builtin_amdgcn_ds_read_tr16_b64_v4i16((LAS bf16x4*)p);
    const bf16x4 hi = __builtin_amdgcn_ds_read_tr16_b64_v4i16((LAS bf16x4*)(p + 4 * RS));
    return mk8(lo, hi);
}
__device__ __forceinline__ u32x4 scale8(u32x4 v, float g) { u32x4 o;
#pragma unroll
    for (int j = 0; j < 4; ++j) o[j] = pk2(bflo(v[j]) * g, bfhi(v[j]) * g);
    return o; }

constexpr int RSA = 136;
constexpr int A1_TAB = 69632;
__device__ __forceinline__ void mlstm_chain(Ctx& F, int l, int s, int h, int dir) {
    FRESH_TID(F);
    const int tid = F.tid, lane = F.lane, w = F.wave, c = lane & 15, q = lane >> 4;
    int row0, L; seq_info(s, row0, L);
    const int nch = L / 64, e0 = 16 * w, gc0 = row0 >> 6;
    const float bi = F.gate_b[l * 16 + dir * 8 + h], bfg = F.gate_b[l * 16 + dir * 8 + 4 + h];
    LAS float* gt = (LAS float*)(F.lds + A1_TAB);
    u32x4 kr0[2], vr0[2], kr1[2], vr1[2];
#define A1_LOAD(nn, KR, VR) do { \
        _Pragma("unroll") for (int i_ = 0; i_ < 2; ++i_) { const int p_ = tid + 512 * i_, r_ = p_ >> 4, cp_ = (p_ & 15) * 8; \
            const int pos_ = dir ? (L - 1 - (64 * (nn) + r_)) : (64 * (nn) + r_); \
            const bf16* src_ = F.PROJ + (size_t)(row0 + pos_) * DINP + h * 128 + cp_; \
            KR[i_] = *(const u32x4*)(src_ + C_AK); VR[i_] = *(const u32x4*)(src_ + C_AV); } } while (0)
    bf16 gi[2], gf[2];
#pragma unroll
    for (int i = 0; i < 2; ++i) { const int n = (w + 8 * i) & (nch - 1);
        const int posl = dir ? (L - 1 - (64 * n + lane)) : (64 * n + lane);
        const bf16* gp = F.PROJ + (size_t)(row0 + posl) * DINP + C_AG + dir * 8 + h; gi[i] = gp[0]; gf[i] = gp[4]; }
    A1_LOAD(0, kr0, vr0); A1_LOAD(1, kr1, vr1);
    f32x4 st[8], nst; float m_prev;
#define A1_SCANS() do { \
    _Pragma("unroll") for (int i = 0; i < 2; ++i) { const int n = w + 8 * i; \
        if (n < nch) { \
            const int posl = dir ? (L - 1 - (64 * n + lane)) : (64 * n + lane); \
            const float ic = bf2f(gi[i]) + bi, fp = bf2f(gf[i]) + bfg; \
            float Fc = logsigmoidf_(fp); \
            _Pragma("unroll") for (int o = 1; o < 64; o <<= 1) { const float t = __shfl_up(Fc, o); if (lane >= o) Fc += t; } \
            const float u = ic - Fc; \
            float pm = u; \
            _Pragma("unroll") for (int o = 1; o < 64; o <<= 1) { const float t = __shfl_up(pm, o); if (lane >= o) pm = fmaxf(pm, t); } \
            const float F_last = __shfl(Fc, 63), pmL = __shfl(pm, 63); \
            gt[n * 64 + lane] = F_last + u; \
            *(f32x4*)(F.AG + (((size_t)(row0 + posl) * 4 + h) * 2 + dir) * 4) = (f32x4){u, pm, Fc, 0.f}; \
            if (lane == 0) { gt[1024 + n] = F_last; gt[1040 + n] = F_last + pmL; } \
        } } } while (0)
    if (s >= 32) {
        const size_t sb = (((size_t)(s - 32) * DEPTH + l) * 2 + dir) * 4 + h;
        const float* C0 = F.st_C + sb * 16384;
#pragma unroll
        for (int t = 0; t < 8; ++t)
#pragma unroll
            for (int r = 0; r < 4; ++r) st[t][r] = C0[(size_t)(16 * t + 4 * q + r) * 128 + e0 + c];
#pragma unroll
        for (int r = 0; r < 4; ++r) nst[r] = F.st_n[sb * 128 + 16 * w + 4 * q + r];
        m_prev = F.st_m[sb];
        A1_SCANS();
    } else {
#pragma unroll
        for (int t = 0; t < 8; ++t) st[t] = (f32x4){0.f, 0.f, 0.f, 0.f};
        nst = (f32x4){0.f, 0.f, 0.f, 0.f}; m_prev = 0.f;
        A1_SCANS();
    }
#undef A1_SCANS
    const u32x4 ones_u = (u32x4){0x3f803f80u, 0x3f803f80u, 0x3f803f80u, 0x3f803f80u};
    const bf16x8 ones = __builtin_bit_cast(bf16x8, ones_u);
    __syncthreads();
#define A1_STEP(nn, KR, VR, BUF) do { \
        LAS bf16* Kg = (LAS bf16*)(F.lds + (BUF) * 34816); LAS bf16* Vs = Kg + 64 * RSA; \
        const float FLn = gt[1024 + (nn)], GMn = gt[1040 + (nn)]; \
        const float m_new = fmaxf(FLn + m_prev, GMn), a_dec = __expf(FLn + m_prev - m_new); \
        { const int m_ = dir ? nch - 1 - (nn) : (nn); const size_t slot = ((size_t)(gc0 + m_) * 4 + h) * 2 + dir; \
          u32x4* sp = (u32x4*)(F.Ast + slot * 16384) + (w * 4) * 64 + lane; \
          _Pragma("unroll") for (int k = 0; k < 4; ++k) __builtin_nontemporal_store(__builtin_bit_cast(u32x4, pack8(st[2 * k], st[2 * k + 1])), sp + k * 64); \
          if (c == 0) *(f32x4*)(F.Anm + slot * 132 + 16 * w + 4 * q) = nst; \
          if (tid == 0) F.Anm[slot * 132 + 128] = m_prev; } \
        _Pragma("unroll") for (int i = 0; i < 2; ++i) { const int p = tid + 512 * i, r = p >> 4, cp = (p & 15) * 8; \
            const float gr = __expf(gt[(nn) * 64 + r] - m_new); \
            *(LAS u32x4*)(Kg + r * RSA + cp) = scale8(KR[i], gr); *(LAS u32x4*)(Vs + r * RSA + cp) = VR[i]; } \
        if ((nn) + 2 < nch) A1_LOAD((nn) + 2, KR, VR); \
        __syncthreads(); \
        bf16x8 vb[2], nf[2]; \
        _Pragma("unroll") for (int k = 0; k < 2; ++k) { vb[k] = tr_frag(Vs, RSA, 32 * k + 8 * q, e0, c); nf[k] = tr_frag(Kg, RSA, 32 * k + 8 * q, 16 * w, c); } \
        _Pragma("unroll") for (int t0 = 0; t0 < 8; t0 += 4) { bf16x8 af[4][2]; \
            _Pragma("unroll") for (int t = 0; t < 4; ++t) _Pragma("unroll") for (int k = 0; k < 2; ++k) af[t][k] = tr_frag(Kg, RSA, 32 * k + 8 * q, 16 * (t0 + t), c); \
            LDS_ISSUED(); \
            _Pragma("unroll") for (int t = 0; t < 4; ++t) { st[t0 + t] = st[t0 + t] * a_dec; \
                _Pragma("unroll") for (int k = 0; k < 2; ++k) st[t0 + t] = MFMA16(af[t][k], vb[k], st[t0 + t]); } } \
        f32x4 nacc = (f32x4){0.f, 0.f, 0.f, 0.f}; \
        _Pragma("unroll") for (int k = 0; k < 2; ++k) nacc = MFMA16(nf[k], ones, nacc); \
        nst = nst * a_dec + nacc; m_prev = m_new; } while (0)
    for (int n = 0; n < nch; n += 2) { A1_STEP(n, kr0, vr0, 0); A1_STEP(n + 1, kr1, vr1, 1); }
#undef A1_STEP
#undef A1_LOAD
    if (s < 32) {
        const size_t sb = (((size_t)s * DEPTH + l) * 2 + dir) * 4 + h;
        float* Co = F.out + O_C + sb * 16384;
#pragma unroll
        for (int t = 0; t < 8; ++t)
#pragma unroll
            for (int r = 0; r < 4; ++r) __builtin_nontemporal_store(st[t][r], Co + (size_t)(16 * t + 4 * q + r) * 128 + e0 + c);
        if (c == 0) *(f32x4*)(F.out + O_N + sb * 128 + 16 * w + 4 * q) = nst;
        if (tid == 0) F.out[O_M + sb] = m_prev;
    }
    __syncthreads();
}

__device__ __forceinline__ void rot8(float (&a)[8], float (&b)[8], int pos, int cp) {
    const float prow = (float)(pos >> 6), pcol = (float)(pos & 63);
#pragma unroll
    for (int x = 0; x < 8; ++x) { const int f = cp + x;
        const float fr = ex2(-(float)(f & 15) * 0.8304820237218406f);
        const float ang = (f < 16 ? prow : pcol) * fr;
        const float cs = __cosf(ang), sn = __sinf(ang);
        const float t1 = a[x], t2 = b[x]; a[x] = t1 * cs - t2 * sn; b[x] = t1 * sn + t2 * cs; }
}
__device__ __forceinline__ void unpack8(u32x4 v, float (&o)[8]) {
#pragma unroll
    for (int j = 0; j < 4; ++j) { o[2 * j] = bflo(v[j]); o[2 * j + 1] = bfhi(v[j]); } }
__device__ __forceinline__ u32x4 packf8(const float (&a)[8], float g) { u32x4 o; o.x = pk2(a[0] * g, a[1] * g); o.y = pk2(a[2] * g, a[3] * g); o.z = pk2(a[4] * g, a[5] * g); o.w = pk2(a[6] * g, a[7] * g); return o; }

__device__ __forceinline__ void ret_chain(Ctx& F, int l, int s, int h) {
    FRESH_TID(F);
    const int tid = F.tid, lane = F.lane, dir = F.wave >> 2, wl = F.wave & 3, tl = tid & 255, c = lane & 15, q = lane >> 4;
    int row0, L; seq_info(s, row0, L);
    const int nch = L / 64, e0 = 16 * wl, gc0 = row0 >> 6;
    const float lg2 = logsigmoid_acc(F.ret_logit[(l * 2 + dir) * 4 + h]) * 1.4426950408889634f;
    const bool rot = s >= 32;
    f32x4 st[4];
    if (s >= 32) {
        const float* S0 = F.st_ret + ((((size_t)(s - 32) * DEPTH + l) * 2 + dir) * 4 + h) * 4096;
#pragma unroll
        for (int t = 0; t < 4; ++t)
#pragma unroll
            for (int r = 0; r < 4; ++r) st[t][r] = S0[(size_t)(16 * t + 4 * q + r) * 64 + e0 + c];
    } else {
#pragma unroll
        for (int t = 0; t < 4; ++t) st[t] = (f32x4){0.f, 0.f, 0.f, 0.f};
    }
    const float g64 = ex2(64.f * lg2);
    const int r = tl >> 2, cp = (tl & 3) * 8;
    const float gr = ex2((float)(63 - r) * lg2);
    u32x4 ka0, kb0, va0, vb0, ka1, kb1, va1, vb1;
#define B1_LOAD(nn, K1, K2, V1, V2) do { const int pos_ = dir ? (L - 1 - (64 * (nn) + r)) : (64 * (nn) + r); \
        const bf16* src_ = F.PROJ + (size_t)(row0 + pos_) * DINP + h * 64 + cp; \
        K1 = *(const u32x4*)(src_ + C_BK); K2 = *(const u32x4*)(src_ + C_BK + 32); V1 = *(const u32x4*)(src_ + C_BV); V2 = *(const u32x4*)(src_ + C_BV + 32); } while (0)
    B1_LOAD(0, ka0, kb0, va0, vb0); B1_LOAD(1, ka1, kb1, va1, vb1);
#define B1_STEP(nn, K1, K2, V1, V2, BUF) do { \
        LAS bf16* Kg = (LAS bf16*)(F.lds + (dir * 2 + (BUF)) * 18432); LAS bf16* Vs = Kg + 64 * 72; \
        { const int m_ = dir ? nch - 1 - (nn) : (nn); const size_t slot = ((size_t)(gc0 + m_) * 4 + h) * 2 + dir; \
          u32x4* sp = (u32x4*)(F.Bst + slot * 4096) + (wl * 2) * 64 + lane; \
          _Pragma("unroll") for (int k = 0; k < 2; ++k) __builtin_nontemporal_store(__builtin_bit_cast(u32x4, pack8(st[2 * k], st[2 * k + 1])), sp + k * 64); } \
        { float ka[8], kb[8]; unpack8(K1, ka); unpack8(K2, kb); \
          if (rot) { const int pos = dir ? (L - 1 - (64 * (nn) + r)) : (64 * (nn) + r); rot8(ka, kb, pos, cp); } \
          *(LAS u32x4*)(Kg + r * 72 + cp) = packf8(ka, gr); *(LAS u32x4*)(Kg + r * 72 + cp + 32) = packf8(kb, gr); \
          *(LAS u32x4*)(Vs + r * 72 + cp) = V1; *(LAS u32x4*)(Vs + r * 72 + cp + 32) = V2; } \
        if ((nn) + 2 < nch) B1_LOAD((nn) + 2, K1, K2, V1, V2); \
        __syncthreads(); \
        bf16x8 vb[2], af[4][2]; \
        _Pragma("unroll") for (int k = 0; k < 2; ++k) vb[k] = tr_frag(Vs, 72, 32 * k + 8 * q, e0, c); \
        _Pragma("unroll") for (int t = 0; t < 4; ++t) _Pragma("unroll") for (int k = 0; k < 2; ++k) af[t][k] = tr_frag(Kg, 72, 32 * k + 8 * q, 16 * t, c); \
        LDS_ISSUED(); \
        _Pragma("unroll") for (int t = 0; t < 4; ++t) { st[t] = st[t] * g64; \
            _Pragma("unroll") for (int k = 0; k < 2; ++k) st[t] = MFMA16(af[t][k], vb[k], st[t]); } } while (0)
    for (int n = 0; n < nch; n += 2) { B1_STEP(n, ka0, kb0, va0, vb0, 0); B1_STEP(n + 1, ka1, kb1, va1, vb1, 1); }
#undef B1_STEP
#undef B1_LOAD
    if (s < 32) {
        float* So = F.out + O_R + ((((size_t)s * DEPTH + l) * 2 + dir) * 4 + h) * 4096;
#pragma unroll
        for (int t = 0; t < 4; ++t)
#pragma unroll
            for (int rr = 0; rr < 4; ++rr) __builtin_nontemporal_store(st[t][rr], So + (size_t)(16 * t + 4 * q + rr) * 64 + e0 + c);
    }
}

__device__ __forceinline__ void gla_chain(Ctx& F, int l, int s, int h, int dir) {
    FRESH_TID(F);
    const int tid = F.tid, lane = F.lane, hw = F.wave >> 2, wl = F.wave & 3, c = lane & 15, q = lane >> 4;
    int row0, L; seq_info(s, row0, L);
    const int nch = L / 32, nss = nch / 4, e0 = 16 * wl, gc0 = row0 >> 5;
    const int dl = lane & 7, jg = lane >> 3, d = 8 * wl + dl;
    LAS bf16* CL = (LAS bf16*)(F.lds); LAS bf16* KR = CL + 2048; LAS bf16* Ku = CL + 7168; LAS bf16* Vs = CL + 12288; LAS float* dec = (LAS float*)(CL + 21504);
    LAS float* cbt = (LAS float*)(F.lds + 43520);
    float w2r[16];
#pragma unroll
    for (int r = 0; r < 16; ++r) w2r[r] = F.gla_w2[(((size_t)l * 2 + dir) * 16 + r) * 128 + h * 32 + d];
    const float b2v = F.gla_b2[((size_t)l * 2 + dir) * 128 + h * 32 + d];
    f32x4 st[2];
    if (s >= 32) {
        const float* S0 = F.st_gla + ((((size_t)(s - 32) * DEPTH + l) * 2 + dir) * 4 + h) * 2048;
#pragma unroll
        for (int t = 0; t < 2; ++t)
#pragma unroll
            for (int r = 0; r < 4; ++r) st[t][r] = S0[(size_t)(16 * t + 4 * q + r) * 64 + e0 + c];
    } else { st[0] = (f32x4){0.f, 0.f, 0.f, 0.f}; st[1] = st[0]; }
    u32x4 pc, pk, pv[2];
#define C1_LOAD(ss) do { \
        if (tid < 256) { const int j_ = tid >> 1; const int pos_ = dir ? (L - 1 - (128 * (ss) + j_)) : (128 * (ss) + j_); \
          pc = *(const u32x4*)(F.PROJ + (size_t)(row0 + pos_) * DINP + C_CLR + dir * 16 + (tid & 1) * 8); } \
        { const int j_ = tid >> 2; const int pos_ = dir ? (L - 1 - (128 * (ss) + j_)) : (128 * (ss) + j_); \
          pk = *(const u32x4*)(F.PROJ + (size_t)(row0 + pos_) * DINP + C_CK + h * 32 + (tid & 3) * 8); } \
        _Pragma("unroll") for (int i_ = 0; i_ < 2; ++i_) { const int p_ = tid + 512 * i_, j_ = p_ >> 3; const int pos_ = dir ? (L - 1 - (128 * (ss) + j_)) : (128 * (ss) + j_); \
          pv[i_] = *(const u32x4*)(F.PROJ + (size_t)(row0 + pos_) * DINP + C_CV + h * 64 + (p_ & 7) * 8); } } while (0)
    C1_LOAD(0);
    for (int ss = 0; ss < nss; ++ss) {
        if (tid < 256) *(LAS u32x4*)(CL + (tid >> 1) * 16 + (tid & 1) * 8) = pc;
        *(LAS u32x4*)(KR + (tid >> 2) * 40 + (tid & 3) * 8) = pk;
#pragma unroll
        for (int i = 0; i < 2; ++i) { const int p = tid + 512 * i; *(LAS u32x4*)(Vs + (p >> 3) * 72 + (p & 7) * 8) = pv[i]; }
        if (ss + 1 < nss) C1_LOAD(ss + 1);
        __syncthreads();
#pragma unroll
        for (int c2 = 0; c2 < 2; ++c2) {
            const int cc = 2 * hw + c2;
            float pb[4], kv[4], run = 0.f;
#pragma unroll
            for (int x = 0; x < 4; ++x) { const int j = 32 * cc + 4 * jg + x;
                const u32x4 c0 = *(const LAS u32x4*)(CL + j * 16), c1 = *(const LAS u32x4*)(CL + j * 16 + 8);
                float xx = b2v;
#pragma unroll
                for (int y = 0; y < 4; ++y) { xx += bflo(c0[y]) * w2r[2 * y] + bfhi(c0[y]) * w2r[2 * y + 1]; xx += bflo(c1[y]) * w2r[8 + 2 * y] + bfhi(c1[y]) * w2r[8 + 2 * y + 1]; }
                run += logsigmoidf_(xx) * 0.0625f; pb[x] = run; kv[x] = bf2f(KR[j * 40 + d]); }
            float tot = run;
#pragma unroll
            for (int o = 8; o < 64; o <<= 1) { const float t = __shfl_up(tot, o); if (lane >= o) tot += t; }
            const float off = tot - run, blast = __shfl(tot, 56 + dl);
#pragma unroll
            for (int x = 0; x < 4; ++x) { const int j = 32 * cc + 4 * jg + x; const float b = off + pb[x];
                Ku[j * 40 + d] = (bf16)f2bf(kv[x] * __expf(blast - b));
                cbt[j * 36 + d] = b; }
            if (jg == 0) dec[cc * 32 + d] = __expf(blast);
        }
        __syncthreads();
#pragma unroll
        for (int i = 0; i < 2; ++i) { const int p = tid + 512 * i, j = p >> 3, ch = p & 7; const int pos = dir ? (L - 1 - (128 * ss + j)) : (128 * ss + j);
            __builtin_nontemporal_store(*(const LAS f32x4*)(cbt + j * 36 + ch * 4), (f32x4*)(F.CB + ((size_t)(row0 + pos) * 2 + dir) * 128 + h * 32 + ch * 4)); }
        if (hw == 0) {
            bf16x8 vb[4], kf[4][2]; f32x4 dv[4][2];
#pragma unroll
            for (int cc = 0; cc < 4; ++cc) { vb[cc] = tr_frag(Vs, 72, 32 * cc + 8 * q, e0, c);
#pragma unroll
                for (int t = 0; t < 2; ++t) { kf[cc][t] = tr_frag(Ku, 40, 32 * cc + 8 * q, 16 * t, c); dv[cc][t] = *(const LAS f32x4*)(dec + cc * 32 + 16 * t + 4 * q); } }
            LDS_ISSUED();
#pragma unroll
            for (int cc = 0; cc < 4; ++cc) {
                const int n = 4 * ss + cc;
                { const int m = dir ? nch - 1 - n : n; const size_t slot = ((size_t)(gc0 + m) * 4 + h) * 2 + dir;
                  u32x4* sp = (u32x4*)(F.Cst + slot * 2048) + wl * 64 + lane; __builtin_nontemporal_store(__builtin_bit_cast(u32x4, pack8(st[0], st[1])), sp); }
#pragma unroll
                for (int t = 0; t < 2; ++t) st[t] = MFMA16(kf[cc][t], vb[cc], st[t] * dv[cc][t]);
            }
        }
        __syncthreads();
    }
#undef C1_LOAD
    if (s < 32 && hw == 0) {
        float* So = F.out + O_G + ((((size_t)s * DEPTH + l) * 2 + dir) * 4 + h) * 2048;
#pragma unroll
        for (int t = 0; t < 2; ++t)
#pragma unroll
            for (int r = 0; r < 4; ++r) __builtin_nontemporal_store(st[t][r], So + (size_t)(16 * t + 4 * q + r) * 64 + e0 + c);
    }
}

__device__ __forceinline__ void p1_unit(Ctx& F, int l, int uq) {
    int typ, s, h, dir = 0;
    if (F.g_typ) { s = F.g_s0;
        if (uq < 8) { typ = 0; h = uq >> 1; dir = uq & 1; }
        else if (uq < 16) { const int v = uq - 8; typ = 2; h = v >> 1; dir = v & 1; }
        else { typ = 1; h = uq - 16; } }
    else {
        if (uq < 32) { typ = 0; s = F.g_s0 + (uq >> 3); h = (uq >> 1) & 3; dir = uq & 1; }
        else if (uq < 48) { const int v = uq - 32; typ = 1; s = F.g_s0 + (v >> 2); h = v & 3; }
        else { const int v = uq - 48; typ = 2; s = F.g_s0 + (v >> 3); h = (v >> 1) & 3; dir = v & 1; } }
    if (typ == 0) mlstm_chain(F, l, s, h, dir); else if (typ == 1) ret_chain(F, l, s, h); else gla_chain(F, l, s, h, dir);
}
__device__ __forceinline__ int p1_static(int typ, int r, int idx) {
    if (typ) { if (r >= 8) return idx == 0 ? (r - 8) : (idx == 1 ? 8 + (r - 8) : -1);
               if (r < 4) return idx == 0 ? 16 + r : -1;
               return -1; }
    if (r >= 8) { const int j = r - 8; if (idx < 3) return 3 * j + idx; if (idx == 3) return 32 + j; if (idx < 6) return 48 + 2 * j + (idx - 4); return idx == 6 ? 65 + 2 * j : -1; }
    if (idx == 0) return 24 + r; if (idx == 1) return 40 + r; return idx == 2 ? 64 + 2 * r : -1;
}
__device__ __forceinline__ void mixer_pass1(Ctx& F, int l) {
    for (int idx = 0; idx < 7; ++idx) { const int uq = p1_static(F.g_typ, F.g_r, idx); if (uq < 0) break; p1_unit(F, l, uq); __syncthreads(); }
}

constexpr int T2_UF = 0, T2_MXF = 64, T2_UB = 128, T2_MXB = 192, T2_WAF = 256, T2_WAB = 320, T2_EMF = 384, T2_EMB = 448, T2_DPF = 512, T2_DPB = 768, T2_QNF = 1024, T2_QNB = 1088,
              T2_NVF = 1152, T2_NVB = 1280, T2_SSP = 1408;
struct A2R { f32x4 agf, agb; float mpf, mpb, nv; };
struct A2F { u32x4 cff[4], cfb[4]; };
struct A2Q { u32x4 qv[2], kv[2], vv[2]; };
__device__ __forceinline__ void a2_decode(int u, int& s, int& h, int& m) { const int gc = u >> 2; h = u & 3; if (gc < 128) { s = gc >> 2; m = gc & 3; } else { s = 32 + ((gc - 128) >> 4); m = (gc - 128) & 15; } }
__device__ __forceinline__ void a2_loadA(Ctx& F, int l, int u, A2R& R) {
    const int tid = F.tid, lane = F.lane;
    int s, h, m; a2_decode(u, s, h, m);
    int row0, L; seq_info(s, row0, L);
    const int gc = (row0 >> 6) + m, rowb = row0 + 64 * m;
    const size_t slot_f = ((size_t)gc * 4 + h) * 2, slot_b = slot_f + 1;
    R.agf = *(const f32x4*)(F.AG + (((size_t)(rowb + lane) * 4 + h) * 2) * 4); R.agb = *(const f32x4*)(F.AG + (((size_t)(rowb + lane) * 4 + h) * 2 + 1) * 4);
    R.mpf = F.Anm[slot_f * 132 + 128]; R.mpb = F.Anm[slot_b * 132 + 128];
    R.nv = F.Anm[(tid < 128 ? slot_f : slot_b) * 132 + (tid & 127)];
}
__device__ __forceinline__ void a2_loadF(Ctx& F, int u, A2F& R) {
    const int lane = F.lane, w = F.wave;
    int s, h, m; a2_decode(u, s, h, m);
    int row0, L; seq_info(s, row0, L);
    const int gc = (row0 >> 6) + m;
    const size_t slot_f = ((size_t)gc * 4 + h) * 2, slot_b = slot_f + 1;
    const u32x4* pf_ = (const u32x4*)(F.Ast + slot_f * 16384) + (w * 4) * 64 + lane; const u32x4* pb_ = (const u32x4*)(F.Ast + slot_b * 16384) + (w * 4) * 64 + lane;
#pragma unroll
    for (int k = 0; k < 4; ++k) { R.cff[k] = __builtin_nontemporal_load(pf_ + k * 64); R.cfb[k] = __builtin_nontemporal_load(pb_ + k * 64); }
}
__device__ __forceinline__ void a2_loadQ(Ctx& F, int u, A2Q& Q) {
    const int tid = F.tid;
    int s, h, m; a2_decode(u, s, h, m);
    int row0, L; seq_info(s, row0, L);
    const int rowb = row0 + 64 * m;
#pragma unroll
    for (int i = 0; i < 2; ++i) { const int p = tid + 512 * i, r = p >> 4, cp = (p & 15) * 8;
        const bf16* src = F.PROJ + (size_t)(rowb + r) * DINP + h * 128 + cp;
        Q.qv[i] = __builtin_nontemporal_load((const u32x4*)(src + C_AQ)); Q.kv[i] = __builtin_nontemporal_load((const u32x4*)(src + C_AK)); Q.vv[i] = __builtin_nontemporal_load((const u32x4*)(src + C_AV)); }
}
__device__ __forceinline__ void a2_compute(Ctx& F, int l, int u, A2R& R, A2Q& Q, A2F& FR, int u_next, A2R& Rn) {
    const int tid = F.tid, lane = F.lane, w = F.wave, c = lane & 15, q = lane >> 4;
    LAS bf16* Qs = (LAS bf16*)(F.lds); LAS bf16* Ks = (LAS bf16*)(F.lds + 17408); LAS bf16* Vs = (LAS bf16*)(F.lds + 34816);
    LAS bf16* Pf = (LAS bf16*)(F.lds + 52224); LAS bf16* Pb = (LAS bf16*)(F.lds + 61440); LAS float* tab = (LAS float*)(F.lds + 70656);
    int s, h, m; a2_decode(u, s, h, m);
    int row0, L; seq_info(s, row0, L);
    const int e0 = 16 * w, rowb = row0 + 64 * m;
    asm volatile("" :: "v"(R.agf), "v"(R.agb));
#pragma unroll
    for (int i = 0; i < 2; ++i) { const int p = tid + 512 * i, r = p >> 4, cp = (p & 15) * 8;
        *(LAS u32x4*)(Qs + r * RSA + cp) = Q.qv[i]; *(LAS u32x4*)(Ks + r * RSA + cp) = Q.kv[i]; *(LAS u32x4*)(Vs + r * RSA + cp) = Q.vv[i]; }
    if (u_next < 1024) { a2_loadQ(F, u_next, Q); a2_loadA(F, l, u_next, Rn); }
    u32x2 ogv[4], zgv[4];
#pragma unroll
    for (int it = 0; it < 4; ++it) { const bf16* pp_ = F.PROJ + (size_t)(rowb + 16 * it + c) * DINP + h * 128 + e0 + 4 * q; ogv[it] = *(const u32x2*)(pp_ + C_AO); zgv[it] = *(const u32x2*)(pp_ + C_AZ); }
    const f32x4 hg = *(const f32x4*)(F.hn_g + l * 1024 + h * 128 + e0 + 4 * q);
    if (tid < 256) tab[T2_NVF + tid] = R.nv;
    const float mpf = R.mpf, mpb = R.mpb;
    const float uf = R.agf[0], pmf = R.agf[1], Ff = R.agf[2], ub = R.agb[0], pmb = R.agb[1], Fb = R.agb[2];
    const float mxf = fmaxf(mpf, pmf), mxb = fmaxf(mpb, pmb);
    if (w == 0) { tab[T2_UF + lane] = uf; tab[T2_MXF + lane] = mxf; tab[T2_UB + lane] = ub; tab[T2_MXB + lane] = mxb;
        tab[T2_WAF + lane] = __expf(mpf - mxf); tab[T2_WAB + lane] = __expf(mpb - mxb); tab[T2_EMF + lane] = __expf(-(Ff + mxf)); tab[T2_EMB + lane] = __expf(-(Fb + mxb)); }
    __syncthreads();
#pragma unroll
    for (int x = 0; x < 2; ++x) {
        const int tix = w + 8 * x, jt = tix & 3, it = tix >> 2;
        f32x4 acc = (f32x4){0.f, 0.f, 0.f, 0.f};
#pragma unroll
        for (int k = 0; k < 4; ++k) acc = MFMA16(*(const LAS bf16x8*)(Ks + (16 * jt + c) * RSA + 32 * k + 8 * q), *(const LAS bf16x8*)(Qs + (16 * it + c) * RSA + 32 * k + 8 * q), acc);
        const int i = 16 * it + c, j0 = 16 * jt + 4 * q;
        const float mxfi = tab[T2_MXF + i], mxbi = tab[T2_MXB + i];
        const f32x4 ufj = *(const LAS f32x4*)(tab + T2_UF + j0), ubj = *(const LAS f32x4*)(tab + T2_UB + j0);
        float pf[4], pb[4], dsf = 0.f, dsb = 0.f;
#pragma unroll
        for (int r = 0; r < 4; ++r) { pf[r] = (j0 + r <= i) ? acc[r] * __expf(ufj[r] - mxfi) : 0.f; pb[r] = (j0 + r >= i) ? acc[r] * __expf(ubj[r] - mxbi) : 0.f; dsf += pf[r]; dsb += pb[r]; }
        dsf = qsum4(dsf); dsb = qsum4(dsb);
        if (q == 0) { tab[T2_DPF + jt * 64 + i] = dsf; tab[T2_DPB + jt * 64 + i] = dsb; }
        u32x2 pw; pw.x = pk2(pf[0], pf[1]); pw.y = pk2(pf[2], pf[3]); *(LAS u32x2*)(Pf + i * 72 + j0) = pw;
        pw.x = pk2(pb[0], pb[1]); pw.y = pk2(pb[2], pb[3]); *(LAS u32x2*)(Pb + i * 72 + j0) = pw;
    }
    {
        const int i = tid >> 3, d0 = (tid & 7) * 16;
        const u32x4 qa = *(const LAS u32x4*)(Qs + i * RSA + d0), qb = *(const LAS u32x4*)(Qs + i * RSA + d0 + 8);
        float sf = 0.f, sb = 0.f;
#pragma unroll
        for (int j = 0; j < 4; ++j) { const float a0 = bflo(qa[j]), a1 = bfhi(qa[j]), b0 = bflo(qb[j]), b1 = bfhi(qb[j]);
            sf += a0 * tab[T2_NVF + d0 + 2 * j] + a1 * tab[T2_NVF + d0 + 2 * j + 1] + b0 * tab[T2_NVF + d0 + 8 + 2 * j] + b1 * tab[T2_NVF + d0 + 8 + 2 * j + 1];
            sb += a0 * tab[T2_NVB + d0 + 2 * j] + a1 * tab[T2_NVB + d0 + 2 * j + 1] + b0 * tab[T2_NVB + d0 + 8 + 2 * j] + b1 * tab[T2_NVB + d0 + 8 + 2 * j + 1]; }
        sf += __shfl_xor(sf, 1); sf += __shfl_xor(sf, 2); sf += __shfl_xor(sf, 4); sb += __shfl_xor(sb, 1); sb += __shfl_xor(sb, 2); sb += __shfl_xor(sb, 4);
        if ((tid & 7) == 0) { tab[T2_QNF + i] = sf; tab[T2_QNB + i] = sb; }
    }
    __syncthreads();
    bf16x8 vf[2];
#pragma unroll
    for (int k = 0; k < 2; ++k) vf[k] = tr_frag(Vs, RSA, 32 * k + 8 * q, e0, c);
    f32x4 ya[4];
#pragma unroll
    for (int it = 0; it < 4; ++it) {
        const int i = 16 * it + c;
        f32x4 aof = (f32x4){0.f, 0.f, 0.f, 0.f}, aob = aof, aif = aof, aib = aof;
        aof = MFMA16(vf[0], *(const LAS bf16x8*)(Pf + i * 72 + 8 * q), aof);
        if (it >= 2) aof = MFMA16(vf[1], *(const LAS bf16x8*)(Pf + i * 72 + 32 + 8 * q), aof);
        aob = MFMA16(vf[1], *(const LAS bf16x8*)(Pb + i * 72 + 32 + 8 * q), aob);
        if (it < 2) aob = MFMA16(vf[0], *(const LAS bf16x8*)(Pb + i * 72 + 8 * q), aob);
#pragma unroll
        for (int k = 0; k < 4; ++k) {
            const bf16x8 qp = mk8(*(const LAS bf16x4*)(Qs + i * RSA + 32 * k + 4 * q), *(const LAS bf16x4*)(Qs + i * RSA + 32 * k + 16 + 4 * q));
            aif = MFMA16(__builtin_bit_cast(bf16x8, FR.cff[k]), qp, aif); aib = MFMA16(__builtin_bit_cast(bf16x8, FR.cfb[k]), qp, aib); }
        const float waf = tab[T2_WAF + i], wab = tab[T2_WAB + i];
        const float denf = tab[T2_DPF + i] + tab[T2_DPF + 64 + i] + tab[T2_DPF + 128 + i] + tab[T2_DPF + 192 + i] + waf * tab[T2_QNF + i];
        const float denb = tab[T2_DPB + i] + tab[T2_DPB + 64 + i] + tab[T2_DPB + 128 + i] + tab[T2_DPB + 192 + i] + wab * tab[T2_QNB + i];
        const float rdf = __builtin_amdgcn_rcpf(fmaxf(fabsf(denf), tab[T2_EMF + i])), rdb = __builtin_amdgcn_rcpf(fmaxf(fabsf(denb), tab[T2_EMB + i]));
        const f32x4 hv = (aof + aif * waf) * rdf + (aob + aib * wab) * rdb;
        const u32x2 og = ogv[it];
        f32x4 y; y[0] = hv[0] * sigmoidf_(bflo(og.x)); y[1] = hv[1] * sigmoidf_(bfhi(og.x)); y[2] = hv[2] * sigmoidf_(bflo(og.y)); y[3] = hv[3] * sigmoidf_(bfhi(og.y));
        ya[it] = y;
        float ss = (y[0] * y[0] + y[1] * y[1]) + (y[2] * y[2] + y[3] * y[3]);
        ss = qsum4(ss);
        if (q == 0) tab[T2_SSP + w * 64 + i] = ss;
    }
    if (u_next < 1024) a2_loadF(F, u_next, FR);
    __syncthreads();
#pragma unroll
    for (int it = 0; it < 4; ++it) {
        const int i = 16 * it + c;
        float ss = 0.f;
#pragma unroll
        for (int ww = 0; ww < 8; ++ww) ss += tab[T2_SSP + ww * 64 + i];
        const float rs = __builtin_amdgcn_rsqf(ss * (1.f / 128.f) + EPS);
        const u32x2 zg = zgv[it];
        const f32x4 y = ya[it] * rs * hg;
        u32x2 o; o.x = pk2(y[0] * siluf_(bflo(zg.x)), y[1] * siluf_(bfhi(zg.x))); o.y = pk2(y[2] * siluf_(bflo(zg.y)), y[3] * siluf_(bfhi(zg.y)));
        *(u32x2*)(F.R1 + (size_t)(rowb + i) * 1024 + h * 128 + e0 + 4 * q) = o;
    }
}

constexpr int RSB = 264;
__device__ __forceinline__ void ret_out(Ctx& F, int l, int s, int m) {
    FRESH_TID(F);
    const int tid = F.tid, lane = F.lane, w = F.wave, hh = w >> 1, ih = w & 1, c = lane & 15, q = lane >> 4;
    LAS bf16* Qs = (LAS bf16*)(F.lds); LAS bf16* Ks = (LAS bf16*)(F.lds + 33792); LAS bf16* Vs = (LAS bf16*)(F.lds + 67584); LAS bf16* Pw = (LAS bf16*)(F.lds + 101376 + w * 4608);
    int row0, L; seq_info(s, row0, L);
    const int gc = (row0 >> 6) + m, rowb = row0 + 64 * m;
    const bool rot = s >= 32;
    const float lgf = logsigmoid_acc(F.ret_logit[(l * 2 + 0) * 4 + hh]) * 1.4426950408889634f, lgb = logsigmoid_acc(F.ret_logit[(l * 2 + 1) * 4 + hh]) * 1.4426950408889634f;
    const float ginvf = ex2(-lgf), gmulb = ex2(lgb);
    u32x4 cff[4][2], cfb[4][2];
    { const size_t slot_f = ((size_t)gc * 4 + hh) * 2;
      const u32x4* pf_ = (const u32x4*)(F.Bst + slot_f * 4096) + lane; const u32x4* pb_ = (const u32x4*)(F.Bst + (slot_f + 1) * 4096) + lane;
#pragma unroll
      for (int es = 0; es < 4; ++es)
#pragma unroll
          for (int k = 0; k < 2; ++k) { cff[es][k] = __builtin_nontemporal_load(pf_ + (es * 2 + k) * 64); cfb[es][k] = __builtin_nontemporal_load(pb_ + (es * 2 + k) * 64); } }
    u32x2 zgv[2][4]; f32x4 hgv[4];
#pragma unroll
    for (int es = 0; es < 4; ++es) { hgv[es] = *(const f32x4*)(F.hn_g + l * 1024 + 512 + hh * 64 + 16 * es + 4 * q);
#pragma unroll
        for (int itl = 0; itl < 2; ++itl) zgv[itl][es] = *(const u32x2*)(F.PROJ + (size_t)(rowb + 16 * (2 * ih + itl) + c) * DINP + C_BZ + hh * 64 + 16 * es + 4 * q); }
#pragma unroll
    for (int i = 0; i < 2; ++i) {
        const int item = tid + 512 * i, r = item >> 4, hd = (item >> 2) & 3, cp = (item & 3) * 8;
        const bf16* src = F.PROJ + (size_t)(rowb + r) * DINP + hd * 64 + cp;
        float qa[8], qb[8], ka[8], kb[8];
        unpack8(*(const u32x4*)(src + C_BQ), qa); unpack8(*(const u32x4*)(src + C_BQ + 32), qb); unpack8(*(const u32x4*)(src + C_BK), ka); unpack8(*(const u32x4*)(src + C_BK + 32), kb);
        if (rot) { rot8(qa, qb, 64 * m + r, cp); rot8(ka, kb, 64 * m + r, cp); }
        *(LAS u32x4*)(Qs + r * RSB + hd * 64 + cp) = packf8(qa, 1.f); *(LAS u32x4*)(Qs + r * RSB + hd * 64 + cp + 32) = packf8(qb, 1.f);
        *(LAS u32x4*)(Ks + r * RSB + hd * 64 + cp) = packf8(ka, 1.f); *(LAS u32x4*)(Ks + r * RSB + hd * 64 + cp + 32) = packf8(kb, 1.f);
    }
#pragma unroll
    for (int i = 0; i < 4; ++i) { const int p = tid + 512 * i, r = p >> 5, cp = (p & 31) * 8;
        *(LAS u32x4*)(Vs + r * RSB + cp) = __builtin_nontemporal_load((const u32x4*)(F.PROJ + (size_t)(rowb + r) * DINP + C_BV + cp)); }
    __syncthreads();
#pragma unroll
    for (int itl = 0; itl < 2; ++itl)
#pragma unroll
        for (int jt = 0; jt < 4; ++jt) {
            const int it = 2 * ih + itl;
            f32x4 acc = (f32x4){0.f, 0.f, 0.f, 0.f};
#pragma unroll
            for (int k = 0; k < 2; ++k) acc = MFMA16(*(const LAS bf16x8*)(Ks + (16 * jt + c) * RSB + hh * 64 + 32 * k + 8 * q), *(const LAS bf16x8*)(Qs + (16 * it + c) * RSB + hh * 64 + 32 * k + 8 * q), acc);
            const int i = 16 * it + c, j0 = 16 * jt + 4 * q;
            float p[4];
            { float wf = ex2((float)(i - j0) * lgf), wb = ex2((float)(j0 - i) * lgb);
#pragma unroll
              for (int r = 0; r < 4; ++r) { const int j = j0 + r; p[r] = acc[r] * (((j <= i) ? wf : 0.f) + ((j >= i) ? wb : 0.f)); wf *= ginvf; wb *= gmulb; } }
            u32x2 pw; pw.x = pk2(p[0], p[1]); pw.y = pk2(p[2], p[3]);
            *(LAS u32x2*)(Pw + (16 * itl + c) * 72 + j0) = pw;
        }
    __syncthreads();
    bf16x8 vf[4][2];
#pragma unroll
    for (int es = 0; es < 4; ++es)
#pragma unroll
        for (int k = 0; k < 2; ++k) vf[es][k] = tr_frag(Vs, RSB, 32 * k + 8 * q, hh * 64 + 16 * es, c);
#pragma unroll
    for (int itl = 0; itl < 2; ++itl) {
        const int i = 16 * (2 * ih + itl) + c;
        const float wqf = ex2((float)(i + 1) * lgf), wqb = ex2((float)(64 - i) * lgb);
        bf16x8 qp[2], pp[2];
#pragma unroll
        for (int k = 0; k < 2; ++k) { qp[k] = mk8(*(const LAS bf16x4*)(Qs + i * RSB + hh * 64 + 32 * k + 4 * q), *(const LAS bf16x4*)(Qs + i * RSB + hh * 64 + 32 * k + 16 + 4 * q));
            pp[k] = *(const LAS bf16x8*)(Pw + (16 * itl + c) * 72 + 32 * k + 8 * q); }
        f32x4 yb[4]; float ss = 0.f;
#pragma unroll
        for (int es = 0; es < 4; ++es) {
            f32x4 ao = (f32x4){0.f, 0.f, 0.f, 0.f}, af = ao, ab = ao;
#pragma unroll
            for (int k = 0; k < 2; ++k) { ao = MFMA16(vf[es][k], pp[k], ao); af = MFMA16(__builtin_bit_cast(bf16x8, cff[es][k]), qp[k], af); ab = MFMA16(__builtin_bit_cast(bf16x8, cfb[es][k]), qp[k], ab); }
            const f32x4 y = ao + af * wqf + ab * wqb; yb[es] = y;
            ss += (y[0] * y[0] + y[1] * y[1]) + (y[2] * y[2] + y[3] * y[3]);
        }
        ss = qsum4(ss);
        const float rs = __builtin_amdgcn_rsqf(ss * (1.f / 64.f) + EPS);
#pragma unroll
        for (int es = 0; es < 4; ++es) {
            const int col = hh * 64 + 16 * es + 4 * q;
            const u32x2 zg = zgv[itl][es];
            const f32x4 hg = hgv[es];
            const f32x4 y = yb[es] * rs * hg;
            u32x2 o; o.x = pk2(y[0] * siluf_(bflo(zg.x)), y[1] * siluf_(bfhi(zg.x))); o.y = pk2(y[2] * siluf_(bflo(zg.y)), y[3] * siluf_(bfhi(zg.y)));
            *(u32x2*)(F.R1 + (size_t)(rowb + i) * 1024 + 512 + col) = o;
        }
    }
}

__device__ __forceinline__ void gla_out(Ctx& F, int l, int s, int m) {
    FRESH_TID(F);
    const int lane = F.lane, w = F.wave, hh = w >> 1, c32 = w & 1, c = lane & 15, q = lane >> 4;
    LAS bf16* base = (LAS bf16*)(F.lds + w * 17408);
    LAS bf16* Qf = base; LAS bf16* Kf = base + 1280; LAS bf16* Qb = base + 2560; LAS bf16* Kb = base + 3840; LAS bf16* Vs = base + 5120; LAS bf16* Pw = base + 7424;
    int row0, L; seq_info(s, row0, L);
    const int rowc = row0 + 64 * m + 32 * c32, gc32 = (row0 >> 5) + 2 * m + c32;
    u32x4 cff[4], cfb[4];
    { const size_t slot_f = ((size_t)gc32 * 4 + hh) * 2;
      const u32x4* pf_ = (const u32x4*)(F.Cst + slot_f * 2048) + lane; const u32x4* pb_ = (const u32x4*)(F.Cst + (slot_f + 1) * 2048) + lane;
#pragma unroll
      for (int es = 0; es < 4; ++es) { cff[es] = __builtin_nontemporal_load(pf_ + es * 64); cfb[es] = __builtin_nontemporal_load(pb_ + es * 64); } }
    u32x2 zgv[2][4]; f32x4 hgv[4];
#pragma unroll
    for (int es = 0; es < 4; ++es) { hgv[es] = *(const f32x4*)(F.hn_g + l * 1024 + 768 + hh * 64 + 16 * es + 4 * q);
#pragma unroll
        for (int it = 0; it < 2; ++it) zgv[it][es] = *(const u32x2*)(F.PROJ + (size_t)(rowc + 16 * it + c) * DINP + C_CZ + hh * 64 + 16 * es + 4 * q); }
#pragma unroll
    for (int i = 0; i < 4; ++i) { const int p = lane + 64 * i, r = p >> 3, cp = (p & 7) * 8;
        *(LAS u32x4*)(Vs + r * 72 + cp) = __builtin_nontemporal_load((const u32x4*)(F.PROJ + (size_t)(rowc + r) * DINP + C_CV + hh * 64 + cp)); }
    {
        const int p = lane >> 1, d0 = (lane & 1) * 16;
        const size_t row = (size_t)(rowc + p);
        const f32x4* cbf = (const f32x4*)(F.CB + (row * 2 + 0) * 128 + hh * 32 + d0); const f32x4* cbb = (const f32x4*)(F.CB + (row * 2 + 1) * 128 + hh * 32 + d0);
        const bf16* src = F.PROJ + row * DINP + hh * 32 + d0;
        float qv[16], kv[16], bf_[16], bb_[16];
        { float t8[8]; unpack8(*(const u32x4*)(src + C_CQ), t8);
#pragma unroll
          for (int j = 0; j < 8; ++j) qv[j] = t8[j];
          unpack8(*(const u32x4*)(src + C_CQ + 8), t8);
#pragma unroll
          for (int j = 0; j < 8; ++j) qv[8 + j] = t8[j];
          unpack8(*(const u32x4*)(src + C_CK), t8);
#pragma unroll
          for (int j = 0; j < 8; ++j) kv[j] = t8[j];
          unpack8(*(const u32x4*)(src + C_CK + 8), t8);
#pragma unroll
          for (int j = 0; j < 8; ++j) kv[8 + j] = t8[j]; }
#pragma unroll
        for (int j = 0; j < 4; ++j) { const f32x4 a = cbf[j], b = cbb[j];
#pragma unroll
            for (int r = 0; r < 4; ++r) { bf_[4 * j + r] = a[r]; bb_[4 * j + r] = b[r]; } }
#pragma unroll
        for (int hp = 0; hp < 2; ++hp) {
            u32x4 o;
#pragma unroll
            for (int j = 0; j < 4; ++j) o[j] = pk2(qv[8 * hp + 2 * j] * __expf(bf_[8 * hp + 2 * j]), qv[8 * hp + 2 * j + 1] * __expf(bf_[8 * hp + 2 * j + 1]));
            *(LAS u32x4*)(Qf + p * 40 + d0 + 8 * hp) = o;
#pragma unroll
            for (int j = 0; j < 4; ++j) o[j] = pk2(kv[8 * hp + 2 * j] * __expf(-bf_[8 * hp + 2 * j]), kv[8 * hp + 2 * j + 1] * __expf(-bf_[8 * hp + 2 * j + 1]));
            *(LAS u32x4*)(Kf + p * 40 + d0 + 8 * hp) = o;
#pragma unroll
            for (int j = 0; j < 4; ++j) o[j] = pk2(qv[8 * hp + 2 * j] * __expf(bb_[8 * hp + 2 * j]), qv[8 * hp + 2 * j + 1] * __expf(bb_[8 * hp + 2 * j + 1]));
            *(LAS u32x4*)(Qb + p * 40 + d0 + 8 * hp) = o;
#pragma unroll
            for (int j = 0; j < 4; ++j) o[j] = pk2(kv[8 * hp + 2 * j] * __expf(-bb_[8 * hp + 2 * j]), kv[8 * hp + 2 * j + 1] * __expf(-bb_[8 * hp + 2 * j + 1]));
            *(LAS u32x4*)(Kb + p * 40 + d0 + 8 * hp) = o;
        }
    }
    __syncthreads();
#pragma unroll
    for (int it = 0; it < 2; ++it)
#pragma unroll
        for (int jt = 0; jt < 2; ++jt) {
            const f32x4 z = (f32x4){0.f, 0.f, 0.f, 0.f};
            const f32x4 af = MFMA16(*(const LAS bf16x8*)(Kf + (16 * jt + c) * 40 + 8 * q), *(const LAS bf16x8*)(Qf + (16 * it + c) * 40 + 8 * q), z);
            const f32x4 ab = MFMA16(*(const LAS bf16x8*)(Kb + (16 * jt + c) * 40 + 8 * q), *(const LAS bf16x8*)(Qb + (16 * it + c) * 40 + 8 * q), z);
            const int i = 16 * it + c, j0 = 16 * jt + 4 * q;
            float p[4];
#pragma unroll
            for (int r = 0; r < 4; ++r) p[r] = ((j0 + r <= i) ? af[r] : 0.f) + ((j0 + r >= i) ? ab[r] : 0.f);
            u32x2 pw; pw.x = pk2(p[0], p[1]); pw.y = pk2(p[2], p[3]);
            *(LAS u32x2*)(Pw + i * 40 + j0) = pw;
        }
    __syncthreads();
    bf16x8 vf[4];
#pragma unroll
    for (int es = 0; es < 4; ++es) vf[es] = tr_frag(Vs, 72, 8 * q, 16 * es, c);
#pragma unroll
    for (int it = 0; it < 2; ++it) {
        const int i = 16 * it + c;
        const bf16x8 pp = *(const LAS bf16x8*)(Pw + i * 40 + 8 * q);
        const bf16x8 qpf = mk8(*(const LAS bf16x4*)(Qf + i * 40 + 4 * q), *(const LAS bf16x4*)(Qf + i * 40 + 16 + 4 * q));
        const bf16x8 qpb = mk8(*(const LAS bf16x4*)(Qb + i * 40 + 4 * q), *(const LAS bf16x4*)(Qb + i * 40 + 16 + 4 * q));
        f32x4 yc[4]; float ss = 0.f;
#pragma unroll
        for (int es = 0; es < 4; ++es) {
            f32x4 ao = (f32x4){0.f, 0.f, 0.f, 0.f};
            ao = MFMA16(vf[es], pp, ao); ao = MFMA16(__builtin_bit_cast(bf16x8, cff[es]), qpf, ao); ao = MFMA16(__builtin_bit_cast(bf16x8, cfb[es]), qpb, ao);
            yc[es] = ao; ss += (ao[0] * ao[0] + ao[1] * ao[1]) + (ao[2] * ao[2] + ao[3] * ao[3]);
        }
        ss = qsum4(ss);
        const float rs = __builtin_amdgcn_rsqf(ss * (1.f / 64.f) + EPS);
#pragma unroll
        for (int es = 0; es < 4; ++es) {
            const int col = hh * 64 + 16 * es + 4 * q;
            const u32x2 zg = zgv[it][es];
            const f32x4 hg = hgv[es];
            const f32x4 y = yc[es] * rs * hg;
            u32x2 o; o.x = pk2(y[0] * siluf_(bflo(zg.x)), y[1] * siluf_(bfhi(zg.x))); o.y = pk2(y[2] * siluf_(bflo(zg.y)), y[3] * siluf_(bfhi(zg.y)));
            *(u32x2*)(F.R1 + (size_t)(rowc + i) * 1024 + 768 + col) = o;
        }
    }
}

__device__ __forceinline__ void mixer_pass2(Ctx& F, int l) {
    FRESH_TID(F);
    const int gc0 = F.g_pm0 * 4, ub = gc0 * 4;
    {
        A2R R, Rn; A2Q Q; A2F FR;
        const int u0 = ub + 16 * (F.g_r & 3) + (F.g_r >> 2);
        a2_loadA(F, l, u0, R); a2_loadQ(F, u0, Q); a2_loadF(F, u0, FR);
#pragma unroll 1
        for (int k = 0; k < 4; ++k) {
            a2_compute(F, l, u0 + 4 * k, R, Q, FR, k < 3 ? u0 + 4 * (k + 1) : 2000, Rn);
            R = Rn;
        }
    }
    __syncthreads();
    { const int gc = gc0 + 4 * (F.g_r & 3) + (F.g_r >> 2);
      int s, m; if (gc < 128) { s = gc >> 2; m = gc & 3; } else { s = 32 + ((gc - 128) >> 4); m = (gc - 128) & 15; }
      ret_out(F, l, s, m);
      __syncthreads();
      gla_out(F, l, s, m);
      __syncthreads(); }
}

__device__ __forceinline__ void group_barrier(Ctx& F, unsigned& epoch, int sub = 0) {
    asm volatile("s_waitcnt vmcnt(0)" ::: "memory");
    __syncthreads();
    ++epoch;
    if (threadIdx.x == 0) {
        unsigned* cnt = F.ctl + CW_GB + 64 * F.g_id + 8 * sub; unsigned* tmo = F.ctl + CW_GTMO;
        if (F.g_rel) {
            __builtin_amdgcn_fence(__ATOMIC_RELEASE, "agent");
            asm volatile("s_waitcnt vmcnt(0)" ::: "memory"); }
        __builtin_amdgcn_fence(__ATOMIC_ACQUIRE, "agent");
        (void)__hip_atomic_fetch_add(cnt, 1u, __ATOMIC_RELAXED, __HIP_MEMORY_SCOPE_AGENT);
        const unsigned target = epoch * (sub ? 4u : 16u); unsigned sp = 0;
        while (__hip_atomic_load(cnt, __ATOMIC_RELAXED, __HIP_MEMORY_SCOPE_AGENT) < target) {
            __builtin_amdgcn_s_sleep(1);
            if ((++sp & 255u) == 0u) { if (__hip_atomic_load(tmo, __ATOMIC_RELAXED, __HIP_MEMORY_SCOPE_AGENT)) break; if (sp > (1u << 20)) { atomicAdd(tmo, 1u); break; } }
        }
        asm volatile("s_waitcnt vmcnt(0)" ::: "memory");
    }
    __syncthreads();
}
__device__ __forceinline__ void final_group(Ctx& F) {
    FRESH_TID(F);
    const int cw = (F.g_r >> 2) * 8 + F.wave;
    for (int mm = cw; mm < 256; mm += 32) {
        const int m = (F.g_pm0 + (F.g_r & 3)) * 256 + mm;
        const float rstd = __builtin_amdgcn_rsqf(F.ssq[4 * NTOK + m] * (1.f / 1024.f) + EPS);
        const u32x4* xr = (const u32x4*)(F.XB + (size_t)m * 1024) + F.lane;
        f32x4* orow = (f32x4*)(F.out + (size_t)m * 1024);
#pragma unroll
        for (int j = 0; j < 2; ++j) { const u32x4 xb = __builtin_nontemporal_load(xr + 64 * j); const int c0 = 8 * F.lane + 512 * j;
            const f32x4 g0 = *(const f32x4*)(F.final_g + c0), g1 = *(const f32x4*)(F.final_g + c0 + 4);
            const f32x4 x0 = (f32x4){bflo(xb.x), bfhi(xb.x), bflo(xb.y), bfhi(xb.y)}, x1 = (f32x4){bflo(xb.z), bfhi(xb.z), bflo(xb.w), bfhi(xb.w)};
            __builtin_nontemporal_store(x0 * rstd * g0, orow + (c0 >> 2)); __builtin_nontemporal_store(x1 * rstd * g1, orow + (c0 >> 2) + 1); }
    }
}

__global__ void __launch_bounds__(512, 2) fwd_kernel(Args args) {
    extern __shared__ __attribute__((aligned(16))) unsigned char lds_raw[];
    Ctx F;
    F.lds = (LAS unsigned char*)lds_raw;
    F.tid = threadIdx.x; F.lane = F.tid & 63; F.wave = __builtin_amdgcn_readfirstlane(F.tid >> 6); F.G = gridDim.x; F.bid = blockIdx.x;
    F.x_prompt = args.in[0]; F.x_sample = args.in[1]; F.st_C = args.in[2]; F.st_n = args.in[3]; F.st_m = args.in[4]; F.st_ret = args.in[5]; F.st_gla = args.in[6];
    F.cvec = args.in[7]; F.c_ctx = args.in[8]; F.norm_g = args.in[9]; F.w_ada = args.in[10]; F.b_ada = args.in[11]; F.w_in = args.in[12]; F.gate_b = args.in[13];
    F.ret_logit = args.in[14]; F.gla_w2 = args.in[15]; F.gla_b2 = args.in[16]; F.hn_g = args.in[17]; F.w_out = args.in[18]; F.final_g = args.in[19];
    F.out = args.out; unsigned char* ws = args.ws;
    F.ctl = (unsigned*)(ws + WS_CTL); F.mod = (float*)(ws + WS_MOD); F.WinT = (bf16*)(ws + WS_WIN); F.WoutT = (bf16*)(ws + WS_WOUT);
    F.R1 = (bf16*)(ws + WS_R1); F.PROJ = (bf16*)(ws + WS_PROJ); F.Ast = (bf16*)(ws + WS_AST); F.Bst = (bf16*)(ws + WS_BST); F.Cst = (bf16*)(ws + WS_CST); F.Anm = (float*)(ws + WS_ANM); F.AG = (float*)(ws + WS_AG); F.CB = (float*)(ws + WS_CB); F.SW = (float*)(ws + WS_SW); F.R3 = (bf16*)(ws + WS_R3); F.XB = (bf16*)(ws + WS_XB); F.ssq = (float*)(F.ctl + CW_SUMSQ);
    if (F.tid < 8) ((LAS unsigned*)(F.lds + LDS_BYTES - 32))[F.tid] = 0u;
    __syncthreads();
    const XcdBarrier xbar = xcd_barrier_post(F.ctl + CW_BAR, (volatile LAS unsigned*)(F.lds + LDS_BYTES - 32));
    p0_prologue(F);
    xcd_barrier(xbar);
    {
        bool uniform = true;
#pragma unroll
        for (unsigned j = 0; j < 16; ++j) { const unsigned cj = xb_ld(&xbar.bar[XB_XCNT(j)]); uniform = uniform && (cj == (j < 8 ? 32u : 0u)); }
        const unsigned myrank = (unsigned)__builtin_amdgcn_readfirstlane((int)((volatile LAS unsigned*)(F.lds + LDS_BYTES - 32))[2]);
        uniform = uniform && (xbar.x < 8u) && (myrank < 32u);
        const int x = uniform ? (int)xbar.x : (F.bid & 7), i = uniform ? (int)myrank : (F.bid >> 3);
        F.g_rel = uniform ? 0 : 1;
        const int xi = __builtin_amdgcn_readfirstlane(x), ii = __builtin_amdgcn_readfirstlane(i);
        F.g_typ = ii >> 4; F.g_r = ii & 15; F.g_id = F.g_typ * 8 + xi; F.g_pm0 = F.g_typ ? 32 + 4 * xi : 4 * xi; F.g_s0 = F.g_typ ? 32 + xi : 4 * xi;
    }
    p0b_phase(F);
    xcd_barrier(xbar);
    unsigned gbe = 0;
    for (int l = 0; l < DEPTH; ++l) {
        {
            pg8::Gemm g{F.R3, F.WinT + (size_t)l * DINP * 1024, NTOK, DIN_EARLY, 1024}; pg8::StaticOrder S; S.init(NTOK, DIN_EARLY, F.G, F.bid);
            S.grp_w = 16; S.grp_r = F.g_r; S.grp_pm0 = F.g_pm0; S.grp_units = 64;
            if (F.g_r < 8) S.late_pn = (DIN_EARLY / 256) + (F.g_r >> 2);
            S.arrive = F.ctl + CW_GA + 64 * F.g_id; S.arrive_pn = 12 + (F.g_r >> 2); S.arrive_rel = F.g_rel;
            pg8::EpiBf16 E{F.PROJ, DINP, F.ssq + (size_t)l * NTOK, F.SW + (size_t)l * 16 * DINP};
            pg8::gemm_phase<pg8::EpiBf16, pg8::StaticOrder, true, true>(F.lds, g, S, E);
        }
        {
            __syncthreads();
            if (threadIdx.x == 0) {
                unsigned* cnt = F.ctl + CW_GA + 64 * F.g_id; unsigned* tmo = F.ctl + CW_GTMO;
                const unsigned target = 128u * (unsigned)(l + 1); unsigned sp = 0;
                __builtin_amdgcn_fence(__ATOMIC_ACQUIRE, "agent");
                while (__hip_atomic_load(cnt, __ATOMIC_RELAXED, __HIP_MEMORY_SCOPE_AGENT) < target) {
                    __builtin_amdgcn_s_sleep(1);
                    if ((++sp & 255u) == 0u) { if (__hip_atomic_load(tmo, __ATOMIC_RELAXED, __HIP_MEMORY_SCOPE_AGENT)) break; if (sp > (1u << 20)) { atomicAdd(tmo, 1u); break; } }
                }
                asm volatile("s_waitcnt vmcnt(0)" ::: "memory");
            }
            __syncthreads();
        }
        mixer_pass1(F, l);
        group_barrier(F, gbe);
        mixer_pass2(F, l);
        { unsigned ec = 2u * (unsigned)l; group_barrier(F, ec, 1 + (F.g_r & 3)); }
        {
            pg8::Gemm g{F.R1, F.WoutT + (size_t)l * 1024 * 1024, NTOK, 1024, 1024}; pg8::StaticOrder S; S.init(NTOK, 1024, F.G, F.bid);
            S.grp_w = 16; S.grp_r = F.g_r; S.grp_pm0 = F.g_pm0; S.grp_units = 16;
            const bool lastl = (l == DEPTH - 1);
            pg8::EpiResid E{F.x_prompt, F.x_sample, l == 0 ? nullptr : F.XB, F.out, F.XB, F.mod + (size_t)l * 9 * 3072 + 2048,
                            lastl ? nullptr : F.norm_g + (l + 1) * 1024, lastl ? nullptr : F.mod + (size_t)(l + 1) * 9 * 3072 + 1024, F.R3, F.ssq + (size_t)(l + 1) * NTOK};
            pg8::gemm_phase<pg8::EpiResid, pg8::StaticOrder, true, true>(F.lds, g, S, E);
        }
        { unsigned ec = 2u * (unsigned)l + 1u; group_barrier(F, ec, 1 + (F.g_r & 3)); }
    }
    final_group(F);
}

extern "C" void kernel_launch(void* const* d_in, const int* in_sizes, int n_in, void* d_out, int out_size, void* d_ws, size_t ws_size, hipStream_t stream) {
    static int grid = 0;
    if (grid == 0) {
        if (n_in != 20 || out_size != (int)O_END || ws_size < WS_END) { fprintf(stderr, "kernel_launch: unexpected shapes: n_in %d out %d ws %zu\n", n_in, out_size, ws_size); grid = -1; return; }
        int dev = 0, cus = 0, per_cu = 0;
        if (hipGetDevice(&dev) != hipSuccess || hipDeviceGetAttribute(&cus, hipDeviceAttributeMultiprocessorCount, dev) != hipSuccess) { grid = -1; return; }
        if (hipFuncSetAttribute((const void*)fwd_kernel, hipFuncAttributeMaxDynamicSharedMemorySize, LDS_BYTES) != hipSuccess) { fprintf(stderr, "kernel_launch: hipFuncSetAttribute failed\n"); grid = -1; return; }
        if (hipOccupancyMaxActiveBlocksPerMultiprocessor(&per_cu, (const void*)fwd_kernel, 512, LDS_BYTES) != hipSuccess || per_cu < 1) { fprintf(stderr, "kernel_launch: occupancy query says %d blocks per CU\n", per_cu); per_cu = 1; }
        (void)hipGetLastError();
        grid = cus;
        if (grid != 256) { fprintf(stderr, "kernel_launch: this kernel is built for a 256-CU device (16 groups of 16 workgroups); found %d CUs\n", cus); grid = -1; return; }
    }
    if (grid < 0) return;
    (void)hipMemsetAsync((char*)d_ws + WS_CTL, 0, CTL_ZERO_BYTES, stream);
    Args a{};
    for (int i = 0; i < 20; ++i) a.in[i] = (const float*)d_in[i];
    a.out = (float*)d_out; a.ws = (unsigned char*)d_ws;
    a.ph_lo = 0; a.ph_hi = NPHASE;
    void* kargs[] = {&a};
    hipError_t e = hipLaunchCooperativeKernel((const void*)fwd_kernel, dim3(grid), dim3(512), kargs, LDS_BYTES, stream);
    if (e != hipSuccess) fprintf(stderr, "kernel_launch: cooperative launch failed: %s (grid %d)\n", hipGetErrorString(e), grid);
}
```
